# Optimizing an MI355X kernel written in HIP

```python
import jax, jax.numpy as jnp
from jax import lax
import numpy as np

D_MODEL = 1024
BATCH = 4
SEQ = 4096
DEPTH = 1

PLE_DIM = 256
EPS = 1e-6
RET_HEADS = 4
RET_DK = 128
RET_DV = 128
RET_CHUNK = 128
SWA_HEADS = 8
SWA_KV_HEADS = 2
SWA_GROUP = SWA_HEADS // SWA_KV_HEADS
SWA_HD = 64
WINDOW = 128
N_GROUPS = 4
EXPERTS_PER_GROUP = 8
N_EXPERTS = N_GROUPS * EXPERTS_PER_GROUP
EXPERT_FF = 256
TOP_K = 2

RET_QK = RET_HEADS * RET_DK
RET_V = RET_HEADS * RET_DV
SWA_Q = SWA_HEADS * SWA_HD
SWA_KV = SWA_KV_HEADS * SWA_HD
IN_SPLITS = (RET_QK, RET_QK, RET_V, RET_V, SWA_Q, SWA_KV, SWA_KV, D_MODEL, D_MODEL)
IN_WIDTH = sum(IN_SPLITS)

kernel_name = "hybrid_retention_swa_hmoe_block"


def rms_norm(x, g):
    xf = x.astype(jnp.float32)
    y = xf * lax.rsqrt(jnp.mean(xf * xf, axis=-1, keepdims=True) + EPS)
    return (y * g.astype(jnp.float32)).astype(x.dtype)


def head_group_norm(y, g, b):
    yf = y.astype(jnp.float32)
    mu = jnp.mean(yf, axis=-1, keepdims=True)
    var = jnp.mean(jnp.square(yf - mu), axis=-1, keepdims=True)
    yn = ((yf - mu) * lax.rsqrt(var + EPS)).reshape(y.shape[0], y.shape[1], -1)
    return (yn * g.astype(jnp.float32) + b.astype(jnp.float32)).astype(y.dtype)


def retention_chunkwise(q, k, v):
    dtype = v.dtype
    q = q.astype(jnp.float32)
    k = k.astype(jnp.float32) * (RET_DK ** -0.5)
    v = v.astype(jnp.float32)
    b, s, h, dk = q.shape
    nc = s // RET_CHUNK
    q = q.reshape(b, nc, RET_CHUNK, h, dk)
    k = k.reshape(b, nc, RET_CHUNK, h, dk)
    v = v.reshape(b, nc, RET_CHUNK, h, RET_DV)
    log_gamma = jnp.log1p(-jnp.exp2(-5.0 - jnp.arange(h, dtype=jnp.float32)))
    pos = jnp.arange(RET_CHUNK, dtype=jnp.float32)
    diff = pos[:, None] - pos[None, :]
    decay_mask = jnp.where(diff[None] >= 0.0,
                           jnp.exp(jnp.maximum(diff, 0.0)[None] * log_gamma[:, None, None]), 0.0)
    scores = jnp.einsum('bnihd,bnjhd->bnhij', q, k) * decay_mask
    inner = jnp.einsum('bnhij,bnjhv->bnihv', scores, v)
    zeta = jnp.exp((RET_CHUNK - 1.0 - pos)[None, :] * log_gamma[:, None])
    chunk_kv = jnp.einsum('bnjhd,bnjhv,hj->nbhdv', k, v, zeta)
    chunk_decay = jnp.exp(RET_CHUNK * log_gamma)[None, :, None, None]

    def step(state, kv):
        return chunk_decay * state + kv, state

    _, prev_states = lax.scan(step, jnp.zeros_like(chunk_kv[0]), chunk_kv)
    xi = jnp.exp((pos + 1.0)[None, :] * log_gamma[:, None])
    cross = jnp.einsum('bnihd,nbhdv,hi->bnihv', q, prev_states, xi)
    return (inner + cross).reshape(b, s, h, RET_DV).astype(dtype)


def sliding_window_gqa(q, k, v, sinks):
    b, s = q.shape[:2]
    nb = s // WINDOW
    qb = q.reshape(b, nb, WINDOW, SWA_KV_HEADS, SWA_GROUP, SWA_HD)
    kb = k.reshape(b, nb, WINDOW, SWA_KV_HEADS, SWA_HD)
    vb = v.reshape(b, nb, WINDOW, SWA_KV_HEADS, SWA_HD)
    k_band = jnp.concatenate([jnp.concatenate([jnp.zeros_like(kb[:, :1]), kb[:, :-1]], axis=1), kb], axis=2)
    v_band = jnp.concatenate([jnp.concatenate([jnp.zeros_like(vb[:, :1]), vb[:, :-1]], axis=1), vb], axis=2)
    scores = jnp.einsum('bnqkgd,bnskd->bnkgqs', qb, k_band).astype(jnp.float32) * (SWA_HD ** -0.5)
    qi = jnp.arange(WINDOW)
    sj = jnp.arange(2 * WINDOW)
    rel = qi[:, None] + WINDOW - sj[None, :]
    in_window = (rel >= 0) & (rel < WINDOW)
    key_exists = (jnp.arange(nb)[:, None] * WINDOW - WINDOW + sj[None, :]) >= 0
    mask = in_window[None] & key_exists[:, None, :]
    slopes = jnp.exp2(-8.0 * jnp.arange(1, SWA_HEADS + 1, dtype=jnp.float32) / SWA_HEADS)
    slopes = slopes.reshape(SWA_KV_HEADS, SWA_GROUP)
    alibi = -slopes[:, :, None, None] * rel.astype(jnp.float32)[None, None]
    scores = jnp.where(mask[None, :, None, None], scores + alibi[None, None], -1e30)
    sink = jnp.broadcast_to(sinks.astype(jnp.float32).reshape(1, 1, SWA_KV_HEADS, SWA_GROUP, 1, 1),
                            scores.shape[:-1] + (1,))
    probs = jax.nn.softmax(jnp.concatenate([scores, sink], axis=-1), axis=-1)[..., :-1]
    out = jnp.einsum('bnkgqs,bnskd->bnqkgd', probs.astype(v.dtype), v_band)
    return out.reshape(b, s, SWA_Q)


def hierarchical_moe(h, w_rg, b_rg, w_re, b_re, w_gate, w_up, w_down):
    b, s, d = h.shape
    hf = h.reshape(-1, d)
    g_prob = jax.nn.softmax((hf @ w_rg + b_rg).astype(jnp.float32), axis=-1)
    g_sel = jnp.argmax(g_prob, axis=-1)
    g_w = jnp.take_along_axis(g_prob, g_sel[:, None], axis=-1)
    e_logits = (hf @ w_re + b_re).astype(jnp.float32).reshape(-1, N_GROUPS, EXPERTS_PER_GROUP)
    e_in_group = jnp.take_along_axis(e_logits, g_sel[:, None, None], axis=1)[:, 0]
    top_p, top_i = lax.top_k(jax.nn.softmax(e_in_group, axis=-1), TOP_K)
    top_p = top_p / jnp.sum(top_p, axis=-1, keepdims=True)
    expert_id = g_sel[:, None] * EXPERTS_PER_GROUP + top_i
    combine = jnp.sum(jax.nn.one_hot(expert_id, N_EXPERTS, dtype=jnp.float32)
                      * (g_w * top_p)[..., None], axis=1)
    y = jnp.zeros_like(hf)
    for grp in range(N_GROUPS):
        sl = slice(grp * EXPERTS_PER_GROUP, (grp + 1) * EXPERTS_PER_GROUP)
        hid = jax.nn.silu(jnp.einsum('td,edf->tef', hf, w_gate[sl])) * jnp.einsum('td,edf->tef', hf, w_up[sl])
        y = y + jnp.einsum('tef,efd->td', hid * combine[:, sl, None].astype(hid.dtype), w_down[sl])
    return y.reshape(b, s, d)


def setup_inputs(seed: int = 0) -> dict:
    key = jax.random.key(seed)
    ks = jax.random.split(key, 26)
    f32 = jnp.float32
    L = DEPTH

    def nrm(k, shape, scale):
        return jax.random.normal(k, shape, f32) * scale

    def gain(k, shape):
        return 1.0 + 0.02 * jax.random.normal(k, shape, f32)

    return dict(
        x=nrm(ks[0], (BATCH, SEQ, D_MODEL), 1.0),
        p=nrm(ks[1], (L, BATCH, SEQ, PLE_DIM), 1.0),
        mix_norm_g=gain(ks[2], (L, D_MODEL)),
        w_in=nrm(ks[3], (L, D_MODEL, IN_WIDTH), D_MODEL ** -0.5),
        ret_gn_g=gain(ks[4], (L, RET_V)),
        ret_gn_b=nrm(ks[5], (L, RET_V), 0.02),
        w_ret_o=nrm(ks[6], (L, RET_V, D_MODEL), RET_V ** -0.5),
        q_norm_g=gain(ks[7], (L, SWA_HD)),
        k_norm_g=gain(ks[8], (L, SWA_HD)),
        attn_sinks=nrm(ks[9], (L, SWA_HEADS), 0.5),
        w_swa_o=nrm(ks[10], (L, SWA_Q, D_MODEL), SWA_Q ** -0.5),
        w_out=nrm(ks[11], (L, D_MODEL, D_MODEL), D_MODEL ** -0.5),
        ffn_norm_g=gain(ks[12], (L, D_MODEL)),
        w_router_group=nrm(ks[13], (L, D_MODEL, N_GROUPS), D_MODEL ** -0.5),
        b_router_group=nrm(ks[14], (L, N_GROUPS), 0.01),
        w_router_expert=nrm(ks[15], (L, D_MODEL, N_EXPERTS), D_MODEL ** -0.5),
        b_router_expert=nrm(ks[16], (L, N_EXPERTS), 0.01),
        w_exp_gate=nrm(ks[17], (L, N_EXPERTS, D_MODEL, EXPERT_FF), D_MODEL ** -0.5),
        w_exp_up=nrm(ks[18], (L, N_EXPERTS, D_MODEL, EXPERT_FF), D_MODEL ** -0.5),
        w_exp_down=nrm(ks[19], (L, N_EXPERTS, EXPERT_FF, D_MODEL), EXPERT_FF ** -0.5),
        ple_gate_norm_g=gain(ks[20], (L, D_MODEL)),
        w_ple_gate=nrm(ks[21], (L, D_MODEL, D_MODEL), D_MODEL ** -0.5),
        w_ple=nrm(ks[22], (L, PLE_DIM, D_MODEL), PLE_DIM ** -0.5),
        ple_norm_g=gain(ks[23], (L, D_MODEL)),
    )


def reference(x, p, mix_norm_g, w_in, ret_gn_g, ret_gn_b, w_ret_o, q_norm_g, k_norm_g, attn_sinks,
              w_swa_o, w_out, ffn_norm_g, w_router_group, b_router_group, w_router_expert,
              b_router_expert, w_exp_gate, w_exp_up, w_exp_down, ple_gate_norm_g, w_ple_gate,
              w_ple, ple_norm_g):
    b, s, _ = x.shape
    split_at = [int(c) for c in np.cumsum(IN_SPLITS)[:-1]]
    for i in range(DEPTH):
        h = rms_norm(x, mix_norm_g[i])
        z = h @ w_in[i]
        rq, rk, rv, rg, sq, sk, sv, gate_r, gate_s = jnp.split(z, split_at, axis=-1)
        y_r = retention_chunkwise(rq.reshape(b, s, RET_HEADS, RET_DK),
                                  rk.reshape(b, s, RET_HEADS, RET_DK),
                                  rv.reshape(b, s, RET_HEADS, RET_DV))
        y_r = (jax.nn.silu(rg) * head_group_norm(y_r, ret_gn_g[i], ret_gn_b[i])) @ w_ret_o[i]
        q = rms_norm(sq.reshape(b, s, SWA_HEADS, SWA_HD), q_norm_g[i])
        k = rms_norm(sk.reshape(b, s, SWA_KV_HEADS, SWA_HD), k_norm_g[i])
        v = sv.reshape(b, s, SWA_KV_HEADS, SWA_HD)
        y_s = sliding_window_gqa(q, k, v, attn_sinks[i]) @ w_swa_o[i]
        merged = jax.nn.sigmoid(gate_r) * y_r + jax.nn.sigmoid(gate_s) * y_s
        x = x + merged @ w_out[i]
        x = x + hierarchical_moe(rms_norm(x, ffn_norm_g[i]), w_router_group[i], b_router_group[i],
                                 w_router_expert[i], b_router_expert[i], w_exp_gate[i],
                                 w_exp_up[i], w_exp_down[i])
        ple = rms_norm(p[i] @ w_ple[i], ple_norm_g[i])
        x = x + jax.nn.sigmoid(rms_norm(x, ple_gate_norm_g[i]) @ w_ple_gate[i]) * ple
    return x
```

```cpp
#include <hip/hip_runtime.h>
#include <cstdio>
#include <cstdint>

constexpr int BATCH = 4, SEQ = 4096, T = BATCH * SEQ, D = 1024;
constexpr int PLE = 256;
constexpr float EPS = 1e-6f;
constexpr int RH = 4, RDK = 128, RC = 128, NC = SEQ / RC;
constexpr int SH = 8, SKV = 2, SG = 4, HD = 64, WIN = 128;
constexpr int NE = 32, EPG = 8, NG = 4, FF = 256;
constexpr int INW = 4864;
constexpr float LOG2E = 1.4426950408889634f;

typedef unsigned short bf16;
__device__ __forceinline__ unsigned f2bf(float f) { unsigned u = __builtin_bit_cast(unsigned, f); return (u + 0x7fffu + ((u >> 16) & 1u)) >> 16; }
__device__ __forceinline__ float bf2f(bf16 h) { return __builtin_bit_cast(float, (unsigned)h << 16); }
__device__ __forceinline__ float wave_sum(float v) {
#pragma unroll
    for (int o = 1; o < 64; o <<= 1) v += __shfl_xor(v, o);
    return v;
}
__device__ __forceinline__ float sigmoidf_(float x) { return 1.f / (1.f + __expf(-x)); }

constexpr size_t MiB = 1u << 20;
constexpr size_t WS_XN = 18 * MiB;
constexpr size_t WS_KV = 18 * MiB;
constexpr size_t WS_MG = 18 * MiB;
constexpr size_t WS_X2B = 18 * MiB;
constexpr size_t WS_RQ = 50 * MiB, WS_RK = 66 * MiB, WS_RV = 82 * MiB, WS_RG = 98 * MiB;
constexpr size_t WS_SQ = 114 * MiB;
constexpr size_t WS_SK = 130 * MiB, WS_SV = 134 * MiB;
constexpr size_t WS_GR = 138 * MiB, WS_GS = 170 * MiB;
constexpr size_t WS_ST = 202 * MiB;
constexpr size_t WS_AS = 218 * MiB, WS_AR = 234 * MiB;
constexpr size_t WS_SQRAW = 202 * MiB;
constexpr size_t WS_MISC = 250 * MiB;
constexpr size_t WS_RSTD1 = WS_MISC, WS_RSTD2 = WS_MISC + 65536, WS_RSTDP = WS_MISC + 2 * 65536;
constexpr size_t WS_SEL = WS_MISC + 3 * 65536;
constexpr size_t WS_CW = WS_SEL + 131072;
constexpr size_t WS_X1B = 50 * MiB;
constexpr size_t WS_HIDN = 130 * MiB;
constexpr size_t WS_PP = 216 * MiB;

__global__ void __launch_bounds__(256) k_rmsnorm_bf16(const float* x, const float* g, bf16* out) {
    const int row = blockIdx.x * 4 + (threadIdx.x >> 6), lane = threadIdx.x & 63;
    const float4* xr = (const float4*)(x + (size_t)row * D) + lane;
    float4 v[4]; float s = 0.f;
#pragma unroll
    for (int j = 0; j < 4; ++j) { v[j] = xr[64 * j]; s += v[j].x * v[j].x + v[j].y * v[j].y + v[j].z * v[j].z + v[j].w * v[j].w; }
    const float rstd = rsqrtf(wave_sum(s) * (1.f / D) + EPS);
#pragma unroll
    for (int j = 0; j < 4; ++j) { const float4 gg = ((const float4*)g)[lane + 64 * j];
        uint2 o; o.x = f2bf(v[j].x * rstd * gg.x) | (f2bf(v[j].y * rstd * gg.y) << 16); o.y = f2bf(v[j].z * rstd * gg.z) | (f2bf(v[j].w * rstd * gg.w) << 16);
        ((uint2*)(out + (size_t)row * D))[lane + 64 * j] = o; }
}

struct NG_Args {
    const void* A; int lda; int a_is_f32; const float* B; int ldb; const float* kscale; int M, N, K;
    const void* A2; const float* B2;
    unsigned char* ws; const float* x; float* out; const float* aux0;
};
enum { MODE_Z = 1, MODE_MERGE = 2, MODE_X1 = 3, MODE_PP = 4, MODE_FINAL = 5 };

template <int MODE> __device__ __forceinline__ void ng_store(const NG_Args& a, int row, int col, float v, float v2) {
    unsigned char* ws = a.ws;
    if (MODE == MODE_Z) {
        if (col < 512) ((bf16*)(ws + WS_RQ))[(size_t)row * 512 + col] = (bf16)f2bf(v);
        else if (col < 1024) ((bf16*)(ws + WS_RK))[(size_t)row * 512 + col - 512] = (bf16)f2bf(v * 0.08838834764831845f);
        else if (col < 1536) ((bf16*)(ws + WS_RV))[(size_t)row * 512 + col - 1024] = (bf16)f2bf(v);
        else if (col < 2048) ((bf16*)(ws + WS_RG))[(size_t)row * 512 + col - 1536] = (bf16)f2bf(v * sigmoidf_(v));
        else if (col < 2688) ((float*)(ws + WS_SQRAW))[(size_t)row * 640 + col - 2048] = v;
        else if (col < 2816) ((bf16*)(ws + WS_SV))[(size_t)row * 128 + col - 2688] = (bf16)f2bf(v);
        else if (col < 3840) ((bf16*)(ws + WS_GR))[(size_t)row * 1024 + col - 2816] = (bf16)f2bf(sigmoidf_(v));
        else ((bf16*)(ws + WS_GS))[(size_t)row * 1024 + col - 3840] = (bf16)f2bf(sigmoidf_(v));
    } else if (MODE == MODE_MERGE) {
        const float gr = bf2f(((const bf16*)(ws + WS_GR))[(size_t)row * 1024 + col]), gs = bf2f(((const bf16*)(ws + WS_GS))[(size_t)row * 1024 + col]);
        ((bf16*)(ws + WS_MG))[(size_t)row * 1024 + col] = (bf16)f2bf(gr * v + gs * v2);
    } else if (MODE == MODE_X1) {
        const float x1 = a.x[(size_t)row * 1024 + col] + v;
        a.out[(size_t)row * 1024 + col] = x1; ((bf16*)(ws + WS_X1B))[(size_t)row * 1024 + col] = (bf16)f2bf(x1);
    } else if (MODE == MODE_PP) {
        ((bf16*)(ws + WS_PP))[(size_t)row * 1024 + col] = (bf16)f2bf(v);
    } else if (MODE == MODE_FINAL) {
        const float rstd2 = ((const float*)(ws + WS_RSTD2))[row], rstdp = ((const float*)(ws + WS_RSTDP))[row];
        const float ple = bf2f(((const bf16*)(ws + WS_PP))[(size_t)row * 1024 + col]) * rstdp * a.aux0[col];
        const float x2 = a.out[(size_t)row * 1024 + col];
        a.out[(size_t)row * 1024 + col] = x2 + sigmoidf_(rstd2 * v) * ple;
    }
}

template <int MODE> __global__ void __launch_bounds__(256) k_gemm_naive(NG_Args a) {
    __shared__ float As[16][68], Bs[16][68], As2[16][68], Bs2[16][68];
    const int tid = threadIdx.x, tx = tid & 15, ty = tid >> 4;
    const int m0 = blockIdx.y * 64, n0 = blockIdx.x * 64;
    float acc[4][4], acc2[4][4];
#pragma unroll
    for (int i = 0; i < 4; ++i)
#pragma unroll
        for (int j = 0; j < 4; ++j) { acc[i][j] = 0.f; acc2[i][j] = 0.f; }
    const int ar = tid >> 2, ak = (tid & 3) * 4;
    const int bk = tid >> 4, bn = (tid & 15) * 4;
    for (int k0 = 0; k0 < a.K; k0 += 16) {
        float av[4];
        if (a.a_is_f32) { const float4 t = *(const float4*)((const float*)a.A + (size_t)(m0 + ar) * a.lda + k0 + ak); av[0] = t.x; av[1] = t.y; av[2] = t.z; av[3] = t.w; }
        else { const uint2 t = *(const uint2*)((const bf16*)a.A + (size_t)(m0 + ar) * a.lda + k0 + ak); av[0] = bf2f(t.x & 0xffff); av[1] = bf2f(t.x >> 16); av[2] = bf2f(t.y & 0xffff); av[3] = bf2f(t.y >> 16); }
        float4 bv = *(const float4*)(a.B + (size_t)(k0 + bk) * a.ldb + n0 + bn);
        if (a.kscale) { const float s = a.kscale[k0 + bk]; bv.x *= s; bv.y *= s; bv.z *= s; bv.w *= s; }
#pragma unroll
        for (int i = 0; i < 4; ++i) As[ak + i][ar] = av[i];
        Bs[bk][bn] = bv.x; Bs[bk][bn + 1] = bv.y; Bs[bk][bn + 2] = bv.z; Bs[bk][bn + 3] = bv.w;
        if (MODE == MODE_MERGE) {
            const uint2 t = *(const uint2*)((const bf16*)a.A2 + (size_t)(m0 + ar) * a.lda + k0 + ak);
            As2[ak][ar] = bf2f(t.x & 0xffff); As2[ak + 1][ar] = bf2f(t.x >> 16); As2[ak + 2][ar] = bf2f(t.y & 0xffff); As2[ak + 3][ar] = bf2f(t.y >> 16);
            const float4 b2 = *(const float4*)(a.B2 + (size_t)(k0 + bk) * a.ldb + n0 + bn);
            Bs2[bk][bn] = b2.x; Bs2[bk][bn + 1] = b2.y; Bs2[bk][bn + 2] = b2.z; Bs2[bk][bn + 3] = b2.w;
        }
        __syncthreads();
#pragma unroll
        for (int kk = 0; kk < 16; ++kk) {
            float ra[4], rb[4];
#pragma unroll
            for (int i = 0; i < 4; ++i) { ra[i] = As[kk][ty * 4 + i]; rb[i] = Bs[kk][tx * 4 + i]; }
#pragma unroll
            for (int i = 0; i < 4; ++i)
#pragma unroll
                for (int j = 0; j < 4; ++j) acc[i][j] += ra[i] * rb[j];
            if (MODE == MODE_MERGE) {
#pragma unroll
                for (int i = 0; i < 4; ++i) { ra[i] = As2[kk][ty * 4 + i]; rb[i] = Bs2[kk][tx * 4 + i]; }
#pragma unroll
                for (int i = 0; i < 4; ++i)
#pragma unroll
                    for (int j = 0; j < 4; ++j) acc2[i][j] += ra[i] * rb[j];
            }
        }
        __syncthreads();
    }
#pragma unroll
    for (int i = 0; i < 4; ++i)
#pragma unroll
        for (int j = 0; j < 4; ++j) ng_store<MODE>(a, m0 + ty * 4 + i, n0 + tx * 4 + j, acc[i][j], acc2[i][j]);
}

__global__ void __launch_bounds__(256) k_qknorm(unsigned char* ws, const float* qg, const float* kg) {
    const int gw = blockIdx.x * 4 + (threadIdx.x >> 6), lane = threadIdx.x & 63;
    const int t = gw / 10, h = gw % 10;
    const float v = ((const float*)(ws + WS_SQRAW))[(size_t)t * 640 + h * 64 + lane];
    const float rstd = rsqrtf(wave_sum(v * v) * (1.f / 64.f) + EPS);
    if (h < 8) ((bf16*)(ws + WS_SQ))[(size_t)t * 512 + h * 64 + lane] = (bf16)f2bf(v * rstd * qg[lane] * (0.125f * LOG2E));
    else ((bf16*)(ws + WS_SK))[(size_t)t * 128 + (h - 8) * 64 + lane] = (bf16)f2bf(v * rstd * kg[lane]);
}

__device__ __forceinline__ float ret_lg(int h) { return log1pf(-exp2f(-5.0f - (float)h)); }

__global__ void __launch_bounds__(256) k_ret_kv(unsigned char* ws) {
    const int bhn = blockIdx.x, n = bhn % NC, h = (bhn / NC) % RH, b = bhn / (NC * RH);
    const bf16* RK = (const bf16*)(ws + WS_RK); const bf16* RV = (const bf16*)(ws + WS_RV);
    float* KV = (float*)(ws + WS_KV) + (size_t)bhn * 128 * 128;
    const float lg = ret_lg(h);
    const size_t t0 = (size_t)b * SEQ + (size_t)n * RC;
    for (int o = threadIdx.x; o < 128 * 128; o += 256) {
        const int d = o >> 7, v = o & 127; float s = 0.f;
        for (int j = 0; j < 128; ++j) s += bf2f(RK[(t0 + j) * 512 + h * 128 + d]) * __expf((127.f - (float)j) * lg) * bf2f(RV[(t0 + j) * 512 + h * 128 + v]);
        KV[o] = s;
    }
}
__global__ void __launch_bounds__(256) k_ret_scan(unsigned char* ws) {
    const int gid = blockIdx.x * 256 + threadIdx.x;
    const int bh = gid >> 14, o = gid & 16383, d = o >> 7, v = o & 127, h = bh % RH;
    const float decay = __expf(128.f * ret_lg(h));
    const float* KV = (const float*)(ws + WS_KV); bf16* ST = (bf16*)(ws + WS_ST);
    float st = 0.f;
    for (int n = 0; n < NC; ++n) {
        const size_t bhn = (size_t)bh * NC + n;
        ST[bhn * 16384 + v * 128 + d] = (bf16)f2bf(st);
        st = decay * st + KV[bhn * 16384 + o];
    }
}
__global__ void __launch_bounds__(256) k_ret_out(unsigned char* ws, const float* gn_g, const float* gn_b) {
    extern __shared__ float sm[];
    float* sc = sm; float* yy = sm + 128 * 128;
    const int bhn = blockIdx.x, n = bhn % NC, h = (bhn / NC) % RH, b = bhn / (NC * RH);
    const bf16* RQ = (const bf16*)(ws + WS_RQ); const bf16* RK = (const bf16*)(ws + WS_RK); const bf16* RV = (const bf16*)(ws + WS_RV);
    const bf16* RG = (const bf16*)(ws + WS_RG); const bf16* ST = (const bf16*)(ws + WS_ST) + (size_t)bhn * 16384; bf16* AR = (bf16*)(ws + WS_AR);
    const float lg = ret_lg(h);
    const size_t t0 = (size_t)b * SEQ + (size_t)n * RC;
    for (int o = threadIdx.x; o < 128 * 128; o += 256) {
        const int i = o >> 7, j = o & 127; float s = 0.f;
        if (i >= j) { for (int d = 0; d < 128; ++d) s += bf2f(RQ[(t0 + i) * 512 + h * 128 + d]) * bf2f(RK[(t0 + j) * 512 + h * 128 + d]); s *= __expf((float)(i - j) * lg); }
        sc[o] = s;
    }
    __syncthreads();
    for (int o = threadIdx.x; o < 128 * 128; o += 256) {
        const int i = o >> 7, v = o & 127; float s = 0.f, c = 0.f;
        for (int j = 0; j <= i; ++j) s += sc[i * 128 + j] * bf2f(RV[(t0 + j) * 512 + h * 128 + v]);
        for (int d = 0; d < 128; ++d) c += bf2f(RQ[(t0 + i) * 512 + h * 128 + d]) * bf2f(ST[v * 128 + d]);
        yy[o] = s + c * __expf((float)(i + 1) * lg);
    }
    __syncthreads();
    if (threadIdx.x < 128) {
        const int i = threadIdx.x; float mu = 0.f;
        for (int v = 0; v < 128; ++v) mu += yy[i * 128 + ((v + i) & 127)];
        mu *= (1.f / 128.f); float var = 0.f;
        for (int v = 0; v < 128; ++v) { const float dd = yy[i * 128 + ((v + i) & 127)] - mu; var += dd * dd; }
        const float rstd = rsqrtf(var * (1.f / 128.f) + EPS);
        for (int v = 0; v < 128; ++v) { const int c = h * 128 + v; const float yn = (yy[i * 128 + v] - mu) * rstd * gn_g[c] + gn_b[c];
            AR[(t0 + i) * 512 + c] = (bf16)f2bf(bf2f(RG[(t0 + i) * 512 + c]) * yn); }
    }
}
__global__ void __launch_bounds__(256) k_swa(unsigned char* ws, const float* sinks) {
    const int gw = blockIdx.x * 4 + (threadIdx.x >> 6), lane = threadIdx.x & 63;
    const int t = gw >> 3, h = gw & 7, kvh = h >> 2, tpos = t & (SEQ - 1), tb = t - tpos;
    const bf16* SQ = (const bf16*)(ws + WS_SQ); const bf16* SK = (const bf16*)(ws + WS_SK); const bf16* SV = (const bf16*)(ws + WS_SV);
    const float q = bf2f(SQ[(size_t)t * 512 + h * 64 + lane]);
    const float slope2 = exp2f(-8.0f * (float)(h + 1) / 8.0f) * LOG2E;
    const float sink2 = sinks[h] * LOG2E;
    float m = sink2, l = 1.f, o = 0.f;
    const int lo = tpos - (WIN - 1) < 0 ? 0 : tpos - (WIN - 1);
    for (int kp = lo; kp <= tpos; ++kp) {
        const size_t tk = (size_t)(tb + kp);
        float s = wave_sum(q * bf2f(SK[tk * 128 + kvh * 64 + lane])) - slope2 * (float)(tpos - kp);
        const float mn = fmaxf(m, s), f = exp2f(m - mn), pp = exp2f(s - mn);
        l = l * f + pp; o = o * f + pp * bf2f(SV[tk * 128 + kvh * 64 + lane]); m = mn;
    }
    ((bf16*)(ws + WS_AS))[(size_t)t * 512 + h * 64 + lane] = (bf16)f2bf(o / l);
}
__global__ void __launch_bounds__(256) k_router(unsigned char* ws, const float* x1, const float* g, const float* wrg, const float* brg, const float* wre, const float* bre) {
    const int t = blockIdx.x * 4 + (threadIdx.x >> 6), lane = threadIdx.x & 63;
    float hv[16]; float ss = 0.f;
#pragma unroll
    for (int j = 0; j < 16; ++j) { hv[j] = x1[(size_t)t * D + j * 64 + lane]; ss += hv[j] * hv[j]; }
    const float rstd = rsqrtf(wave_sum(ss) * (1.f / D) + EPS);
#pragma unroll
    for (int j = 0; j < 16; ++j) hv[j] *= rstd * g[j * 64 + lane];
    float lgts[4], le[32];
#pragma unroll
    for (int o = 0; o < 4; ++o) { float s = 0.f;
#pragma unroll
        for (int j = 0; j < 16; ++j) s += hv[j] * wrg[(size_t)(j * 64 + lane) * 4 + o];
        lgts[o] = wave_sum(s) + brg[o]; }
#pragma unroll
    for (int o = 0; o < 32; ++o) { float s = 0.f;
#pragma unroll
        for (int j = 0; j < 16; ++j) s += hv[j] * wre[(size_t)(j * 64 + lane) * 32 + o];
        le[o] = wave_sum(s) + bre[o]; }
    float gm = lgts[0]; int gs = 0;
#pragma unroll
    for (int o = 1; o < 4; ++o) if (lgts[o] > gm) { gm = lgts[o]; gs = o; }
    float gden = 0.f;
#pragma unroll
    for (int o = 0; o < 4; ++o) gden += __expf(lgts[o] - gm);
    const float gw = 1.f / gden;
    float e8[8];
#pragma unroll
    for (int o = 0; o < 8; ++o) { e8[o] = gs == 0 ? le[o] : gs == 1 ? le[8 + o] : gs == 2 ? le[16 + o] : le[24 + o]; }
    float m1 = e8[0]; int i1 = 0;
#pragma unroll
    for (int o = 1; o < 8; ++o) if (e8[o] > m1) { m1 = e8[o]; i1 = o; }
    float m2 = -3.0e38f; int i2 = 0;
#pragma unroll
    for (int o = 0; o < 8; ++o) if (o != i1 && e8[o] > m2) { m2 = e8[o]; i2 = o; }
    const float p2 = __expf(m2 - m1), inv = 1.f / (1.f + p2);
    if (lane == 0) {
        ((float*)(ws + WS_RSTD1))[t] = rstd;
        ((int*)(ws + WS_SEL))[t * 2] = gs * 8 + i1; ((int*)(ws + WS_SEL))[t * 2 + 1] = gs * 8 + i2;
        ((float*)(ws + WS_CW))[t * 2] = gw * inv; ((float*)(ws + WS_CW))[t * 2 + 1] = gw * p2 * inv;
    }
}
__global__ void __launch_bounds__(256) k_moe_up(unsigned char* ws, const float* g, const float* wg, const float* wu) {
    const int tk = blockIdx.x, t = tk >> 1, f = threadIdx.x;
    const int e = ((const int*)(ws + WS_SEL))[tk]; const float cw = ((const float*)(ws + WS_CW))[tk], rstd = ((const float*)(ws + WS_RSTD1))[t];
    const bf16* xb = (const bf16*)(ws + WS_X1B) + (size_t)t * D;
    const float* Wg = wg + (size_t)e * D * FF; const float* Wu = wu + (size_t)e * D * FF;
    float a = 0.f, u = 0.f;
    for (int d = 0; d < D; ++d) { const float hv = bf2f(xb[d]) * g[d]; a += hv * Wg[(size_t)d * FF + f]; u += hv * Wu[(size_t)d * FF + f]; }
    a *= rstd; u *= rstd;
    ((bf16*)(ws + WS_HIDN))[(size_t)tk * FF + f] = (bf16)f2bf(a * sigmoidf_(a) * u * cw);
}
__global__ void __launch_bounds__(256) k_moe_down(unsigned char* ws, float* out, const float* wd) {
    const int t = blockIdx.x, c0 = threadIdx.x * 4;
    float4 acc = *(const float4*)(out + (size_t)t * D + c0);
    for (int k = 0; k < 2; ++k) {
        const int e = ((const int*)(ws + WS_SEL))[t * 2 + k]; const float* Wd = wd + (size_t)e * FF * D;
        const bf16* hid = (const bf16*)(ws + WS_HIDN) + (size_t)(t * 2 + k) * FF;
        for (int f = 0; f < FF; ++f) { const float hv = bf2f(hid[f]); const float4 w = *(const float4*)(Wd + (size_t)f * D + c0); acc.x += hv * w.x; acc.y += hv * w.y; acc.z += hv * w.z; acc.w += hv * w.w; }
    }
    *(float4*)(out + (size_t)t * D + c0) = acc;
}
__global__ void __launch_bounds__(256) k_x2_stats(unsigned char* ws, const float* x2) {
    const int row = blockIdx.x * 4 + (threadIdx.x >> 6), lane = threadIdx.x & 63;
    const float4* xr = (const float4*)(x2 + (size_t)row * D) + lane; float s = 0.f;
#pragma unroll
    for (int j = 0; j < 4; ++j) { const float4 v = xr[64 * j]; s += v.x * v.x + v.y * v.y + v.z * v.z + v.w * v.w;
        uint2 o; o.x = f2bf(v.x) | (f2bf(v.y) << 16); o.y = f2bf(v.z) | (f2bf(v.w) << 16); ((uint2*)((bf16*)(ws + WS_X2B) + (size_t)row * D))[lane + 64 * j] = o; }
    s = wave_sum(s);
    if (lane == 0) ((float*)(ws + WS_RSTD2))[row] = rsqrtf(s * (1.f / D) + EPS);
}
__global__ void __launch_bounds__(256) k_pp_stats(unsigned char* ws) {
    const int row = blockIdx.x * 4 + (threadIdx.x >> 6), lane = threadIdx.x & 63;
    const bf16* pr = (const bf16*)(ws + WS_PP) + (size_t)row * D; float s = 0.f;
#pragma unroll
    for (int j = 0; j < 16; ++j) { const float v = bf2f(pr[j * 64 + lane]); s += v * v; }
    s = wave_sum(s);
    if (lane == 0) ((float*)(ws + WS_RSTDP))[row] = rsqrtf(s * (1.f / D) + EPS);
}

extern "C" void kernel_launch(void* const* d_in, const int* in_sizes, int n_in, void* d_out, int out_size, void* d_ws, size_t ws_size, hipStream_t stream) {
    const float* x = (const float*)d_in[0]; const float* p = (const float*)d_in[1];
    const float* mix_g = (const float*)d_in[2]; const float* w_in = (const float*)d_in[3];
    const float* gn_g = (const float*)d_in[4]; const float* gn_b = (const float*)d_in[5]; const float* w_ret_o = (const float*)d_in[6];
    const float* qg = (const float*)d_in[7]; const float* kg = (const float*)d_in[8]; const float* sinks = (const float*)d_in[9];
    const float* w_swa_o = (const float*)d_in[10]; const float* w_out = (const float*)d_in[11]; const float* ffn_g = (const float*)d_in[12];
    const float* wrg = (const float*)d_in[13]; const float* brg = (const float*)d_in[14]; const float* wre = (const float*)d_in[15]; const float* bre = (const float*)d_in[16];
    const float* weg = (const float*)d_in[17]; const float* weu = (const float*)d_in[18]; const float* wed = (const float*)d_in[19];
    const float* pg_g = (const float*)d_in[20]; const float* w_pg = (const float*)d_in[21]; const float* w_ple = (const float*)d_in[22]; const float* ple_g = (const float*)d_in[23];
    unsigned char* ws = (unsigned char*)d_ws; float* out = (float*)d_out;
    static bool once = false;
    if (!once) { once = true; (void)hipFuncSetAttribute((const void*)k_ret_out, hipFuncAttributeMaxDynamicSharedMemorySize, 131072); }

    k_rmsnorm_bf16<<<T / 4, 256, 0, stream>>>(x, mix_g, (bf16*)(ws + WS_XN));
    { NG_Args a{}; a.A = ws + WS_XN; a.lda = D; a.a_is_f32 = 0; a.B = w_in; a.ldb = INW; a.M = T; a.N = INW; a.K = D; a.ws = ws;
      k_gemm_naive<MODE_Z><<<dim3(INW / 64, T / 64), 256, 0, stream>>>(a); }
    k_qknorm<<<T * 10 / 4, 256, 0, stream>>>(ws, qg, kg);
    k_ret_kv<<<BATCH * RH * NC, 256, 0, stream>>>(ws);
    k_ret_scan<<<16 * 16384 / 256, 256, 0, stream>>>(ws);
    k_swa<<<T * SH / 4, 256, 0, stream>>>(ws, sinks);
    k_ret_out<<<BATCH * RH * NC, 256, 131072, stream>>>(ws, gn_g, gn_b);
    { NG_Args a{}; a.A = ws + WS_AR; a.A2 = ws + WS_AS; a.lda = 512; a.B = w_ret_o; a.B2 = w_swa_o; a.ldb = D; a.M = T; a.N = D; a.K = 512; a.ws = ws;
      k_gemm_naive<MODE_MERGE><<<dim3(D / 64, T / 64), 256, 0, stream>>>(a); }
    { NG_Args a{}; a.A = ws + WS_MG; a.lda = D; a.B = w_out; a.ldb = D; a.M = T; a.N = D; a.K = D; a.ws = ws; a.x = x; a.out = out;
      k_gemm_naive<MODE_X1><<<dim3(D / 64, T / 64), 256, 0, stream>>>(a); }
    k_router<<<T / 4, 256, 0, stream>>>(ws, out, ffn_g, wrg, brg, wre, bre);
    k_moe_up<<<T * 2, 256, 0, stream>>>(ws, ffn_g, weg, weu);
    k_moe_down<<<T, 256, 0, stream>>>(ws, out, wed);
    k_x2_stats<<<T / 4, 256, 0, stream>>>(ws, out);
    { NG_Args a{}; a.A = p; a.lda = PLE; a.a_is_f32 = 1; a.B = w_ple; a.ldb = D; a.M = T; a.N = D; a.K = PLE; a.ws = ws;
      k_gemm_naive<MODE_PP><<<dim3(D / 64, T / 64), 256, 0, stream>>>(a); }
    k_pp_stats<<<T / 4, 256, 0, stream>>>(ws);
    { NG_Args a{}; a.A = ws + WS_X2B; a.lda = D; a.B = w_pg; a.ldb = D; a.kscale = pg_g; a.M = T; a.N = D; a.K = D; a.ws = ws; a.out = out; a.aux0 = ple_g;
      k_gemm_naive<MODE_FINAL><<<dim3(D / 64, T / 64), 256, 0, stream>>>(a); }
}
```

```cpp
#include <hip/hip_runtime.h>
#include <cstdio>
#include <cstdint>

constexpr int BATCH = 4, SEQ = 4096, T = BATCH * SEQ, D = 1024;
constexpr int PLE = 256;
constexpr float EPS = 1e-6f;
constexpr int RH = 4, RDK = 128, RC = 128, NC = SEQ / RC;
constexpr int SH = 8, SKV = 2, SG = 4, HD = 64, WIN = 128;
constexpr int NE = 32, EPG = 8, NG = 4, FF = 256;
constexpr int INW = 4864;
constexpr float LOG2E = 1.4426950408889634f;
constexpr float QSCALE = 0.125f * LOG2E;
constexpr float KSCALE = 0.08838834764831845f;

typedef unsigned short bf16;
__device__ __forceinline__ unsigned f2bf(float f) { unsigned u = __builtin_bit_cast(unsigned, f); return (u + 0x7fffu + ((u >> 16) & 1u)) >> 16; }
__device__ __forceinline__ unsigned pk2(float lo, float hi) { return f2bf(lo) | (f2bf(hi) << 16); }
__device__ __forceinline__ float bf2f(bf16 h) { return __builtin_bit_cast(float, (unsigned)h << 16); }
__device__ __forceinline__ float wave_sum(float v) {
#pragma unroll
    for (int o = 1; o < 64; o <<= 1) v += __shfl_xor(v, o);
    return v;
}
__device__ __forceinline__ float sigmoidf_(float x) { return __builtin_amdgcn_rcpf(1.f + __expf(-x)); }

constexpr size_t MiB = 1u << 20;
constexpr size_t WS_CTL = 0, CTL_ZERO_BYTES = 1 * MiB;
constexpr size_t WS_WIN = 1 * MiB;
constexpr size_t WS_WRO = 11 * MiB;
constexpr size_t WS_WSO = 12 * MiB;
constexpr size_t WS_WOUT = 13 * MiB;
constexpr size_t WS_WPG = 15 * MiB;
constexpr size_t WS_WPLE = 17 * MiB;
constexpr size_t WS_XN = 18 * MiB;
constexpr size_t WS_KV = 18 * MiB;
constexpr size_t WS_MG = 18 * MiB;
constexpr size_t WS_X2B = 18 * MiB;
constexpr size_t WS_RQ = 50 * MiB, WS_RK = 66 * MiB, WS_RV = 82 * MiB, WS_RG = 98 * MiB;
constexpr size_t WS_SQ = 114 * MiB;
constexpr size_t WS_SK = 130 * MiB, WS_SV = 134 * MiB;
constexpr size_t WS_GR = 138 * MiB, WS_GS = 170 * MiB;
constexpr size_t WS_ST = 202 * MiB;
constexpr size_t WS_AS = 218 * MiB, WS_AR = 234 * MiB;
constexpr size_t WS_MISC = 250 * MiB;
constexpr size_t WS_RSTD1 = WS_MISC, WS_RSTD2 = WS_MISC + 65536, WS_RSTDP = WS_MISC + 2 * 65536;
constexpr size_t WS_SEL = WS_MISC + 3 * 65536;
constexpr size_t WS_CW = WS_SEL + 131072;
constexpr size_t WS_X1B = 50 * MiB;
constexpr size_t WS_HIDN = 130 * MiB;
constexpr size_t WS_PP = 216 * MiB;
constexpr size_t WS_END = 256 * MiB;
constexpr int CW_BAR = 4096;

namespace pg8 {
#define PG8_LAS __attribute__((address_space(3)))
typedef unsigned short bf16_t;
typedef short bf16x8 __attribute__((ext_vector_type(8)));
typedef float f32x4 __attribute__((ext_vector_type(4)));
typedef unsigned u32x4 __attribute__((ext_vector_type(4)));
constexpr int BM = 256, BK = 64, HALF = 128, HTB = HALF * BK * 2  , STAGE_BYTES = 8 * HTB, NXCD = 8, WGM = 8;

__host__ __device__ __forceinline__ int lds_byte(int r, int c) { const int st = (r >> 4) * 2 + (c >> 5), rr = r & 15, cc = c & 31, ob = rr * 64 + cc * 2; return st * 1024 + (ob ^ (((ob >> 9) & 1) << 5)); }
__host__ __device__ __forceinline__ void stage_rc(int b, int& R, int& C) { const int st = b / 1024, sb = b % 1024, swz = sb ^ (((sb >> 9) & 1) << 5); R = (st >> 1) * 16 + swz / 64; C = (st & 1) * 32 + (swz % 64) / 2; }
__host__ __device__ __forceinline__ int perm32(int rho) { const int n = rho >> 4, i = rho & 15; return 8 * (i >> 2) + 4 * n + (i & 3); }
struct Unit { int pm, pn; const char* a; const char* b; };

struct TileOrder {
    int nM, nN, nwg, G, c; const char* A; const char* Bt; size_t tstep;
    __device__ void init(const void* A_, const void* Bt_, int M, int N, int K, int G_, int c_) { nM = M / BM; nN = N / BM; nwg = nM * nN; G = G_; c = c_; A = (const char*)A_; Bt = (const char*)Bt_; tstep = (size_t)BM * K * 2; }
    __device__ bool next(int i, Unit& u) const {
        const long L = (long)i * G + c; if (L >= nwg) return false;
        int wgid = (int)L; { const int q = nwg / NXCD, r = nwg % NXCD, xcd = wgid % NXCD, off = wgid / NXCD; wgid = (xcd < r ? xcd * (q + 1) : r * (q + 1) + (xcd - r) * q) + off; }
        const int nig = WGM * nN, gid = wgid / nig, fm = gid * WGM, gsz = (nM - fm) < WGM ? (nM - fm) : WGM;
        u.pm = fm + ((wgid % nig) % gsz); u.pn = (wgid % nig) / gsz; u.a = A + (size_t)u.pm * tstep; u.b = Bt + (size_t)u.pn * tstep; return true;
    }
    __device__ __forceinline__ void a_ready(const Unit&) const {}
    __device__ __forceinline__ void done(const Unit&) const {}
};

__device__ __forceinline__ unsigned cvt_pk_bf16(float lo, float hi) { unsigned r; asm volatile("v_cvt_pk_bf16_f32 %0, %1, %2" : "=v"(r) : "v"(lo), "v"(hi)); return r; }
__device__ __forceinline__ u32x4 pack8(const f32x4 v0, const f32x4 v1) { u32x4 w; w.x = cvt_pk_bf16(v0[0], v0[1]); w.y = cvt_pk_bf16(v0[2], v0[3]); w.z = cvt_pk_bf16(v1[0], v1[1]); w.w = cvt_pk_bf16(v1[2], v1[3]); return w; }
__device__ __forceinline__ float sigm(float x) { return __builtin_amdgcn_rcpf(1.f + __expf(-x)); }

struct EpiZ {
    static constexpr bool PERM = true, AFTER_DRAIN = false;
    unsigned char* ws; const float* qg; const float* kg;
    __device__ __forceinline__ void operator()(const f32x4 (&acc)[2][2][4][2], const Unit& u, int wr, int wc, int fr, int fq) const {
        const int pn = u.pn; const int row0 = u.pm * BM + wr * 64 + fr;
        if (pn < 8 || pn >= 11) {
            int kind, ld, colt; bf16_t* base;
            if (pn < 8) { kind = pn >> 1; base = (bf16_t*)(ws + WS_RQ + (size_t)kind * (16 * MiB)); ld = 512; colt = (pn & 1) * 256; }
            else { const int g = pn - 11; kind = 4; base = (bf16_t*)(ws + WS_GR + (size_t)(g >> 2) * (32 * MiB)); ld = 1024; colt = (g & 3) * 256; }
            const int col0 = colt + wc * 32 + 8 * fq;
#pragma unroll
            for (int ai = 0; ai < 2; ++ai)
#pragma unroll
                for (int m = 0; m < 4; ++m) { bf16_t* rowp = base + (size_t)(row0 + ai * HALF + m * 16) * ld + col0;
#pragma unroll
                    for (int bj = 0; bj < 2; ++bj) { f32x4 v0 = acc[ai][bj][m][0], v1 = acc[ai][bj][m][1];
                        if (kind == 1) { v0 = v0 * KSCALE; v1 = v1 * KSCALE; }
                        else if (kind == 3) {
#pragma unroll
                            for (int j = 0; j < 4; ++j) { v0[j] = v0[j] * sigm(v0[j]); v1[j] = v1[j] * sigm(v1[j]); } }
                        else if (kind == 4) {
#pragma unroll
                            for (int j = 0; j < 4; ++j) { v0[j] = sigm(v0[j]); v1[j] = sigm(v1[j]); } }
                        *(u32x4*)(rowp + bj * HALF) = pack8(v0, v1); } }
        } else {
            const bool isq = pn < 10, isk = (pn == 10) && (wc < 2);
            f32x4 gv[2][2];
#pragma unroll
            for (int bj = 0; bj < 2; ++bj)
#pragma unroll
                for (int n = 0; n < 2; ++n) { const int dd = 32 * bj + 8 * fq + 4 * n;
                    gv[bj][n] = isq ? *(const f32x4*)(qg + dd) * QSCALE : isk ? *(const f32x4*)(kg + dd) : (f32x4){1.f, 1.f, 1.f, 1.f}; }
            bf16_t* base; int ld;
            if (isq) { base = (bf16_t*)(ws + WS_SQ) + (pn - 8) * 256 + 64 * wc + 8 * fq; ld = 512; }
            else if (isk) { base = (bf16_t*)(ws + WS_SK) + 64 * wc + 8 * fq; ld = 128; }
            else { base = (bf16_t*)(ws + WS_SV) + 64 * (wc - 2) + 8 * fq; ld = 128; }
#pragma unroll
            for (int ai = 0; ai < 2; ++ai)
#pragma unroll
                for (int m = 0; m < 4; ++m) {
                    float ss = 0.f;
#pragma unroll
                    for (int bj = 0; bj < 2; ++bj)
#pragma unroll
                        for (int n = 0; n < 2; ++n) { const f32x4 x = acc[ai][bj][m][n]; ss += (x[0] * x[0] + x[1] * x[1]) + (x[2] * x[2] + x[3] * x[3]); }
                    ss += __shfl_xor(ss, 16); ss += __shfl_xor(ss, 32);
                    const float rstd = (isq || isk) ? rsqrtf(ss * (1.f / 64.f) + EPS) : 1.f;
                    bf16_t* rowp = base + (size_t)(row0 + ai * HALF + m * 16) * ld;
#pragma unroll
                    for (int bj = 0; bj < 2; ++bj) *(u32x4*)(rowp + 32 * bj) = pack8(acc[ai][bj][m][0] * rstd * gv[bj][0], acc[ai][bj][m][1] * rstd * gv[bj][1]); }
        }
    }
};

template <class Epi, class Sched, bool ALIGN_EPI = false, bool SP2 = false>
__device__ __forceinline__ void gemm_phase(PG8_LAS unsigned char* lds, const int K, const Sched& S, const Epi& E) {
    const int tid = threadIdx.x, wid = __builtin_amdgcn_readfirstlane(tid >> 6), lane = tid & 63, wr = wid >> 2, wc = wid & 3, fr = lane & 15, fq = lane >> 4;
    const int nt = K / BK;
    unsigned voffA[2], voffB[2];
#pragma unroll
    for (int i = 0; i < 2; ++i) { int R, C; stage_rc(tid * 16 + i * 8192, R, C); const int Rb = Epi::PERM ? ((R & ~31) + perm32(R & 31)) : R;
        voffA[i] = (unsigned)(R * K + C) * 2u; voffB[i] = (unsigned)(Rb * K + C) * 2u; }
    const size_t kstep = (size_t)(BK * 2);
    const size_t hstep = (size_t)HALF * K * 2;
    const unsigned ldsw = (unsigned)wid * 1024u;
    const int aoff = lds_byte(wr * 64 + fr, fq * 8), boff = lds_byte(wc * 32 + fr, fq * 8);
#define PG8_SA(b, h) (((b) * 2 + (h)) * HTB)
#define PG8_SB(b, h) ((4 + (b) * 2 + (h)) * HTB)
#define PG8_STAGE(bufoff, gbase, voff) do { _Pragma("unroll") for (int _i = 0; _i < 2; ++_i) \
        __builtin_amdgcn_global_load_lds((const unsigned*)((const char*)(gbase) + (voff)[_i]), (PG8_LAS unsigned*)(lds + (bufoff) + ldsw + _i * 8192), 16, 0, 0); } while (0)
#define PG8_LDA(dst, b, h) do { _Pragma("unroll") for (int m = 0; m < 4; ++m) _Pragma("unroll") for (int k = 0; k < 2; ++k) dst[m][k] = *(const PG8_LAS bf16x8*)(lds + PG8_SA(b, h) + aoff + m * 2048 + k * 1024); } while (0)
#define PG8_LDB(dst, b, h) do { _Pragma("unroll") for (int n = 0; n < 2; ++n) _Pragma("unroll") for (int k = 0; k < 2; ++k) dst[n][k] = *(const PG8_LAS bf16x8*)(lds + PG8_SB(b, h) + boff + n * 2048 + k * 1024); } while (0)
#define PG8_MMA(ai, bj, At, Bt) do { __builtin_amdgcn_s_setprio(1); _Pragma("unroll") for (int m = 0; m < 4; ++m) _Pragma("unroll") for (int n = 0; n < 2; ++n) _Pragma("unroll") for (int k = 0; k < 2; ++k) \
        acc[ai][bj][m][n] = __builtin_amdgcn_mfma_f32_16x16x32_bf16(Bt[n][k], At[m][k], acc[ai][bj][m][n], 0, 0, 0); __builtin_amdgcn_s_setprio(0); } while (0)
#define PG8_WAIT_V(n) asm volatile("s_waitcnt vmcnt(" #n ")" ::: "memory")
#define PG8_WAIT_L(n) asm volatile("s_waitcnt lgkmcnt(" #n ")" ::: "memory")
#define PG8_BAR __builtin_amdgcn_s_barrier()
#define PG8_SCHED __builtin_amdgcn_sched_barrier(0)
    Unit cur, nxt; int ui = 0;
    if (!S.next(0, cur)) return;
    f32x4 acc[2][2][4][2];
#pragma unroll
    for (int a = 0; a < 2; ++a)
#pragma unroll
        for (int b = 0; b < 2; ++b)
#pragma unroll
            for (int m = 0; m < 4; ++m)
#pragma unroll
                for (int n = 0; n < 2; ++n) acc[a][b][m][n] = (f32x4){0.f, 0.f, 0.f, 0.f};
    bf16x8 At[4][2], B0[2][2], B1[2][2];
    const char* cA = cur.a; const char* cB = cur.b;
    S.a_ready(cur);
    if constexpr (SP2) {
        PG8_STAGE(PG8_SB(0, 0), cB, voffB); PG8_STAGE(PG8_SB(0, 1), cB + hstep, voffB); PG8_STAGE(PG8_SA(0, 0), cA, voffA); PG8_STAGE(PG8_SA(0, 1), cA + hstep, voffA);
        if (wr == 1) PG8_BAR;
        PG8_WAIT_V(2); PG8_BAR;
        PG8_STAGE(PG8_SB(1, 0), cB + kstep, voffB); PG8_STAGE(PG8_SA(1, 0), cA + kstep, voffA); PG8_STAGE(PG8_SB(1, 1), cB + hstep + kstep, voffB);
        PG8_WAIT_V(6); PG8_BAR;
    } else {
        PG8_STAGE(PG8_SB(0, 0), cB, voffB); PG8_STAGE(PG8_SA(0, 0), cA, voffA); PG8_STAGE(PG8_SB(0, 1), cB + hstep, voffB); PG8_STAGE(PG8_SA(0, 1), cA + hstep, voffA);
        if (wr == 1) PG8_BAR;
        PG8_WAIT_V(4); PG8_BAR;
        PG8_STAGE(PG8_SB(1, 0), cB + kstep, voffB); PG8_STAGE(PG8_SA(1, 0), cA + kstep, voffA); PG8_STAGE(PG8_SB(1, 1), cB + hstep + kstep, voffB);
        PG8_WAIT_V(6); PG8_BAR;
    }
    for (;;) {
        const bool has_next = S.next(ui + 1, nxt);
        const char* nA = has_next ? nxt.a : cA; const char* nB = has_next ? nxt.b : cB;
        for (int t = 0; t < nt; t += 2) {
            const bool last = (t == nt - 2);
            const char* a1 = cA + (size_t)(t + 1) * kstep;
            const char* a2 = last ? nA : cA + (size_t)(t + 2) * kstep; const char* b2 = last ? nB : cB + (size_t)(t + 2) * kstep;
            const char* a3 = a2 + kstep; const char* b3 = b2 + kstep;
            if (last && has_next) S.a_ready(nxt);
            if constexpr (SP2) {
            PG8_LDB(B0, 0, 0); PG8_LDB(B1, 0, 1); PG8_SCHED; PG8_LDA(At, 0, 0); PG8_STAGE(PG8_SA(1, 1), a1 + hstep, voffA);
            PG8_WAIT_V(8); PG8_WAIT_L(0); PG8_BAR; PG8_MMA(0, 0, At, B0); PG8_MMA(0, 1, At, B1); PG8_BAR; PG8_SCHED;
            PG8_LDA(At, 0, 1); PG8_STAGE(PG8_SB(0, 0), b2, voffB); PG8_STAGE(PG8_SB(0, 1), b2 + hstep, voffB); PG8_STAGE(PG8_SA(0, 0), a2, voffA);
            PG8_WAIT_V(8); PG8_WAIT_L(0); PG8_BAR; PG8_MMA(1, 0, At, B0); PG8_MMA(1, 1, At, B1); PG8_BAR; PG8_SCHED;
            PG8_LDB(B0, 1, 0); PG8_LDB(B1, 1, 1); PG8_SCHED; PG8_LDA(At, 1, 0); PG8_STAGE(PG8_SA(0, 1), a2 + hstep, voffA);
            PG8_WAIT_V(8); PG8_WAIT_L(0); PG8_BAR; PG8_MMA(0, 0, At, B0); PG8_MMA(0, 1, At, B1); PG8_BAR; PG8_SCHED;
            PG8_LDA(At, 1, 1); PG8_STAGE(PG8_SB(1, 0), b3, voffB); PG8_STAGE(PG8_SB(1, 1), b3 + hstep, voffB); PG8_STAGE(PG8_SA(1, 0), a3, voffA);
            PG8_WAIT_V(8); PG8_WAIT_L(0); PG8_BAR; PG8_MMA(1, 0, At, B0); PG8_MMA(1, 1, At, B1); PG8_BAR; PG8_SCHED;
            } else {
            PG8_LDB(B0, 0, 0); PG8_SCHED; PG8_LDA(At, 0, 0); PG8_STAGE(PG8_SA(1, 1), a1 + hstep, voffA);
            PG8_WAIT_L(8); PG8_BAR; PG8_WAIT_L(0); PG8_MMA(0, 0, At, B0); PG8_BAR; PG8_SCHED;
            PG8_LDB(B1, 0, 1); PG8_STAGE(PG8_SB(0, 0), b2, voffB);
            PG8_BAR; PG8_WAIT_L(0); PG8_MMA(0, 1, At, B1); PG8_BAR;
            PG8_LDA(At, 0, 1); PG8_STAGE(PG8_SA(0, 0), a2, voffA);
            PG8_BAR; PG8_WAIT_L(0); PG8_MMA(1, 0, At, B0); PG8_BAR; PG8_SCHED;
            PG8_STAGE(PG8_SB(0, 1), b2 + hstep, voffB);
            PG8_WAIT_V(6); PG8_BAR; PG8_MMA(1, 1, At, B1); PG8_BAR;
            PG8_LDB(B0, 1, 0); PG8_SCHED; PG8_LDA(At, 1, 0); PG8_STAGE(PG8_SA(0, 1), a2 + hstep, voffA);
            PG8_WAIT_L(8); PG8_BAR; PG8_WAIT_L(0); PG8_MMA(0, 0, At, B0); PG8_BAR; PG8_SCHED;
            PG8_LDB(B1, 1, 1); PG8_STAGE(PG8_SB(1, 0), b3, voffB);
            PG8_BAR; PG8_WAIT_L(0); PG8_MMA(0, 1, At, B1); PG8_BAR;
            PG8_LDA(At, 1, 1); PG8_STAGE(PG8_SA(1, 0), a3, voffA);
            PG8_BAR; PG8_WAIT_L(0); PG8_MMA(1, 0, At, B0); PG8_BAR; PG8_SCHED;
            PG8_STAGE(PG8_SB(1, 1), b3 + hstep, voffB);
            PG8_WAIT_V(6); PG8_BAR; PG8_MMA(1, 1, At, B1); PG8_BAR;
            }
        }
        if constexpr (ALIGN_EPI) { if (wr == 0) PG8_BAR; }
        if constexpr (!Epi::AFTER_DRAIN) { E(acc, cur, wr, wc, fr, fq); S.done(cur); }
        if (!has_next) break;
#pragma unroll
        for (int a = 0; a < 2; ++a)
#pragma unroll
            for (int b = 0; b < 2; ++b)
#pragma unroll
                for (int m = 0; m < 4; ++m)
#pragma unroll
                    for (int n = 0; n < 2; ++n) acc[a][b][m][n] = (f32x4){0.f, 0.f, 0.f, 0.f};
        cur = nxt; cA = nA; cB = nB; ++ui;
        if constexpr (ALIGN_EPI) { if (wr == 1) PG8_BAR; }
    }
    PG8_WAIT_V(0);
    if constexpr (!ALIGN_EPI) { if (wr == 0) PG8_BAR; }
    PG8_BAR;
    if constexpr (Epi::AFTER_DRAIN) { E.fused(acc, cur, wr, wc, fr, fq, lds, wid, lane); S.done(cur); }
#undef PG8_SA
#undef PG8_SB
#undef PG8_STAGE
#undef PG8_LDA
#undef PG8_LDB
#undef PG8_MMA
#undef PG8_WAIT_V
#undef PG8_WAIT_L
#undef PG8_BAR
#undef PG8_SCHED
}
}
#define GAS __attribute__((address_space(1)))
#define LAS __attribute__((address_space(3)))
typedef unsigned v4u __attribute__((ext_vector_type(4)));
typedef float f32x4 __attribute__((ext_vector_type(4)));
typedef short bf16x8 __attribute__((ext_vector_type(8)));
typedef GAS unsigned gu32;
typedef GAS unsigned long long gu64;
#define RLX_AGENT __ATOMIC_RELAXED, __HIP_MEMORY_SCOPE_AGENT
#define LDS_WAIT() asm volatile("s_waitcnt lgkmcnt(0)" ::: "memory")
#define VM_WAIT() asm volatile("s_waitcnt vmcnt(0)" ::: "memory")
__device__ __forceinline__ unsigned long long rt() { return __builtin_amdgcn_s_memrealtime(); }


#define XB_TMO      128
#define XB_XCNT(j)  (256  + 64 * (j))
#define XB_XSUB(j)  (1280 + 64 * (j))
#define XB_XGEN(j)  (2304 + 64 * (j))
#define XB_TOP      3328
#define XB_TOPGEN   3392
#define XCD_BAR_WORDS 3456
#define XB_SPIN_CAP (1u << 18)

__device__ __forceinline__ unsigned xb_ld(unsigned* p)              { return __hip_atomic_load(p, __ATOMIC_RELAXED, __HIP_MEMORY_SCOPE_AGENT); }
__device__ __forceinline__ unsigned xb_add(unsigned* p, unsigned v) { return __hip_atomic_fetch_add(p, v, __ATOMIC_RELAXED, __HIP_MEMORY_SCOPE_AGENT); }
__device__ __forceinline__ unsigned xb_xcc_id() { return (unsigned)__builtin_amdgcn_s_getreg((3 << 11) | 20) & 0xFu; }
#define XB_SPIN(cond, bar) do { unsigned _sp = 0; while (cond) { __builtin_amdgcn_s_sleep(1); \
    if ((++_sp & 255u) == 0u) { if (xb_ld(&(bar)[XB_TMO])) break; if (_sp > XB_SPIN_CAP) { atomicAdd(&(bar)[XB_TMO], 1u); break; } } } } while (0)

struct XcdBarrier {
    unsigned* bar; unsigned x;
    volatile LAS unsigned* st;
};

__device__ __forceinline__ XcdBarrier xcd_barrier_post(unsigned* bar, volatile LAS unsigned* st) {
    XcdBarrier b; b.bar = bar; b.x = xb_xcc_id(); b.st = st;
    if (threadIdx.x == 0) (void)xb_add(&bar[XB_XCNT(b.x)], 1u);
    return b;
}
__device__ __forceinline__ void xcd_barrier_complete(unsigned* bar, unsigned x, unsigned& nloc, unsigned& nx) {
    const unsigned G = gridDim.x * gridDim.y * gridDim.z;
    unsigned sum, cnt, mine, sp = 0u;
    for (;;) {
        sum = 0u; cnt = 0u; mine = 0u;
#pragma unroll
        for (unsigned j = 0; j < 16; ++j) { const unsigned c = xb_ld(&bar[XB_XCNT(j)]); sum += c; cnt += (c > 0u) ? 1u : 0u; mine = (j == x) ? c : mine; }
        if (sum == G) break;
        __builtin_amdgcn_s_sleep(1);
        if ((++sp & 255u) == 0u) { if (xb_ld(&bar[XB_TMO])) break; if (sp > XB_SPIN_CAP) { atomicAdd(&bar[XB_TMO], 1u); break; } }
    }
    nloc = mine > 0u ? mine : 1u; nx = cnt > 0u ? cnt : 1u;
}

__device__ __forceinline__ void xcd_barrier(const XcdBarrier& b) {
    asm volatile("s_waitcnt vmcnt(0)" ::: "memory");
    __syncthreads();
    if (threadIdx.x == 0) {
        unsigned* bar = b.bar;
        __builtin_amdgcn_s_waitcnt(0);
        unsigned nloc = b.st[0], nx = b.st[1];
        if (nloc == 0u) { xcd_barrier_complete(bar, b.x, nloc, nx); b.st[0] = nloc; b.st[1] = nx; }
        const unsigned old = xb_add(&bar[XB_XSUB(b.x)], 1u);
        const unsigned gen = old / nloc;
        if (old + 1u == (gen + 1u) * nloc) {
            __builtin_amdgcn_fence(__ATOMIC_RELEASE, "agent");
            asm volatile("s_waitcnt vmcnt(0)" ::: "memory");
            const unsigned og = xb_add(&bar[XB_TOP], 1u);
            const unsigned tg = og / nx;
            if (og + 1u == (tg + 1u) * nx) xb_add(&bar[XB_TOPGEN], 1u);
            else XB_SPIN(xb_ld(&bar[XB_TOPGEN]) == tg, bar);
            __builtin_amdgcn_fence(__ATOMIC_ACQUIRE, "agent");
            xb_add(&bar[XB_XGEN(b.x)], 1u);
            asm volatile("s_waitcnt vmcnt(0)" ::: "memory");
        } else {
            XB_SPIN(xb_ld(&bar[XB_XGEN(b.x)]) == gen, bar);
            __builtin_amdgcn_fence(__ATOMIC_ACQUIRE, "agent");
            asm volatile("s_waitcnt vmcnt(0)" ::: "memory");
        }
    }
    __syncthreads();
}
constexpr int NWAVES = 8;
constexpr int RING_OFF = 0, RING_BYTES = 131072;
constexpr int LDSCTL_OFF = RING_BYTES, MISC_OFF = LDSCTL_OFF + 320;
constexpr int LDS_BYTES = 147456;

__device__ __forceinline__ void p0_transpose_item(const float* W, int ldw, int k0, int ns0, bf16* WT, int ldt, int nd0, const float* ks, LAS float* scr, int lane) {
#pragma unroll 8
    for (int i = 0; i < 32; ++i) { const int kk = 2 * i + (lane >> 5); scr[kk * 33 + (lane & 31)] = W[(size_t)(k0 + kk) * ldw + ns0 + (lane & 31)]; }
    LDS_WAIT(); asm volatile("" ::: "memory");
    const int c = lane & 7;
    float sc[8];
#pragma unroll
    for (int i = 0; i < 8; ++i) sc[i] = ks ? ks[k0 + 8 * c + i] : 1.f;
#pragma unroll
    for (int j = 0; j < 4; ++j) { const int n = (lane >> 3) + 8 * j; const LAS float* s = scr + (8 * c) * 33 + n;
        v4u o; o.x = pk2(s[0 * 33] * sc[0], s[1 * 33] * sc[1]); o.y = pk2(s[2 * 33] * sc[2], s[3 * 33] * sc[3]); o.z = pk2(s[4 * 33] * sc[4], s[5 * 33] * sc[5]); o.w = pk2(s[6 * 33] * sc[6], s[7 * 33] * sc[7]);
        *(GAS v4u*)(WT + (size_t)(nd0 + n) * ldt + k0 + 8 * c) = o; }
    LDS_WAIT(); asm volatile("" ::: "memory");
}
__device__ __forceinline__ void rms_row_to_bf16(const float* xrow, const float* g, bf16* orow, int lane) {
    const GAS f32x4* xr = (const GAS f32x4*)xrow + lane;
    f32x4 v[4]; float s = 0.f;
#pragma unroll
    for (int j = 0; j < 4; ++j) { v[j] = xr[64 * j]; s += (v[j].x * v[j].x + v[j].y * v[j].y) + (v[j].z * v[j].z + v[j].w * v[j].w); }
    const float rstd = rsqrtf(wave_sum(s) * (1.f / D) + EPS);
    GAS unsigned long long* o8 = (GAS unsigned long long*)orow + lane;
#pragma unroll
    for (int j = 0; j < 4; ++j) { const f32x4 gg = ((const GAS f32x4*)g)[lane + 64 * j];
        o8[64 * j] = (unsigned long long)pk2(v[j].x * rstd * gg.x, v[j].y * rstd * gg.y) | ((unsigned long long)pk2(v[j].z * rstd * gg.z, v[j].w * rstd * gg.w) << 32); }
}

struct Args { const float* in[24]; float* out; unsigned char* ws; int ph_lo, ph_hi; };
enum { I_X = 0, I_P, I_MIXG, I_WIN, I_GNG, I_GNB, I_WRO, I_QG, I_KG, I_SINK, I_WSO, I_WOUT, I_FFNG, I_WRG, I_BRG, I_WRE, I_BRE, I_WEG, I_WEU, I_WED, I_PGG, I_WPG, I_WPLE, I_PLEG };

__device__ __forceinline__ void p0_prologue(const Args& A, LAS unsigned char* lds, int vcu, int G, int wave, int lane) {
    LAS float* scr = (LAS float*)(lds + RING_OFF + wave * 16384);
    unsigned char* ws = A.ws;
    const int gw = vcu * NWAVES + wave, NGW = G * NWAVES;
    constexpr int I_IN = 16 * 152, I_RO = 8 * 32, I_SO = 8 * 32, I_OUT = 16 * 32, I_PG = 16 * 32, I_PL = 4 * 32;
    constexpr int NITEMS = I_IN + I_RO + I_SO + I_OUT + I_PG + I_PL;
    for (int it = gw; it < NITEMS; it += NGW) {
        int r = it;
        if (r < I_IN) { const int kb = r / 152, nb = r % 152, pn = nb >> 3, q = nb & 7; int ns0 = 32 * nb;
            if (pn >= 8 && pn <= 10) ns0 = 256 * pn + 32 * (((q & 3) << 1) | (q >> 2));
            p0_transpose_item(A.in[I_WIN], INW, 64 * kb, ns0, (bf16*)(ws + WS_WIN), D, 32 * nb, nullptr, scr, lane); continue; } r -= I_IN;
        if (r < I_RO) { p0_transpose_item(A.in[I_WRO], D, 64 * (r / 32), 32 * (r % 32), (bf16*)(ws + WS_WRO), 512, 32 * (r % 32), nullptr, scr, lane); continue; } r -= I_RO;
        if (r < I_SO) { p0_transpose_item(A.in[I_WSO], D, 64 * (r / 32), 32 * (r % 32), (bf16*)(ws + WS_WSO), 512, 32 * (r % 32), nullptr, scr, lane); continue; } r -= I_SO;
        if (r < I_OUT) { p0_transpose_item(A.in[I_WOUT], D, 64 * (r / 32), 32 * (r % 32), (bf16*)(ws + WS_WOUT), D, 32 * (r % 32), nullptr, scr, lane); continue; } r -= I_OUT;
        if (r < I_PG) { p0_transpose_item(A.in[I_WPG], D, 64 * (r / 32), 32 * (r % 32), (bf16*)(ws + WS_WPG), D, 32 * (r % 32), A.in[I_PGG], scr, lane); continue; } r -= I_PG;
        p0_transpose_item(A.in[I_WPLE], D, 64 * (r / 32), 32 * (r % 32), (bf16*)(ws + WS_WPLE), PLE, 32 * (r % 32), nullptr, scr, lane);
    }
    for (int m = gw; m < T; m += NGW) rms_row_to_bf16(A.in[I_X] + (size_t)m * D, A.in[I_MIXG], (bf16*)(ws + WS_XN) + (size_t)m * D, lane);
}

constexpr int N_PHASES = 2;
__global__ void __launch_bounds__(NWAVES * 64, 2) mk_fwd(Args args) {
    extern __shared__ __attribute__((aligned(16))) unsigned char lds_raw[];
    LAS unsigned char* lds = (LAS unsigned char*)lds_raw;
    volatile LAS unsigned* MISC = (volatile LAS unsigned*)(lds + MISC_OFF);
    const int tid = threadIdx.x, lane = tid & 63, wave = __builtin_amdgcn_readfirstlane(tid >> 6);
    const int G = gridDim.x; const int bx = blockIdx.x; const int vcu = (G % 8 == 0) ? (bx % 8) * (G / 8) + bx / 8 : bx;
    unsigned char* ws = args.ws;
    gu32* ctl = (gu32*)(ws + WS_CTL);
    for (int u = tid; u < (LDS_BYTES - LDSCTL_OFF) / 4; u += NWAVES * 64) ((LAS unsigned*)(lds + LDSCTL_OFF))[u] = 0u;
    __syncthreads();
    XcdBarrier bar = xcd_barrier_post((unsigned*)(ctl + CW_BAR), MISC + 8);
    const int lo = args.ph_lo, hi = args.ph_hi;
#define IN(k) (lo <= (k) && (k) < hi)
#define BOTH(k) (IN(k) && IN((k) + 1))
#define GRID_BAR() xcd_barrier(bar)

    if (IN(0)) { p0_prologue(args, lds, vcu, G, wave, lane); if (BOTH(0)) GRID_BAR(); }

    if (IN(1)) {
        pg8::TileOrder S; S.init(ws + WS_XN, ws + WS_WIN, T, INW, D, G, bx);
        pg8::EpiZ E{ws, args.in[I_QG], args.in[I_KG]};
        pg8::gemm_phase<pg8::EpiZ, pg8::TileOrder, true, true>(lds + RING_OFF, D, S, E);
        if (BOTH(1)) GRID_BAR();
    }
#undef IN
#undef BOTH
#undef GRID_BAR
}

__global__ void __launch_bounds__(256) k_rmsnorm_bf16(const float* x, const float* g, bf16* out) {
    const int row = blockIdx.x * 4 + (threadIdx.x >> 6), lane = threadIdx.x & 63;
    const float4* xr = (const float4*)(x + (size_t)row * D) + lane;
    float4 v[4]; float s = 0.f;
#pragma unroll
    for (int j = 0; j < 4; ++j) { v[j] = xr[64 * j]; s += v[j].x * v[j].x + v[j].y * v[j].y + v[j].z * v[j].z + v[j].w * v[j].w; }
    const float rstd = rsqrtf(wave_sum(s) * (1.f / D) + EPS);
#pragma unroll
    for (int j = 0; j < 4; ++j) { const float4 gg = ((const float4*)g)[lane + 64 * j];
        uint2 o; o.x = f2bf(v[j].x * rstd * gg.x) | (f2bf(v[j].y * rstd * gg.y) << 16); o.y = f2bf(v[j].z * rstd * gg.z) | (f2bf(v[j].w * rstd * gg.w) << 16);
        ((uint2*)(out + (size_t)row * D))[lane + 64 * j] = o; }
}

struct NG_Args {
    const void* A; int lda; int a_is_f32; const float* B; int ldb; const float* kscale; int M, N, K;
    const void* A2; const float* B2;
    unsigned char* ws; const float* x; float* out; const float* aux0;
};
enum { MODE_Z = 1, MODE_MERGE = 2, MODE_X1 = 3, MODE_PP = 4, MODE_FINAL = 5 };

template <int MODE> __device__ __forceinline__ void ng_store(const NG_Args& a, int row, int col, float v, float v2) {
    unsigned char* ws = a.ws;
    if (MODE == MODE_Z) {
        if (col < 512) ((bf16*)(ws + WS_RQ))[(size_t)row * 512 + col] = (bf16)f2bf(v);
        else if (col < 1024) ((bf16*)(ws + WS_RK))[(size_t)row * 512 + col - 512] = (bf16)f2bf(v * 0.08838834764831845f);
        else if (col < 1536) ((bf16*)(ws + WS_RV))[(size_t)row * 512 + col - 1024] = (bf16)f2bf(v);
        else if (col < 2048) ((bf16*)(ws + WS_RG))[(size_t)row * 512 + col - 1536] = (bf16)f2bf(v * sigmoidf_(v));
        else if (col < 2816) ((bf16*)(ws + WS_SV))[(size_t)row * 128 + col - 2688] = (bf16)f2bf(v);
        else if (col < 3840) ((bf16*)(ws + WS_GR))[(size_t)row * 1024 + col - 2816] = (bf16)f2bf(sigmoidf_(v));
        else ((bf16*)(ws + WS_GS))[(size_t)row * 1024 + col - 3840] = (bf16)f2bf(sigmoidf_(v));
    } else if (MODE == MODE_MERGE) {
        const float gr = bf2f(((const bf16*)(ws + WS_GR))[(size_t)row * 1024 + col]), gs = bf2f(((const bf16*)(ws + WS_GS))[(size_t)row * 1024 + col]);
        ((bf16*)(ws + WS_MG))[(size_t)row * 1024 + col] = (bf16)f2bf(gr * v + gs * v2);
    } else if (MODE == MODE_X1) {
        const float x1 = a.x[(size_t)row * 1024 + col] + v;
        a.out[(size_t)row * 1024 + col] = x1; ((bf16*)(ws + WS_X1B))[(size_t)row * 1024 + col] = (bf16)f2bf(x1);
    } else if (MODE == MODE_PP) {
        ((bf16*)(ws + WS_PP))[(size_t)row * 1024 + col] = (bf16)f2bf(v);
    } else if (MODE == MODE_FINAL) {
        const float rstd2 = ((const float*)(ws + WS_RSTD2))[row], rstdp = ((const float*)(ws + WS_RSTDP))[row];
        const float ple = bf2f(((const bf16*)(ws + WS_PP))[(size_t)row * 1024 + col]) * rstdp * a.aux0[col];
        const float x2 = a.out[(size_t)row * 1024 + col];
        a.out[(size_t)row * 1024 + col] = x2 + sigmoidf_(rstd2 * v) * ple;
    }
}

template <int MODE> __global__ void __launch_bounds__(256) k_gemm_naive(NG_Args a) {
    __shared__ float As[16][68], Bs[16][68], As2[16][68], Bs2[16][68];
    const int tid = threadIdx.x, tx = tid & 15, ty = tid >> 4;
    const int m0 = blockIdx.y * 64, n0 = blockIdx.x * 64;
    float acc[4][4], acc2[4][4];
#pragma unroll
    for (int i = 0; i < 4; ++i)
#pragma unroll
        for (int j = 0; j < 4; ++j) { acc[i][j] = 0.f; acc2[i][j] = 0.f; }
    const int ar = tid >> 2, ak = (tid & 3) * 4;
    const int bk = tid >> 4, bn = (tid & 15) * 4;
    for (int k0 = 0; k0 < a.K; k0 += 16) {
        float av[4];
        if (a.a_is_f32) { const float4 t = *(const float4*)((const float*)a.A + (size_t)(m0 + ar) * a.lda + k0 + ak); av[0] = t.x; av[1] = t.y; av[2] = t.z; av[3] = t.w; }
        else { const uint2 t = *(const uint2*)((const bf16*)a.A + (size_t)(m0 + ar) * a.lda + k0 + ak); av[0] = bf2f(t.x & 0xffff); av[1] = bf2f(t.x >> 16); av[2] = bf2f(t.y & 0xffff); av[3] = bf2f(t.y >> 16); }
        float4 bv = *(const float4*)(a.B + (size_t)(k0 + bk) * a.ldb + n0 + bn);
        if (a.kscale) { const float s = a.kscale[k0 + bk]; bv.x *= s; bv.y *= s; bv.z *= s; bv.w *= s; }
#pragma unroll
        for (int i = 0; i < 4; ++i) As[ak + i][ar] = av[i];
        Bs[bk][bn] = bv.x; Bs[bk][bn + 1] = bv.y; Bs[bk][bn + 2] = bv.z; Bs[bk][bn + 3] = bv.w;
        if (MODE == MODE_MERGE) {
            const uint2 t = *(const uint2*)((const bf16*)a.A2 + (size_t)(m0 + ar) * a.lda + k0 + ak);
            As2[ak][ar] = bf2f(t.x & 0xffff); As2[ak + 1][ar] = bf2f(t.x >> 16); As2[ak + 2][ar] = bf2f(t.y & 0xffff); As2[ak + 3][ar] = bf2f(t.y >> 16);
            const float4 b2 = *(const float4*)(a.B2 + (size_t)(k0 + bk) * a.ldb + n0 + bn);
            Bs2[bk][bn] = b2.x; Bs2[bk][bn + 1] = b2.y; Bs2[bk][bn + 2] = b2.z; Bs2[bk][bn + 3] = b2.w;
        }
        __syncthreads();
#pragma unroll
        for (int kk = 0; kk < 16; ++kk) {
            float ra[4], rb[4];
#pragma unroll
            for (int i = 0; i < 4; ++i) { ra[i] = As[kk][ty * 4 + i]; rb[i] = Bs[kk][tx * 4 + i]; }
#pragma unroll
            for (int i = 0; i < 4; ++i)
#pragma unroll
                for (int j = 0; j < 4; ++j) acc[i][j] += ra[i] * rb[j];
            if (MODE == MODE_MERGE) {
#pragma unroll
                for (int i = 0; i < 4; ++i) { ra[i] = As2[kk][ty * 4 + i]; rb[i] = Bs2[kk][tx * 4 + i]; }
#pragma unroll
                for (int i = 0; i < 4; ++i)
#pragma unroll
                    for (int j = 0; j < 4; ++j) acc2[i][j] += ra[i] * rb[j];
            }
        }
        __syncthreads();
    }
#pragma unroll
    for (int i = 0; i < 4; ++i)
#pragma unroll
        for (int j = 0; j < 4; ++j) ng_store<MODE>(a, m0 + ty * 4 + i, n0 + tx * 4 + j, acc[i][j], acc2[i][j]);
}

__device__ __forceinline__ float ret_lg(int h) { return log1pf(-exp2f(-5.0f - (float)h)); }

__global__ void __launch_bounds__(256) k_ret_kv(unsigned char* ws) {
    const int bhn = blockIdx.x, n = bhn % NC, h = (bhn / NC) % RH, b = bhn / (NC * RH);
    const bf16* RK = (const bf16*)(ws + WS_RK); const bf16* RV = (const bf16*)(ws + WS_RV);
    float* KV = (float*)(ws + WS_KV) + (size_t)bhn * 128 * 128;
    const float lg = ret_lg(h);
    const size_t t0 = (size_t)b * SEQ + (size_t)n * RC;
    for (int o = threadIdx.x; o < 128 * 128; o += 256) {
        const int d = o >> 7, v = o & 127; float s = 0.f;
        for (int j = 0; j < 128; ++j) s += bf2f(RK[(t0 + j) * 512 + h * 128 + d]) * __expf((127.f - (float)j) * lg) * bf2f(RV[(t0 + j) * 512 + h * 128 + v]);
        KV[o] = s;
    }
}
__global__ void __launch_bounds__(256) k_ret_scan(unsigned char* ws) {
    const int gid = blockIdx.x * 256 + threadIdx.x;
    const int bh = gid >> 14, o = gid & 16383, d = o >> 7, v = o & 127, h = bh % RH;
    const float decay = __expf(128.f * ret_lg(h));
    const float* KV = (const float*)(ws + WS_KV); bf16* ST = (bf16*)(ws + WS_ST);
    float st = 0.f;
    for (int n = 0; n < NC; ++n) {
        const size_t bhn = (size_t)bh * NC + n;
        ST[bhn * 16384 + v * 128 + d] = (bf16)f2bf(st);
        st = decay * st + KV[bhn * 16384 + o];
    }
}
__global__ void __launch_bounds__(256) k_ret_out(unsigned char* ws, const float* gn_g, const float* gn_b) {
    extern __shared__ float sm[];
    float* sc = sm; float* yy = sm + 128 * 128;
    const int bhn = blockIdx.x, n = bhn % NC, h = (bhn / NC) % RH, b = bhn / (NC * RH);
    const bf16* RQ = (const bf16*)(ws + WS_RQ); const bf16* RK = (const bf16*)(ws + WS_RK); const bf16* RV = (const bf16*)(ws + WS_RV);
    const bf16* RG = (const bf16*)(ws + WS_RG); const bf16* ST = (const bf16*)(ws + WS_ST) + (size_t)bhn * 16384; bf16* AR = (bf16*)(ws + WS_AR);
    const float lg = ret_lg(h);
    const size_t t0 = (size_t)b * SEQ + (size_t)n * RC;
    for (int o = threadIdx.x; o < 128 * 128; o += 256) {
        const int i = o >> 7, j = o & 127; float s = 0.f;
        if (i >= j) { for (int d = 0; d < 128; ++d) s += bf2f(RQ[(t0 + i) * 512 + h * 128 + d]) * bf2f(RK[(t0 + j) * 512 + h * 128 + d]); s *= __expf((float)(i - j) * lg); }
        sc[o] = s;
    }
    __syncthreads();
    for (int o = threadIdx.x; o < 128 * 128; o += 256) {
        const int i = o >> 7, v = o & 127; float s = 0.f, c = 0.f;
        for (int j = 0; j <= i; ++j) s += sc[i * 128 + j] * bf2f(RV[(t0 + j) * 512 + h * 128 + v]);
        for (int d = 0; d < 128; ++d) c += bf2f(RQ[(t0 + i) * 512 + h * 128 + d]) * bf2f(ST[v * 128 + d]);
        yy[o] = s + c * __expf((float)(i + 1) * lg);
    }
    __syncthreads();
    if (threadIdx.x < 128) {
        const int i = threadIdx.x; float mu = 0.f;
        for (int v = 0; v < 128; ++v) mu += yy[i * 128 + ((v + i) & 127)];
        mu *= (1.f / 128.f); float var = 0.f;
        for (int v = 0; v < 128; ++v) { const float dd = yy[i * 128 + ((v + i) & 127)] - mu; var += dd * dd; }
        const float rstd = rsqrtf(var * (1.f / 128.f) + EPS);
        for (int v = 0; v < 128; ++v) { const int c = h * 128 + v; const float yn = (yy[i * 128 + v] - mu) * rstd * gn_g[c] + gn_b[c];
            AR[(t0 + i) * 512 + c] = (bf16)f2bf(bf2f(RG[(t0 + i) * 512 + c]) * yn); }
    }
}
__global__ void __launch_bounds__(256) k_swa(unsigned char* ws, const float* sinks) {
    const int gw = blockIdx.x * 4 + (threadIdx.x >> 6), lane = threadIdx.x & 63;
    const int t = gw >> 3, h = gw & 7, kvh = h >> 2, tpos = t & (SEQ - 1), tb = t - tpos;
    const bf16* SQ = (const bf16*)(ws + WS_SQ); const bf16* SK = (const bf16*)(ws + WS_SK); const bf16* SV = (const bf16*)(ws + WS_SV);
    const float q = bf2f(SQ[(size_t)t * 512 + h * 64 + lane]);
    const float slope2 = exp2f(-8.0f * (float)(h + 1) / 8.0f) * LOG2E;
    const float sink2 = sinks[h] * LOG2E;
    float m = sink2, l = 1.f, o = 0.f;
    const int lo = tpos - (WIN - 1) < 0 ? 0 : tpos - (WIN - 1);
    for (int kp = lo; kp <= tpos; ++kp) {
        const size_t tk = (size_t)(tb + kp);
        float s = wave_sum(q * bf2f(SK[tk * 128 + kvh * 64 + lane])) - slope2 * (float)(tpos - kp);
        const float mn = fmaxf(m, s), f = exp2f(m - mn), pp = exp2f(s - mn);
        l = l * f + pp; o = o * f + pp * bf2f(SV[tk * 128 + kvh * 64 + lane]); m = mn;
    }
    ((bf16*)(ws + WS_AS))[(size_t)t * 512 + h * 64 + lane] = (bf16)f2bf(o / l);
}
__global__ void __launch_bounds__(256) k_router(unsigned char* ws, const float* x1, const float* g, const float* wrg, const float* brg, const float* wre, const float* bre) {
    const int t = blockIdx.x * 4 + (threadIdx.x >> 6), lane = threadIdx.x & 63;
    float hv[16]; float ss = 0.f;
#pragma unroll
    for (int j = 0; j < 16; ++j) { hv[j] = x1[(size_t)t * D + j * 64 + lane]; ss += hv[j] * hv[j]; }
    const float rstd = rsqrtf(wave_sum(ss) * (1.f / D) + EPS);
#pragma unroll
    for (int j = 0; j < 16; ++j) hv[j] *= rstd * g[j * 64 + lane];
    float lgts[4], le[32];
#pragma unroll
    for (int o = 0; o < 4; ++o) { float s = 0.f;
#pragma unroll
        for (int j = 0; j < 16; ++j) s += hv[j] * wrg[(size_t)(j * 64 + lane) * 4 + o];
        lgts[o] = wave_sum(s) + brg[o]; }
#pragma unroll
    for (int o = 0; o < 32; ++o) { float s = 0.f;
#pragma unroll
        for (int j = 0; j < 16; ++j) s += hv[j] * wre[(size_t)(j * 64 + lane) * 32 + o];
        le[o] = wave_sum(s) + bre[o]; }
    float gm = lgts[0]; int gs = 0;
#pragma unroll
    for (int o = 1; o < 4; ++o) if (lgts[o] > gm) { gm = lgts[o]; gs = o; }
    float gden = 0.f;
#pragma unroll
    for (int o = 0; o < 4; ++o) gden += __expf(lgts[o] - gm);
    const float gw = 1.f / gden;
    float e8[8];
#pragma unroll
    for (int o = 0; o < 8; ++o) { e8[o] = gs == 0 ? le[o] : gs == 1 ? le[8 + o] : gs == 2 ? le[16 + o] : le[24 + o]; }
    float m1 = e8[0]; int i1 = 0;
#pragma unroll
    for (int o = 1; o < 8; ++o) if (e8[o] > m1) { m1 = e8[o]; i1 = o; }
    float m2 = -3.0e38f; int i2 = 0;
#pragma unroll
    for (int o = 0; o < 8; ++o) if (o != i1 && e8[o] > m2) { m2 = e8[o]; i2 = o; }
    const float p2 = __expf(m2 - m1), inv = 1.f / (1.f + p2);
    if (lane == 0) {
        ((float*)(ws + WS_RSTD1))[t] = rstd;
        ((int*)(ws + WS_SEL))[t * 2] = gs * 8 + i1; ((int*)(ws + WS_SEL))[t * 2 + 1] = gs * 8 + i2;
        ((float*)(ws + WS_CW))[t * 2] = gw * inv; ((float*)(ws + WS_CW))[t * 2 + 1] = gw * p2 * inv;
    }
}
__global__ void __launch_bounds__(256) k_moe_up(unsigned char* ws, const float* g, const float* wg, const float* wu) {
    const int tk = blockIdx.x, t = tk >> 1, f = threadIdx.x;
    const int e = ((const int*)(ws + WS_SEL))[tk]; const float cw = ((const float*)(ws + WS_CW))[tk], rstd = ((const float*)(ws + WS_RSTD1))[t];
    const bf16* xb = (const bf16*)(ws + WS_X1B) + (size_t)t * D;
    const float* Wg = wg + (size_t)e * D * FF; const float* Wu = wu + (size_t)e * D * FF;
    float a = 0.f, u = 0.f;
    for (int d = 0; d < D; ++d) { const float hv = bf2f(xb[d]) * g[d]; a += hv * Wg[(size_t)d * FF + f]; u += hv * Wu[(size_t)d * FF + f]; }
    a *= rstd; u *= rstd;
    ((bf16*)(ws + WS_HIDN))[(size_t)tk * FF + f] = (bf16)f2bf(a * sigmoidf_(a) * u * cw);
}
__global__ void __launch_bounds__(256) k_moe_down(unsigned char* ws, float* out, const float* wd) {
    const int t = blockIdx.x, c0 = threadIdx.x * 4;
    float4 acc = *(const float4*)(out + (size_t)t * D + c0);
    for (int k = 0; k < 2; ++k) {
        const int e = ((const int*)(ws + WS_SEL))[t * 2 + k]; const float* Wd = wd + (size_t)e * FF * D;
        const bf16* hid = (const bf16*)(ws + WS_HIDN) + (size_t)(t * 2 + k) * FF;
        for (int f = 0; f < FF; ++f) { const float hv = bf2f(hid[f]); const float4 w = *(const float4*)(Wd + (size_t)f * D + c0); acc.x += hv * w.x; acc.y += hv * w.y; acc.z += hv * w.z; acc.w += hv * w.w; }
    }
    *(float4*)(out + (size_t)t * D + c0) = acc;
}
__global__ void __launch_bounds__(256) k_x2_stats(unsigned char* ws, const float* x2) {
    const int row = blockIdx.x * 4 + (threadIdx.x >> 6), lane = threadIdx.x & 63;
    const float4* xr = (const float4*)(x2 + (size_t)row * D) + lane; float s = 0.f;
#pragma unroll
    for (int j = 0; j < 4; ++j) { const float4 v = xr[64 * j]; s += v.x * v.x + v.y * v.y + v.z * v.z + v.w * v.w;
        uint2 o; o.x = f2bf(v.x) | (f2bf(v.y) << 16); o.y = f2bf(v.z) | (f2bf(v.w) << 16); ((uint2*)((bf16*)(ws + WS_X2B) + (size_t)row * D))[lane + 64 * j] = o; }
    s = wave_sum(s);
    if (lane == 0) ((float*)(ws + WS_RSTD2))[row] = rsqrtf(s * (1.f / D) + EPS);
}
__global__ void __launch_bounds__(256) k_pp_stats(unsigned char* ws) {
    const int row = blockIdx.x * 4 + (threadIdx.x >> 6), lane = threadIdx.x & 63;
    const bf16* pr = (const bf16*)(ws + WS_PP) + (size_t)row * D; float s = 0.f;
#pragma unroll
    for (int j = 0; j < 16; ++j) { const float v = bf2f(pr[j * 64 + lane]); s += v * v; }
    s = wave_sum(s);
    if (lane == 0) ((float*)(ws + WS_RSTDP))[row] = rsqrtf(s * (1.f / D) + EPS);
}

extern "C" void kernel_launch(void* const* d_in, const int* in_sizes, int n_in, void* d_out, int out_size, void* d_ws, size_t ws_size, hipStream_t stream) {
    static int grid = 0;
    if (grid == 0) {
        if (n_in != 24 || in_sizes[0] != T * D || out_size != T * D || ws_size < WS_END) { fprintf(stderr, "kernel_launch: unexpected shapes (n_in %d, in0 %d, out %d, ws %zu); nothing launched\n", n_in, n_in > 0 ? in_sizes[0] : -1, out_size, ws_size); grid = -1; return; }
        int dev = 0, cus = 0, per_cu = 0;
        if (hipGetDevice(&dev) != hipSuccess || hipDeviceGetAttribute(&cus, hipDeviceAttributeMultiprocessorCount, dev) != hipSuccess) { grid = -1; return; }
        if (hipFuncSetAttribute((const void*)mk_fwd, hipFuncAttributeMaxDynamicSharedMemorySize, LDS_BYTES) != hipSuccess) { fprintf(stderr, "kernel_launch: hipFuncSetAttribute failed\n"); grid = -1; return; }
        if (hipOccupancyMaxActiveBlocksPerMultiprocessor(&per_cu, (const void*)mk_fwd, NWAVES * 64, LDS_BYTES) != hipSuccess || per_cu < 1) { fprintf(stderr, "kernel_launch: occupancy query says %d workgroups per CU\n", per_cu); }
        (void)hipGetLastError();
        grid = cus;
        (void)hipFuncSetAttribute((const void*)k_ret_out, hipFuncAttributeMaxDynamicSharedMemorySize, 131072);
    }
    if (grid < 0) return;
    const float* x = (const float*)d_in[0]; const float* p = (const float*)d_in[1];
    const float* gn_g = (const float*)d_in[4]; const float* gn_b = (const float*)d_in[5]; const float* w_ret_o = (const float*)d_in[6];
    const float* sinks = (const float*)d_in[9];
    const float* w_swa_o = (const float*)d_in[10]; const float* w_out = (const float*)d_in[11]; const float* ffn_g = (const float*)d_in[12];
    const float* wrg = (const float*)d_in[13]; const float* brg = (const float*)d_in[14]; const float* wre = (const float*)d_in[15]; const float* bre = (const float*)d_in[16];
    const float* weg = (const float*)d_in[17]; const float* weu = (const float*)d_in[18]; const float* wed = (const float*)d_in[19];
    const float* pg_g = (const float*)d_in[20]; const float* w_pg = (const float*)d_in[21]; const float* w_ple = (const float*)d_in[22]; const float* ple_g = (const float*)d_in[23];
    unsigned char* ws = (unsigned char*)d_ws; float* out = (float*)d_out;

    (void)hipMemsetAsync(ws + WS_CTL, 0, CTL_ZERO_BYTES, stream);
    Args a{};
    for (int i = 0; i < 24; ++i) a.in[i] = (const float*)d_in[i];
    a.out = out; a.ws = ws; a.ph_lo = 0; a.ph_hi = N_PHASES;
    hipLaunchKernelGGL(mk_fwd, dim3(grid), dim3(NWAVES * 64), LDS_BYTES, stream, a);

    k_ret_kv<<<BATCH * RH * NC, 256, 0, stream>>>(ws);
    k_ret_scan<<<16 * 16384 / 256, 256, 0, stream>>>(ws);
    k_swa<<<T * SH / 4, 256, 0, stream>>>(ws, sinks);
    k_ret_out<<<BATCH * RH * NC, 256, 131072, stream>>>(ws, gn_g, gn_b);
    { NG_Args a{}; a.A = ws + WS_AR; a.A2 = ws + WS_AS; a.lda = 512; a.B = w_ret_o; a.B2 = w_swa_o; a.ldb = D; a.M = T; a.N = D; a.K = 512; a.ws = ws;
      k_gemm_naive<MODE_MERGE><<<dim3(D / 64, T / 64), 256, 0, stream>>>(a); }
    { NG_Args a{}; a.A = ws + WS_MG; a.lda = D; a.B = w_out; a.ldb = D; a.M = T; a.N = D; a.K = D; a.ws = ws; a.x = x; a.out = out;
      k_gemm_naive<MODE_X1><<<dim3(D / 64, T / 64), 256, 0, stream>>>(a); }
    k_router<<<T / 4, 256, 0, stream>>>(ws, out, ffn_g, wrg, brg, wre, bre);
    k_moe_up<<<T * 2, 256, 0, stream>>>(ws, ffn_g, weg, weu);
    k_moe_down<<<T, 256, 0, stream>>>(ws, out, wed);
    k_x2_stats<<<T / 4, 256, 0, stream>>>(ws, out);
    { NG_Args a{}; a.A = p; a.lda = PLE; a.a_is_f32 = 1; a.B = w_ple; a.ldb = D; a.M = T; a.N = D; a.K = PLE; a.ws = ws;
      k_gemm_naive<MODE_PP><<<dim3(D / 64, T / 64), 256, 0, stream>>>(a); }
    k_pp_stats<<<T / 4, 256, 0, stream>>>(ws);
    { NG_Args a{}; a.A = ws + WS_X2B; a.lda = D; a.B = w_pg; a.ldb = D; a.kscale = pg_g; a.M = T; a.N = D; a.K = D; a.ws = ws; a.out = out; a.aux0 = ple_g;
      k_gemm_naive<MODE_FINAL><<<dim3(D / 64, T / 64), 256, 0, stream>>>(a); }
}
```

```cpp
#include <hip/hip_runtime.h>
#include <cstdio>
#include <cstdint>

constexpr int BATCH = 4, SEQ = 4096, T = BATCH * SEQ, D = 1024;
constexpr int PLE = 256;
constexpr float EPS = 1e-6f;
constexpr int RH = 4, RDK = 128, RC = 128, NC = SEQ / RC;
constexpr int SH = 8, SKV = 2, SG = 4, HD = 64, WIN = 128;
constexpr int NE = 32, EPG = 8, NG = 4, FF = 256;
constexpr int INW = 4864;
constexpr float LOG2E = 1.4426950408889634f;
constexpr float QSCALE = 0.125f * LOG2E;
constexpr float KSCALE = 0.08838834764831845f;

typedef unsigned short bf16;
__device__ __forceinline__ unsigned f2bf(float f) { unsigned u = __builtin_bit_cast(unsigned, f); return (u + 0x7fffu + ((u >> 16) & 1u)) >> 16; }
__device__ __forceinline__ unsigned pk2(float lo, float hi) { return f2bf(lo) | (f2bf(hi) << 16); }
__device__ __forceinline__ float bf2f(bf16 h) { return __builtin_bit_cast(float, (unsigned)h << 16); }
__device__ __forceinline__ float wave_sum(float v) {
#pragma unroll
    for (int o = 1; o < 64; o <<= 1) v += __shfl_xor(v, o);
    return v;
}
__device__ __forceinline__ float sigmoidf_(float x) { return __builtin_amdgcn_rcpf(1.f + __expf(-x)); }

constexpr size_t MiB = 1u << 20;
constexpr size_t WS_CTL = 0, CTL_ZERO_BYTES = 1 * MiB;
constexpr size_t WS_WIN = 1 * MiB;
constexpr size_t WS_WRO = 11 * MiB;
constexpr size_t WS_WSO = 12 * MiB;
constexpr size_t WS_WOUT = 13 * MiB;
constexpr size_t WS_WPG = 15 * MiB;
constexpr size_t WS_WPLE = 17 * MiB;
constexpr size_t WS_XN = 18 * MiB;
constexpr size_t WS_KV = 18 * MiB;
constexpr size_t WS_MG = 18 * MiB;
constexpr size_t WS_X2B = 18 * MiB;
constexpr size_t WS_RQ = 50 * MiB, WS_RK = 66 * MiB, WS_RV = 82 * MiB, WS_RG = 98 * MiB;
constexpr size_t WS_SQ = 114 * MiB;
constexpr size_t WS_SK = 130 * MiB, WS_SV = 134 * MiB;
constexpr size_t WS_GR = 138 * MiB, WS_GS = 170 * MiB;
constexpr size_t WS_ST = 202 * MiB;
constexpr size_t WS_AS = 218 * MiB, WS_AR = 234 * MiB;
constexpr size_t WS_MISC = 250 * MiB;
constexpr size_t WS_RSTD1 = WS_MISC, WS_RSTD2 = WS_MISC + 65536, WS_RSTDP = WS_MISC + 2 * 65536;
constexpr size_t WS_SEL = WS_MISC + 3 * 65536;
constexpr size_t WS_CW = WS_SEL + 131072;
constexpr size_t WS_SSP = 251 * MiB;
constexpr size_t WS_X1B = 50 * MiB;
constexpr size_t WS_HIDN = 130 * MiB;
constexpr size_t WS_PP = 216 * MiB;
constexpr size_t WS_PB = 152 * MiB;
constexpr size_t WS_END = 256 * MiB;
constexpr int CW_BAR = 4096;

namespace pg8 {
#define PG8_LAS __attribute__((address_space(3)))
typedef unsigned short bf16_t;
typedef short bf16x8 __attribute__((ext_vector_type(8)));
typedef float f32x4 __attribute__((ext_vector_type(4)));
typedef unsigned u32x4 __attribute__((ext_vector_type(4)));
constexpr int BM = 256, BK = 64, HALF = 128, HTB = HALF * BK * 2  , STAGE_BYTES = 8 * HTB, NXCD = 8, WGM = 8;

__host__ __device__ __forceinline__ int lds_byte(int r, int c) { const int st = (r >> 4) * 2 + (c >> 5), rr = r & 15, cc = c & 31, ob = rr * 64 + cc * 2; return st * 1024 + (ob ^ (((ob >> 9) & 1) << 5)); }
__host__ __device__ __forceinline__ void stage_rc(int b, int& R, int& C) { const int st = b / 1024, sb = b % 1024, swz = sb ^ (((sb >> 9) & 1) << 5); R = (st >> 1) * 16 + swz / 64; C = (st & 1) * 32 + (swz % 64) / 2; }
__host__ __device__ __forceinline__ int perm32(int rho) { const int n = rho >> 4, i = rho & 15; return 8 * (i >> 2) + 4 * n + (i & 3); }
struct Unit { int pm, pn; const char* a; const char* b; int tag; };

__device__ __forceinline__ void tile_of(int L, int nM, int nN, int& pm, int& pn) {
    const int nwg = nM * nN; int wgid = L; { const int q = nwg / NXCD, r = nwg % NXCD, xcd = wgid % NXCD, off = wgid / NXCD; wgid = (xcd < r ? xcd * (q + 1) : r * (q + 1) + (xcd - r) * q) + off; }
    const int nig = WGM * nN, gid = wgid / nig, fm = gid * WGM, gsz = (nM - fm) < WGM ? (nM - fm) : WGM;
    pm = fm + ((wgid % nig) % gsz); pn = (wgid % nig) / gsz;
}
struct TileOrder {
    int nM, nN, nwg, G, c; const char* A; const char* Bt; size_t tstep;
    __device__ void init(const void* A_, const void* Bt_, int M, int N, int K, int G_, int c_) { nM = M / BM; nN = N / BM; nwg = nM * nN; G = G_; c = c_; A = (const char*)A_; Bt = (const char*)Bt_; tstep = (size_t)BM * K * 2; }
    __device__ bool next(int i, Unit& u) const {
        const long L = (long)i * G + c; if (L >= nwg) return false;
        tile_of((int)L, nM, nN, u.pm, u.pn); u.a = A + (size_t)u.pm * tstep; u.b = Bt + (size_t)u.pn * tstep; u.tag = 0; return true;
    }
    __device__ __forceinline__ void a_ready(const Unit&) const {}
    __device__ __forceinline__ void done(const Unit&) const {}
};
struct TwoPassOrder {
    int nM, nN, nwg, G, c; const char* A0; const char* A1; const char* B0; const char* B1; size_t tstep;
    __device__ void init(const void* A0_, const void* B0_, const void* A1_, const void* B1_, int M, int N, int K, int G_, int c_) { nM = M / BM; nN = N / BM; nwg = nM * nN; G = G_; c = c_;
        A0 = (const char*)A0_; A1 = (const char*)A1_; B0 = (const char*)B0_; B1 = (const char*)B1_; tstep = (size_t)BM * K * 2; }
    __device__ bool next(int i, Unit& u) const {
        const long L = (long)(i >> 1) * G + c; if (L >= nwg) return false;
        tile_of((int)L, nM, nN, u.pm, u.pn); u.tag = i & 1; u.a = (u.tag ? A1 : A0) + (size_t)u.pm * tstep; u.b = (u.tag ? B1 : B0) + (size_t)u.pn * tstep; return true;
    }
    __device__ __forceinline__ void a_ready(const Unit&) const {}
    __device__ __forceinline__ void done(const Unit&) const {}
};

__device__ __forceinline__ unsigned cvt_pk_bf16(float lo, float hi) { unsigned r; asm volatile("v_cvt_pk_bf16_f32 %0, %1, %2" : "=v"(r) : "v"(lo), "v"(hi)); return r; }
__device__ __forceinline__ u32x4 pack8(const f32x4 v0, const f32x4 v1) { u32x4 w; w.x = cvt_pk_bf16(v0[0], v0[1]); w.y = cvt_pk_bf16(v0[2], v0[3]); w.z = cvt_pk_bf16(v1[0], v1[1]); w.w = cvt_pk_bf16(v1[2], v1[3]); return w; }
__device__ __forceinline__ float sigm(float x) { return __builtin_amdgcn_rcpf(1.f + __expf(-x)); }

struct EpiZ {
    static constexpr bool PERM = true, AFTER_DRAIN = false;
    unsigned char* ws; const float* qg; const float* kg;
    __device__ __forceinline__ void operator()(const f32x4 (&acc)[2][2][4][2], const Unit& u, int wr, int wc, int fr, int fq) const {
        const int pn = u.pn; const int row0 = u.pm * BM + wr * 64 + fr;
        if (pn < 8 || pn >= 11) {
            int kind, ld, colt; bf16_t* base;
            if (pn < 8) { kind = pn >> 1; base = (bf16_t*)(ws + WS_RQ + (size_t)kind * (16 * MiB)); ld = 512; colt = (pn & 1) * 256; }
            else { const int g = pn - 11; kind = 4; base = (bf16_t*)(ws + WS_GR + (size_t)(g >> 2) * (32 * MiB)); ld = 1024; colt = (g & 3) * 256; }
            const int col0 = colt + wc * 32 + 8 * fq;
#pragma unroll
            for (int ai = 0; ai < 2; ++ai)
#pragma unroll
                for (int m = 0; m < 4; ++m) { bf16_t* rowp = base + (size_t)(row0 + ai * HALF + m * 16) * ld + col0;
#pragma unroll
                    for (int bj = 0; bj < 2; ++bj) { f32x4 v0 = acc[ai][bj][m][0], v1 = acc[ai][bj][m][1];
                        if (kind == 1) { v0 = v0 * KSCALE; v1 = v1 * KSCALE; }
                        else if (kind == 3) {
#pragma unroll
                            for (int j = 0; j < 4; ++j) { v0[j] = v0[j] * sigm(v0[j]); v1[j] = v1[j] * sigm(v1[j]); } }
                        else if (kind == 4) {
#pragma unroll
                            for (int j = 0; j < 4; ++j) { v0[j] = sigm(v0[j]); v1[j] = sigm(v1[j]); } }
                        *(u32x4*)(rowp + bj * HALF) = pack8(v0, v1); } }
        } else {
            const bool isq = pn < 10, isk = (pn == 10) && (wc < 2);
            f32x4 gv[2][2];
#pragma unroll
            for (int bj = 0; bj < 2; ++bj)
#pragma unroll
                for (int n = 0; n < 2; ++n) { const int dd = 32 * bj + 8 * fq + 4 * n;
                    gv[bj][n] = isq ? *(const f32x4*)(qg + dd) * QSCALE : isk ? *(const f32x4*)(kg + dd) : (f32x4){1.f, 1.f, 1.f, 1.f}; }
            bf16_t* base; int ld;
            if (isq) { base = (bf16_t*)(ws + WS_SQ) + (pn - 8) * 256 + 64 * wc + 8 * fq; ld = 512; }
            else if (isk) { base = (bf16_t*)(ws + WS_SK) + 64 * wc + 8 * fq; ld = 128; }
            else { base = (bf16_t*)(ws + WS_SV) + 64 * (wc - 2) + 8 * fq; ld = 128; }
#pragma unroll
            for (int ai = 0; ai < 2; ++ai)
#pragma unroll
                for (int m = 0; m < 4; ++m) {
                    float ss = 0.f;
#pragma unroll
                    for (int bj = 0; bj < 2; ++bj)
#pragma unroll
                        for (int n = 0; n < 2; ++n) { const f32x4 x = acc[ai][bj][m][n]; ss += (x[0] * x[0] + x[1] * x[1]) + (x[2] * x[2] + x[3] * x[3]); }
                    ss += __shfl_xor(ss, 16); ss += __shfl_xor(ss, 32);
                    const float rstd = (isq || isk) ? rsqrtf(ss * (1.f / 64.f) + EPS) : 1.f;
                    bf16_t* rowp = base + (size_t)(row0 + ai * HALF + m * 16) * ld;
#pragma unroll
                    for (int bj = 0; bj < 2; ++bj) *(u32x4*)(rowp + 32 * bj) = pack8(acc[ai][bj][m][0] * rstd * gv[bj][0], acc[ai][bj][m][1] * rstd * gv[bj][1]); }
        }
    }
};


__device__ __forceinline__ void unpack8(const u32x4 w, f32x4& v0, f32x4& v1) {
    v0[0] = __builtin_bit_cast(float, w.x << 16); v0[1] = __builtin_bit_cast(float, w.x & 0xffff0000u); v0[2] = __builtin_bit_cast(float, w.y << 16); v0[3] = __builtin_bit_cast(float, w.y & 0xffff0000u);
    v1[0] = __builtin_bit_cast(float, w.z << 16); v1[1] = __builtin_bit_cast(float, w.z & 0xffff0000u); v1[2] = __builtin_bit_cast(float, w.w << 16); v1[3] = __builtin_bit_cast(float, w.w & 0xffff0000u);
}
typedef unsigned u32x2 __attribute__((ext_vector_type(2)));
__device__ __forceinline__ f32x4 unpack4(const u32x2 w) { f32x4 v; v[0] = __builtin_bit_cast(float, w.x << 16); v[1] = __builtin_bit_cast(float, w.x & 0xffff0000u); v[2] = __builtin_bit_cast(float, w.y << 16); v[3] = __builtin_bit_cast(float, w.y & 0xffff0000u); return v; }

struct EpiMerge {
    static constexpr bool PERM = true, AFTER_DRAIN = false;
    const bf16_t* GR; const bf16_t* GS; bf16_t* MG;
    __device__ __forceinline__ void operator()(const f32x4 (&acc)[2][2][4][2], const Unit& u, int wr, int wc, int fr, int fq) const {
        const int row0 = u.pm * BM + wr * 64 + fr, col0 = u.pn * BM + wc * 32 + 8 * fq; const bf16_t* G = u.tag ? GS : GR;
#pragma unroll
        for (int ai = 0; ai < 2; ++ai)
#pragma unroll
            for (int m = 0; m < 4; ++m) { const size_t off = (size_t)(row0 + ai * HALF + m * 16) * D + col0;
#pragma unroll
                for (int bj = 0; bj < 2; ++bj) { f32x4 g0, g1; unpack8(*(const u32x4*)(G + off + bj * HALF), g0, g1);
                    f32x4 v0 = acc[ai][bj][m][0] * g0, v1 = acc[ai][bj][m][1] * g1;
                    if (u.tag) { f32x4 p0, p1; unpack8(*(const u32x4*)(MG + off + bj * HALF), p0, p1); v0 = v0 + p0; v1 = v1 + p1; }
                    *(u32x4*)(MG + off + bj * HALF) = pack8(v0, v1); } }
    }
};
struct EpiX1 {
    static constexpr bool PERM = false, AFTER_DRAIN = false;
    const float* x; float* out; bf16_t* xb;
    __device__ __forceinline__ void operator()(const f32x4 (&acc)[2][2][4][2], const Unit& u, int wr, int wc, int fr, int fq) const {
        const int row0 = u.pm * BM + wr * 64 + fr, col0 = u.pn * BM + wc * 32 + 4 * fq;
#pragma unroll
        for (int ai = 0; ai < 2; ++ai)
#pragma unroll
            for (int m = 0; m < 4; ++m) { const size_t off = (size_t)(row0 + ai * HALF + m * 16) * D + col0;
#pragma unroll
                for (int bj = 0; bj < 2; ++bj)
#pragma unroll
                    for (int n = 0; n < 2; ++n) { const size_t o = off + bj * HALF + n * 16; const f32x4 v = *(const f32x4*)(x + o) + acc[ai][bj][m][n];
                        *(f32x4*)(out + o) = v; u32x2 w; w.x = cvt_pk_bf16(v[0], v[1]); w.y = cvt_pk_bf16(v[2], v[3]); *(u32x2*)(xb + o) = w; } }
    }
};
struct EpiPP {
    static constexpr bool PERM = true, AFTER_DRAIN = false;
    bf16_t* PP; float* SSP;
    __device__ __forceinline__ void operator()(const f32x4 (&acc)[2][2][4][2], const Unit& u, int wr, int wc, int fr, int fq) const {
        const int row0 = u.pm * BM + wr * 64 + fr, col0 = u.pn * BM + wc * 32 + 8 * fq;
#pragma unroll
        for (int ai = 0; ai < 2; ++ai)
#pragma unroll
            for (int m = 0; m < 4; ++m) { const int row = row0 + ai * HALF + m * 16; float ss = 0.f;
#pragma unroll
                for (int bj = 0; bj < 2; ++bj) { const f32x4 a = acc[ai][bj][m][0], b = acc[ai][bj][m][1];
                    ss += (a[0] * a[0] + a[1] * a[1]) + (a[2] * a[2] + a[3] * a[3]) + (b[0] * b[0] + b[1] * b[1]) + (b[2] * b[2] + b[3] * b[3]);
                    *(u32x4*)(PP + (size_t)row * D + col0 + bj * HALF) = pack8(a, b); }
                ss += __shfl_xor(ss, 16); ss += __shfl_xor(ss, 32);
                if (fq == 0) SSP[(size_t)row * 16 + u.pn * 4 + wc] = ss; }
    }
};
struct EpiFinal {
    static constexpr bool PERM = false, AFTER_DRAIN = false;
    float* out; const bf16_t* PP; const float* rstd2; const float* rstdp; const float* pleg;
    __device__ __forceinline__ void operator()(const f32x4 (&acc)[2][2][4][2], const Unit& u, int wr, int wc, int fr, int fq) const {
        const int row0 = u.pm * BM + wr * 64 + fr, col0 = u.pn * BM + wc * 32 + 4 * fq;
        f32x4 gv[2][2];
#pragma unroll
        for (int bj = 0; bj < 2; ++bj)
#pragma unroll
            for (int n = 0; n < 2; ++n) gv[bj][n] = *(const f32x4*)(pleg + col0 + bj * HALF + n * 16);
#pragma unroll
        for (int ai = 0; ai < 2; ++ai)
#pragma unroll
            for (int m = 0; m < 4; ++m) { const int row = row0 + ai * HALF + m * 16; const size_t off = (size_t)row * D + col0; const float r2 = rstd2[row], rp = rstdp[row];
#pragma unroll
                for (int bj = 0; bj < 2; ++bj)
#pragma unroll
                    for (int n = 0; n < 2; ++n) { const size_t o = off + bj * HALF + n * 16; const f32x4 x2 = *(const f32x4*)(out + o); const f32x4 pp = unpack4(*(const u32x2*)(PP + o)); const f32x4 a = acc[ai][bj][m][n];
                        f32x4 r;
#pragma unroll
                        for (int j = 0; j < 4; ++j) r[j] = x2[j] + sigm(r2 * a[j]) * (pp[j] * rp * gv[bj][n][j]);
                        *(f32x4*)(out + o) = r; } }
    }
};

template <class Epi, class Sched, bool ALIGN_EPI = false, bool SP2 = false>
__device__ __forceinline__ void gemm_phase(PG8_LAS unsigned char* lds, const int K, const Sched& S, const Epi& E) {
    const int tid = threadIdx.x, wid = __builtin_amdgcn_readfirstlane(tid >> 6), lane = tid & 63, wr = wid >> 2, wc = wid & 3, fr = lane & 15, fq = lane >> 4;
    const int nt = K / BK;
    unsigned voffA[2], voffB[2];
#pragma unroll
    for (int i = 0; i < 2; ++i) { int R, C; stage_rc(tid * 16 + i * 8192, R, C); const int Rb = Epi::PERM ? ((R & ~31) + perm32(R & 31)) : R;
        voffA[i] = (unsigned)(R * K + C) * 2u; voffB[i] = (unsigned)(Rb * K + C) * 2u; }
    const size_t kstep = (size_t)(BK * 2);
    const size_t hstep = (size_t)HALF * K * 2;
    const unsigned ldsw = (unsigned)wid * 1024u;
    const int aoff = lds_byte(wr * 64 + fr, fq * 8), boff = lds_byte(wc * 32 + fr, fq * 8);
#define PG8_SA(b, h) (((b) * 2 + (h)) * HTB)
#define PG8_SB(b, h) ((4 + (b) * 2 + (h)) * HTB)
#define PG8_STAGE(bufoff, gbase, voff) do { _Pragma("unroll") for (int _i = 0; _i < 2; ++_i) \
        __builtin_amdgcn_global_load_lds((const unsigned*)((const char*)(gbase) + (voff)[_i]), (PG8_LAS unsigned*)(lds + (bufoff) + ldsw + _i * 8192), 16, 0, 0); } while (0)
#define PG8_LDA(dst, b, h) do { _Pragma("unroll") for (int m = 0; m < 4; ++m) _Pragma("unroll") for (int k = 0; k < 2; ++k) dst[m][k] = *(const PG8_LAS bf16x8*)(lds + PG8_SA(b, h) + aoff + m * 2048 + k * 1024); } while (0)
#define PG8_LDB(dst, b, h) do { _Pragma("unroll") for (int n = 0; n < 2; ++n) _Pragma("unroll") for (int k = 0; k < 2; ++k) dst[n][k] = *(const PG8_LAS bf16x8*)(lds + PG8_SB(b, h) + boff + n * 2048 + k * 1024); } while (0)
#define PG8_MMA(ai, bj, At, Bt) do { __builtin_amdgcn_s_setprio(1); _Pragma("unroll") for (int m = 0; m < 4; ++m) _Pragma("unroll") for (int n = 0; n < 2; ++n) _Pragma("unroll") for (int k = 0; k < 2; ++k) \
        acc[ai][bj][m][n] = __builtin_amdgcn_mfma_f32_16x16x32_bf16(Bt[n][k], At[m][k], acc[ai][bj][m][n], 0, 0, 0); __builtin_amdgcn_s_setprio(0); } while (0)
#define PG8_WAIT_V(n) asm volatile("s_waitcnt vmcnt(" #n ")" ::: "memory")
#define PG8_WAIT_L(n) asm volatile("s_waitcnt lgkmcnt(" #n ")" ::: "memory")
#define PG8_BAR __builtin_amdgcn_s_barrier()
#define PG8_SCHED __builtin_amdgcn_sched_barrier(0)
    Unit cur, nxt; int ui = 0;
    if (!S.next(0, cur)) return;
    f32x4 acc[2][2][4][2];
#pragma unroll
    for (int a = 0; a < 2; ++a)
#pragma unroll
        for (int b = 0; b < 2; ++b)
#pragma unroll
            for (int m = 0; m < 4; ++m)
#pragma unroll
                for (int n = 0; n < 2; ++n) acc[a][b][m][n] = (f32x4){0.f, 0.f, 0.f, 0.f};
    bf16x8 At[4][2], B0[2][2], B1[2][2];
    const char* cA = cur.a; const char* cB = cur.b;
    S.a_ready(cur);
    if constexpr (SP2) {
        PG8_STAGE(PG8_SB(0, 0), cB, voffB); PG8_STAGE(PG8_SB(0, 1), cB + hstep, voffB); PG8_STAGE(PG8_SA(0, 0), cA, voffA); PG8_STAGE(PG8_SA(0, 1), cA + hstep, voffA);
        if (wr == 1) PG8_BAR;
        PG8_WAIT_V(2); PG8_BAR;
        PG8_STAGE(PG8_SB(1, 0), cB + kstep, voffB); PG8_STAGE(PG8_SA(1, 0), cA + kstep, voffA); PG8_STAGE(PG8_SB(1, 1), cB + hstep + kstep, voffB);
        PG8_WAIT_V(6); PG8_BAR;
    } else {
        PG8_STAGE(PG8_SB(0, 0), cB, voffB); PG8_STAGE(PG8_SA(0, 0), cA, voffA); PG8_STAGE(PG8_SB(0, 1), cB + hstep, voffB); PG8_STAGE(PG8_SA(0, 1), cA + hstep, voffA);
        if (wr == 1) PG8_BAR;
        PG8_WAIT_V(4); PG8_BAR;
        PG8_STAGE(PG8_SB(1, 0), cB + kstep, voffB); PG8_STAGE(PG8_SA(1, 0), cA + kstep, voffA); PG8_STAGE(PG8_SB(1, 1), cB + hstep + kstep, voffB);
        PG8_WAIT_V(6); PG8_BAR;
    }
    for (;;) {
        const bool has_next = S.next(ui + 1, nxt);
        const char* nA = has_next ? nxt.a : cA; const char* nB = has_next ? nxt.b : cB;
        for (int t = 0; t < nt; t += 2) {
            const bool last = (t == nt - 2);
            const char* a1 = cA + (size_t)(t + 1) * kstep;
            const char* a2 = last ? nA : cA + (size_t)(t + 2) * kstep; const char* b2 = last ? nB : cB + (size_t)(t + 2) * kstep;
            const char* a3 = a2 + kstep; const char* b3 = b2 + kstep;
            if (last && has_next) S.a_ready(nxt);
            if constexpr (SP2) {
            PG8_LDB(B0, 0, 0); PG8_LDB(B1, 0, 1); PG8_SCHED; PG8_LDA(At, 0, 0); PG8_STAGE(PG8_SA(1, 1), a1 + hstep, voffA);
            PG8_WAIT_V(8); PG8_WAIT_L(0); PG8_BAR; PG8_MMA(0, 0, At, B0); PG8_MMA(0, 1, At, B1); PG8_BAR; PG8_SCHED;
            PG8_LDA(At, 0, 1); PG8_STAGE(PG8_SB(0, 0), b2, voffB); PG8_STAGE(PG8_SB(0, 1), b2 + hstep, voffB); PG8_STAGE(PG8_SA(0, 0), a2, voffA);
            PG8_WAIT_V(8); PG8_WAIT_L(0); PG8_BAR; PG8_MMA(1, 0, At, B0); PG8_MMA(1, 1, At, B1); PG8_BAR; PG8_SCHED;
            PG8_LDB(B0, 1, 0); PG8_LDB(B1, 1, 1); PG8_SCHED; PG8_LDA(At, 1, 0); PG8_STAGE(PG8_SA(0, 1), a2 + hstep, voffA);
            PG8_WAIT_V(8); PG8_WAIT_L(0); PG8_BAR; PG8_MMA(0, 0, At, B0); PG8_MMA(0, 1, At, B1); PG8_BAR; PG8_SCHED;
            PG8_LDA(At, 1, 1); PG8_STAGE(PG8_SB(1, 0), b3, voffB); PG8_STAGE(PG8_SB(1, 1), b3 + hstep, voffB); PG8_STAGE(PG8_SA(1, 0), a3, voffA);
            PG8_WAIT_V(8); PG8_WAIT_L(0); PG8_BAR; PG8_MMA(1, 0, At, B0); PG8_MMA(1, 1, At, B1); PG8_BAR; PG8_SCHED;
            } else {
            PG8_LDB(B0, 0, 0); PG8_SCHED; PG8_LDA(At, 0, 0); PG8_STAGE(PG8_SA(1, 1), a1 + hstep, voffA);
            PG8_WAIT_L(8); PG8_BAR; PG8_WAIT_L(0); PG8_MMA(0, 0, At, B0); PG8_BAR; PG8_SCHED;
            PG8_LDB(B1, 0, 1); PG8_STAGE(PG8_SB(0, 0), b2, voffB);
            PG8_BAR; PG8_WAIT_L(0); PG8_MMA(0, 1, At, B1); PG8_BAR;
            PG8_LDA(At, 0, 1); PG8_STAGE(PG8_SA(0, 0), a2, voffA);
            PG8_BAR; PG8_WAIT_L(0); PG8_MMA(1, 0, At, B0); PG8_BAR; PG8_SCHED;
            PG8_STAGE(PG8_SB(0, 1), b2 + hstep, voffB);
            PG8_WAIT_V(6); PG8_BAR; PG8_MMA(1, 1, At, B1); PG8_BAR;
            PG8_LDB(B0, 1, 0); PG8_SCHED; PG8_LDA(At, 1, 0); PG8_STAGE(PG8_SA(0, 1), a2 + hstep, voffA);
            PG8_WAIT_L(8); PG8_BAR; PG8_WAIT_L(0); PG8_MMA(0, 0, At, B0); PG8_BAR; PG8_SCHED;
            PG8_LDB(B1, 1, 1); PG8_STAGE(PG8_SB(1, 0), b3, voffB);
            PG8_BAR; PG8_WAIT_L(0); PG8_MMA(0, 1, At, B1); PG8_BAR;
            PG8_LDA(At, 1, 1); PG8_STAGE(PG8_SA(1, 0), a3, voffA);
            PG8_BAR; PG8_WAIT_L(0); PG8_MMA(1, 0, At, B0); PG8_BAR; PG8_SCHED;
            PG8_STAGE(PG8_SB(1, 1), b3 + hstep, voffB);
            PG8_WAIT_V(6); PG8_BAR; PG8_MMA(1, 1, At, B1); PG8_BAR;
            }
        }
        if constexpr (ALIGN_EPI) { if (wr == 0) PG8_BAR; }
        if constexpr (!Epi::AFTER_DRAIN) { E(acc, cur, wr, wc, fr, fq); S.done(cur); }
        if (!has_next) break;
#pragma unroll
        for (int a = 0; a < 2; ++a)
#pragma unroll
            for (int b = 0; b < 2; ++b)
#pragma unroll
                for (int m = 0; m < 4; ++m)
#pragma unroll
                    for (int n = 0; n < 2; ++n) acc[a][b][m][n] = (f32x4){0.f, 0.f, 0.f, 0.f};
        cur = nxt; cA = nA; cB = nB; ++ui;
        if constexpr (ALIGN_EPI) { if (wr == 1) PG8_BAR; }
    }
    PG8_WAIT_V(0);
    if constexpr (!ALIGN_EPI) { if (wr == 0) PG8_BAR; }
    PG8_BAR;
    if constexpr (Epi::AFTER_DRAIN) { E.fused(acc, cur, wr, wc, fr, fq, lds, wid, lane); S.done(cur); }
#undef PG8_SA
#undef PG8_SB
#undef PG8_STAGE
#undef PG8_LDA
#undef PG8_LDB
#undef PG8_MMA
#undef PG8_WAIT_V
#undef PG8_WAIT_L
#undef PG8_BAR
#undef PG8_SCHED
}
}
#define GAS __attribute__((address_space(1)))
#define LAS __attribute__((address_space(3)))
typedef unsigned v4u __attribute__((ext_vector_type(4)));
typedef float f32x4 __attribute__((ext_vector_type(4)));
typedef short bf16x8 __attribute__((ext_vector_type(8)));
typedef GAS unsigned gu32;
typedef GAS unsigned long long gu64;
#define RLX_AGENT __ATOMIC_RELAXED, __HIP_MEMORY_SCOPE_AGENT
#define LDS_WAIT() asm volatile("s_waitcnt lgkmcnt(0)" ::: "memory")
#define VM_WAIT() asm volatile("s_waitcnt vmcnt(0)" ::: "memory")
__device__ __forceinline__ unsigned long long rt() { return __builtin_amdgcn_s_memrealtime(); }


#define XB_TMO      128
#define XB_XCNT(j)  (256  + 64 * (j))
#define XB_XSUB(j)  (1280 + 64 * (j))
#define XB_XGEN(j)  (2304 + 64 * (j))
#define XB_TOP      3328
#define XB_TOPGEN   3392
#define XCD_BAR_WORDS 3456
#define XB_SPIN_CAP (1u << 18)

__device__ __forceinline__ unsigned xb_ld(unsigned* p)              { return __hip_atomic_load(p, __ATOMIC_RELAXED, __HIP_MEMORY_SCOPE_AGENT); }
__device__ __forceinline__ unsigned xb_add(unsigned* p, unsigned v) { return __hip_atomic_fetch_add(p, v, __ATOMIC_RELAXED, __HIP_MEMORY_SCOPE_AGENT); }
__device__ __forceinline__ unsigned xb_xcc_id() { return (unsigned)__builtin_amdgcn_s_getreg((3 << 11) | 20) & 0xFu; }
#define XB_SPIN(cond, bar) do { unsigned _sp = 0; while (cond) { __builtin_amdgcn_s_sleep(1); \
    if ((++_sp & 255u) == 0u) { if (xb_ld(&(bar)[XB_TMO])) break; if (_sp > XB_SPIN_CAP) { atomicAdd(&(bar)[XB_TMO], 1u); break; } } } } while (0)

struct XcdBarrier {
    unsigned* bar; unsigned x;
    volatile LAS unsigned* st;
};

__device__ __forceinline__ XcdBarrier xcd_barrier_post(unsigned* bar, volatile LAS unsigned* st) {
    XcdBarrier b; b.bar = bar; b.x = xb_xcc_id(); b.st = st;
    if (threadIdx.x == 0) (void)xb_add(&bar[XB_XCNT(b.x)], 1u);
    return b;
}
__device__ __forceinline__ void xcd_barrier_complete(unsigned* bar, unsigned x, unsigned& nloc, unsigned& nx) {
    const unsigned G = gridDim.x * gridDim.y * gridDim.z;
    unsigned sum, cnt, mine, sp = 0u;
    for (;;) {
        sum = 0u; cnt = 0u; mine = 0u;
#pragma unroll
        for (unsigned j = 0; j < 16; ++j) { const unsigned c = xb_ld(&bar[XB_XCNT(j)]); sum += c; cnt += (c > 0u) ? 1u : 0u; mine = (j == x) ? c : mine; }
        if (sum == G) break;
        __builtin_amdgcn_s_sleep(1);
        if ((++sp & 255u) == 0u) { if (xb_ld(&bar[XB_TMO])) break; if (sp > XB_SPIN_CAP) { atomicAdd(&bar[XB_TMO], 1u); break; } }
    }
    nloc = mine > 0u ? mine : 1u; nx = cnt > 0u ? cnt : 1u;
}

__device__ __forceinline__ void xcd_barrier(const XcdBarrier& b) {
    asm volatile("s_waitcnt vmcnt(0)" ::: "memory");
    __syncthreads();
    if (threadIdx.x == 0) {
        unsigned* bar = b.bar;
        __builtin_amdgcn_s_waitcnt(0);
        unsigned nloc = b.st[0], nx = b.st[1];
        if (nloc == 0u) { xcd_barrier_complete(bar, b.x, nloc, nx); b.st[0] = nloc; b.st[1] = nx; }
        const unsigned old = xb_add(&bar[XB_XSUB(b.x)], 1u);
        const unsigned gen = old / nloc;
        if (old + 1u == (gen + 1u) * nloc) {
            __builtin_amdgcn_fence(__ATOMIC_RELEASE, "agent");
            asm volatile("s_waitcnt vmcnt(0)" ::: "memory");
            const unsigned og = xb_add(&bar[XB_TOP], 1u);
            const unsigned tg = og / nx;
            if (og + 1u == (tg + 1u) * nx) xb_add(&bar[XB_TOPGEN], 1u);
            else XB_SPIN(xb_ld(&bar[XB_TOPGEN]) == tg, bar);
            __builtin_amdgcn_fence(__ATOMIC_ACQUIRE, "agent");
            xb_add(&bar[XB_XGEN(b.x)], 1u);
            asm volatile("s_waitcnt vmcnt(0)" ::: "memory");
        } else {
            XB_SPIN(xb_ld(&bar[XB_XGEN(b.x)]) == gen, bar);
            __builtin_amdgcn_fence(__ATOMIC_ACQUIRE, "agent");
            asm volatile("s_waitcnt vmcnt(0)" ::: "memory");
        }
    }
    __syncthreads();
}
constexpr int NWAVES = 8;
constexpr int RING_OFF = 0, RING_BYTES = 131072;
constexpr int LDSCTL_OFF = RING_BYTES, MISC_OFF = LDSCTL_OFF + 320;
constexpr int LDS_BYTES = 147456;

__device__ __forceinline__ void p0_transpose_item(const float* W, int ldw, int k0, int ns0, bf16* WT, int ldt, int nd0, const float* ks, LAS float* scr, int lane) {
#pragma unroll 8
    for (int i = 0; i < 32; ++i) { const int kk = 2 * i + (lane >> 5); scr[kk * 33 + (lane & 31)] = W[(size_t)(k0 + kk) * ldw + ns0 + (lane & 31)]; }
    LDS_WAIT(); asm volatile("" ::: "memory");
    const int c = lane & 7;
    float sc[8];
#pragma unroll
    for (int i = 0; i < 8; ++i) sc[i] = ks ? ks[k0 + 8 * c + i] : 1.f;
#pragma unroll
    for (int j = 0; j < 4; ++j) { const int n = (lane >> 3) + 8 * j; const LAS float* s = scr + (8 * c) * 33 + n;
        v4u o; o.x = pk2(s[0 * 33] * sc[0], s[1 * 33] * sc[1]); o.y = pk2(s[2 * 33] * sc[2], s[3 * 33] * sc[3]); o.z = pk2(s[4 * 33] * sc[4], s[5 * 33] * sc[5]); o.w = pk2(s[6 * 33] * sc[6], s[7 * 33] * sc[7]);
        *(GAS v4u*)(WT + (size_t)(nd0 + n) * ldt + k0 + 8 * c) = o; }
    LDS_WAIT(); asm volatile("" ::: "memory");
}
__device__ __forceinline__ void rms_row_to_bf16(const float* xrow, const float* g, bf16* orow, int lane) {
    const GAS f32x4* xr = (const GAS f32x4*)xrow + lane;
    f32x4 v[4]; float s = 0.f;
#pragma unroll
    for (int j = 0; j < 4; ++j) { v[j] = xr[64 * j]; s += (v[j].x * v[j].x + v[j].y * v[j].y) + (v[j].z * v[j].z + v[j].w * v[j].w); }
    const float rstd = rsqrtf(wave_sum(s) * (1.f / D) + EPS);
    GAS unsigned long long* o8 = (GAS unsigned long long*)orow + lane;
#pragma unroll
    for (int j = 0; j < 4; ++j) { const f32x4 gg = ((const GAS f32x4*)g)[lane + 64 * j];
        o8[64 * j] = (unsigned long long)pk2(v[j].x * rstd * gg.x, v[j].y * rstd * gg.y) | ((unsigned long long)pk2(v[j].z * rstd * gg.z, v[j].w * rstd * gg.w) << 32); }
}

struct Args { const float* in[24]; float* out; unsigned char* ws; int ph_lo, ph_hi; };
enum { I_X = 0, I_P, I_MIXG, I_WIN, I_GNG, I_GNB, I_WRO, I_QG, I_KG, I_SINK, I_WSO, I_WOUT, I_FFNG, I_WRG, I_BRG, I_WRE, I_BRE, I_WEG, I_WEU, I_WED, I_PGG, I_WPG, I_WPLE, I_PLEG };

__device__ __forceinline__ void p0_prologue(const Args& A, LAS unsigned char* lds, int vcu, int G, int wave, int lane) {
    LAS float* scr = (LAS float*)(lds + RING_OFF + wave * 16384);
    unsigned char* ws = A.ws;
    const int gw = vcu * NWAVES + wave, NGW = G * NWAVES;
    constexpr int I_IN = 16 * 152, I_RO = 8 * 32, I_SO = 8 * 32, I_OUT = 16 * 32, I_PG = 16 * 32, I_PL = 4 * 32;
    constexpr int NITEMS = I_IN + I_RO + I_SO + I_OUT + I_PG + I_PL;
    for (int it = gw; it < NITEMS; it += NGW) {
        int r = it;
        if (r < I_IN) { const int kb = r / 152, nb = r % 152, pn = nb >> 3, q = nb & 7; int ns0 = 32 * nb;
            if (pn >= 8 && pn <= 10) ns0 = 256 * pn + 32 * (((q & 3) << 1) | (q >> 2));
            p0_transpose_item(A.in[I_WIN], INW, 64 * kb, ns0, (bf16*)(ws + WS_WIN), D, 32 * nb, nullptr, scr, lane); continue; } r -= I_IN;
        if (r < I_RO) { p0_transpose_item(A.in[I_WRO], D, 64 * (r / 32), 32 * (r % 32), (bf16*)(ws + WS_WRO), 512, 32 * (r % 32), nullptr, scr, lane); continue; } r -= I_RO;
        if (r < I_SO) { p0_transpose_item(A.in[I_WSO], D, 64 * (r / 32), 32 * (r % 32), (bf16*)(ws + WS_WSO), 512, 32 * (r % 32), nullptr, scr, lane); continue; } r -= I_SO;
        if (r < I_OUT) { p0_transpose_item(A.in[I_WOUT], D, 64 * (r / 32), 32 * (r % 32), (bf16*)(ws + WS_WOUT), D, 32 * (r % 32), nullptr, scr, lane); continue; } r -= I_OUT;
        if (r < I_PG) { p0_transpose_item(A.in[I_WPG], D, 64 * (r / 32), 32 * (r % 32), (bf16*)(ws + WS_WPG), D, 32 * (r % 32), A.in[I_PGG], scr, lane); continue; } r -= I_PG;
        p0_transpose_item(A.in[I_WPLE], D, 64 * (r / 32), 32 * (r % 32), (bf16*)(ws + WS_WPLE), PLE, 32 * (r % 32), nullptr, scr, lane);
    }
    for (int m = gw; m < T; m += NGW) rms_row_to_bf16(A.in[I_X] + (size_t)m * D, A.in[I_MIXG], (bf16*)(ws + WS_XN) + (size_t)m * D, lane);
}

constexpr int N_PHASES = 12;
__global__ void __launch_bounds__(NWAVES * 64, 2) mk_fwd(Args args) {
    extern __shared__ __attribute__((aligned(16))) unsigned char lds_raw[];
    LAS unsigned char* lds = (LAS unsigned char*)lds_raw;
    volatile LAS unsigned* MISC = (volatile LAS unsigned*)(lds + MISC_OFF);
    const int tid = threadIdx.x, lane = tid & 63, wave = __builtin_amdgcn_readfirstlane(tid >> 6);
    const int G = gridDim.x; const int bx = blockIdx.x; const int vcu = (G % 8 == 0) ? (bx % 8) * (G / 8) + bx / 8 : bx;
    unsigned char* ws = args.ws;
    gu32* ctl = (gu32*)(ws + WS_CTL);
    for (int u = tid; u < (LDS_BYTES - LDSCTL_OFF) / 4; u += NWAVES * 64) ((LAS unsigned*)(lds + LDSCTL_OFF))[u] = 0u;
    __syncthreads();
    XcdBarrier bar = xcd_barrier_post((unsigned*)(ctl + CW_BAR), MISC + 8);
    const int lo = args.ph_lo, hi = args.ph_hi;
#define IN(k) (lo <= (k) && (k) < hi)
#define BOTH(k) (IN(k) && IN((k) + 1))
#define GRID_BAR() xcd_barrier(bar)

    if (IN(0)) { p0_prologue(args, lds, vcu, G, wave, lane); if (BOTH(0)) GRID_BAR(); }

    if (IN(1)) {
        pg8::TileOrder S; S.init(ws + WS_XN, ws + WS_WIN, T, INW, D, G, bx);
        pg8::EpiZ E{ws, args.in[I_QG], args.in[I_KG]};
        pg8::gemm_phase<pg8::EpiZ, pg8::TileOrder, true, true>(lds + RING_OFF, D, S, E);
        if (BOTH(1)) GRID_BAR();
    }

    if (IN(5)) {
        pg8::TwoPassOrder S; S.init(ws + WS_AR, ws + WS_WRO, ws + WS_AS, ws + WS_WSO, T, D, 512, G, bx);
        pg8::EpiMerge E{(const bf16*)(ws + WS_GR), (const bf16*)(ws + WS_GS), (bf16*)(ws + WS_MG)};
        pg8::gemm_phase<pg8::EpiMerge, pg8::TwoPassOrder, true, true>(lds + RING_OFF, 512, S, E);
        if (BOTH(5)) GRID_BAR();
    }
    if (IN(6)) {
        { const int gw = vcu * NWAVES + wave, NGW = G * NWAVES;
          for (int m = gw; m < T; m += NGW) { const f32x4 v = ((const GAS f32x4*)(args.in[I_P] + (size_t)m * PLE))[lane];
              ((GAS unsigned long long*)((bf16*)(ws + WS_PB) + (size_t)m * PLE))[lane] = (unsigned long long)pk2(v.x, v.y) | ((unsigned long long)pk2(v.z, v.w) << 32); } }
        pg8::TileOrder S; S.init(ws + WS_MG, ws + WS_WOUT, T, D, D, G, bx);
        pg8::EpiX1 E{args.in[I_X], args.out, (bf16*)(ws + WS_X1B)};
        pg8::gemm_phase<pg8::EpiX1, pg8::TileOrder, true, true>(lds + RING_OFF, D, S, E);
        if (BOTH(6)) GRID_BAR();
    }
    if (IN(7)) {
        pg8::TileOrder S; S.init(ws + WS_PB, ws + WS_WPLE, T, D, PLE, G, bx);
        pg8::EpiPP E{(bf16*)(ws + WS_PP), (float*)(ws + WS_SSP)};
        pg8::gemm_phase<pg8::EpiPP, pg8::TileOrder, true, true>(lds + RING_OFF, PLE, S, E);
        if (BOTH(7)) GRID_BAR();
    }
    if (IN(11)) {
        pg8::TileOrder S; S.init(ws + WS_X2B, ws + WS_WPG, T, D, D, G, bx);
        pg8::EpiFinal E{args.out, (const bf16*)(ws + WS_PP), (const float*)(ws + WS_RSTD2), (const float*)(ws + WS_RSTDP), args.in[I_PLEG]};
        pg8::gemm_phase<pg8::EpiFinal, pg8::TileOrder, true, true>(lds + RING_OFF, D, S, E);
    }
#undef IN
#undef BOTH
#undef GRID_BAR
}

__global__ void __launch_bounds__(256) k_rmsnorm_bf16(const float* x, const float* g, bf16* out) {
    const int row = blockIdx.x * 4 + (threadIdx.x >> 6), lane = threadIdx.x & 63;
    const float4* xr = (const float4*)(x + (size_t)row * D) + lane;
    float4 v[4]; float s = 0.f;
#pragma unroll
    for (int j = 0; j < 4; ++j) { v[j] = xr[64 * j]; s += v[j].x * v[j].x + v[j].y * v[j].y + v[j].z * v[j].z + v[j].w * v[j].w; }
    const float rstd = rsqrtf(wave_sum(s) * (1.f / D) + EPS);
#pragma unroll
    for (int j = 0; j < 4; ++j) { const float4 gg = ((const float4*)g)[lane + 64 * j];
        uint2 o; o.x = f2bf(v[j].x * rstd * gg.x) | (f2bf(v[j].y * rstd * gg.y) << 16); o.y = f2bf(v[j].z * rstd * gg.z) | (f2bf(v[j].w * rstd * gg.w) << 16);
        ((uint2*)(out + (size_t)row * D))[lane + 64 * j] = o; }
}

struct NG_Args {
    const void* A; int lda; int a_is_f32; const float* B; int ldb; const float* kscale; int M, N, K;
    const void* A2; const float* B2;
    unsigned char* ws; const float* x; float* out; const float* aux0;
};
enum { MODE_Z = 1, MODE_MERGE = 2, MODE_X1 = 3, MODE_PP = 4, MODE_FINAL = 5 };

template <int MODE> __device__ __forceinline__ void ng_store(const NG_Args& a, int row, int col, float v, float v2) {
    unsigned char* ws = a.ws;
    if (MODE == MODE_Z) {
        if (col < 512) ((bf16*)(ws + WS_RQ))[(size_t)row * 512 + col] = (bf16)f2bf(v);
        else if (col < 1024) ((bf16*)(ws + WS_RK))[(size_t)row * 512 + col - 512] = (bf16)f2bf(v * 0.08838834764831845f);
        else if (col < 1536) ((bf16*)(ws + WS_RV))[(size_t)row * 512 + col - 1024] = (bf16)f2bf(v);
        else if (col < 2048) ((bf16*)(ws + WS_RG))[(size_t)row * 512 + col - 1536] = (bf16)f2bf(v * sigmoidf_(v));
        else if (col < 2816) ((bf16*)(ws + WS_SV))[(size_t)row * 128 + col - 2688] = (bf16)f2bf(v);
        else if (col < 3840) ((bf16*)(ws + WS_GR))[(size_t)row * 1024 + col - 2816] = (bf16)f2bf(sigmoidf_(v));
        else ((bf16*)(ws + WS_GS))[(size_t)row * 1024 + col - 3840] = (bf16)f2bf(sigmoidf_(v));
    } else if (MODE == MODE_MERGE) {
        const float gr = bf2f(((const bf16*)(ws + WS_GR))[(size_t)row * 1024 + col]), gs = bf2f(((const bf16*)(ws + WS_GS))[(size_t)row * 1024 + col]);
        ((bf16*)(ws + WS_MG))[(size_t)row * 1024 + col] = (bf16)f2bf(gr * v + gs * v2);
    } else if (MODE == MODE_X1) {
        const float x1 = a.x[(size_t)row * 1024 + col] + v;
        a.out[(size_t)row * 1024 + col] = x1; ((bf16*)(ws + WS_X1B))[(size_t)row * 1024 + col] = (bf16)f2bf(x1);
    } else if (MODE == MODE_PP) {
        ((bf16*)(ws + WS_PP))[(size_t)row * 1024 + col] = (bf16)f2bf(v);
    } else if (MODE == MODE_FINAL) {
        const float rstd2 = ((const float*)(ws + WS_RSTD2))[row], rstdp = ((const float*)(ws + WS_RSTDP))[row];
        const float ple = bf2f(((const bf16*)(ws + WS_PP))[(size_t)row * 1024 + col]) * rstdp * a.aux0[col];
        const float x2 = a.out[(size_t)row * 1024 + col];
        a.out[(size_t)row * 1024 + col] = x2 + sigmoidf_(rstd2 * v) * ple;
    }
}

template <int MODE> __global__ void __launch_bounds__(256) k_gemm_naive(NG_Args a) {
    __shared__ float As[16][68], Bs[16][68], As2[16][68], Bs2[16][68];
    const int tid = threadIdx.x, tx = tid & 15, ty = tid >> 4;
    const int m0 = blockIdx.y * 64, n0 = blockIdx.x * 64;
    float acc[4][4], acc2[4][4];
#pragma unroll
    for (int i = 0; i < 4; ++i)
#pragma unroll
        for (int j = 0; j < 4; ++j) { acc[i][j] = 0.f; acc2[i][j] = 0.f; }
    const int ar = tid >> 2, ak = (tid & 3) * 4;
    const int bk = tid >> 4, bn = (tid & 15) * 4;
    for (int k0 = 0; k0 < a.K; k0 += 16) {
        float av[4];
        if (a.a_is_f32) { const float4 t = *(const float4*)((const float*)a.A + (size_t)(m0 + ar) * a.lda + k0 + ak); av[0] = t.x; av[1] = t.y; av[2] = t.z; av[3] = t.w; }
        else { const uint2 t = *(const uint2*)((const bf16*)a.A + (size_t)(m0 + ar) * a.lda + k0 + ak); av[0] = bf2f(t.x & 0xffff); av[1] = bf2f(t.x >> 16); av[2] = bf2f(t.y & 0xffff); av[3] = bf2f(t.y >> 16); }
        float4 bv = *(const float4*)(a.B + (size_t)(k0 + bk) * a.ldb + n0 + bn);
        if (a.kscale) { const float s = a.kscale[k0 + bk]; bv.x *= s; bv.y *= s; bv.z *= s; bv.w *= s; }
#pragma unroll
        for (int i = 0; i < 4; ++i) As[ak + i][ar] = av[i];
        Bs[bk][bn] = bv.x; Bs[bk][bn + 1] = bv.y; Bs[bk][bn + 2] = bv.z; Bs[bk][bn + 3] = bv.w;
        if (MODE == MODE_MERGE) {
            const uint2 t = *(const uint2*)((const bf16*)a.A2 + (size_t)(m0 + ar) * a.lda + k0 + ak);
            As2[ak][ar] = bf2f(t.x & 0xffff); As2[ak + 1][ar] = bf2f(t.x >> 16); As2[ak + 2][ar] = bf2f(t.y & 0xffff); As2[ak + 3][ar] = bf2f(t.y >> 16);
            const float4 b2 = *(const float4*)(a.B2 + (size_t)(k0 + bk) * a.ldb + n0 + bn);
            Bs2[bk][bn] = b2.x; Bs2[bk][bn + 1] = b2.y; Bs2[bk][bn + 2] = b2.z; Bs2[bk][bn + 3] = b2.w;
        }
        __syncthreads();
#pragma unroll
        for (int kk = 0; kk < 16; ++kk) {
            float ra[4], rb[4];
#pragma unroll
            for (int i = 0; i < 4; ++i) { ra[i] = As[kk][ty * 4 + i]; rb[i] = Bs[kk][tx * 4 + i]; }
#pragma unroll
            for (int i = 0; i < 4; ++i)
#pragma unroll
                for (int j = 0; j < 4; ++j) acc[i][j] += ra[i] * rb[j];
            if (MODE == MODE_MERGE) {
#pragma unroll
                for (int i = 0; i < 4; ++i) { ra[i] = As2[kk][ty * 4 + i]; rb[i] = Bs2[kk][tx * 4 + i]; }
#pragma unroll
                for (int i = 0; i < 4; ++i)
#pragma unroll
                    for (int j = 0; j < 4; ++j) acc2[i][j] += ra[i] * rb[j];
            }
        }
        __syncthreads();
    }
#pragma unroll
    for (int i = 0; i < 4; ++i)
#pragma unroll
        for (int j = 0; j < 4; ++j) ng_store<MODE>(a, m0 + ty * 4 + i, n0 + tx * 4 + j, acc[i][j], acc2[i][j]);
}

__device__ __forceinline__ float ret_lg(int h) { return log1pf(-exp2f(-5.0f - (float)h)); }

__global__ void __launch_bounds__(256) k_ret_kv(unsigned char* ws) {
    const int bhn = blockIdx.x, n = bhn % NC, h = (bhn / NC) % RH, b = bhn / (NC * RH);
    const bf16* RK = (const bf16*)(ws + WS_RK); const bf16* RV = (const bf16*)(ws + WS_RV);
    float* KV = (float*)(ws + WS_KV) + (size_t)bhn * 128 * 128;
    const float lg = ret_lg(h);
    const size_t t0 = (size_t)b * SEQ + (size_t)n * RC;
    for (int o = threadIdx.x; o < 128 * 128; o += 256) {
        const int d = o >> 7, v = o & 127; float s = 0.f;
        for (int j = 0; j < 128; ++j) s += bf2f(RK[(t0 + j) * 512 + h * 128 + d]) * __expf((127.f - (float)j) * lg) * bf2f(RV[(t0 + j) * 512 + h * 128 + v]);
        KV[o] = s;
    }
}
__global__ void __launch_bounds__(256) k_ret_scan(unsigned char* ws) {
    const int gid = blockIdx.x * 256 + threadIdx.x;
    const int bh = gid >> 14, o = gid & 16383, d = o >> 7, v = o & 127, h = bh % RH;
    const float decay = __expf(128.f * ret_lg(h));
    const float* KV = (const float*)(ws + WS_KV); bf16* ST = (bf16*)(ws + WS_ST);
    float st = 0.f;
    for (int n = 0; n < NC; ++n) {
        const size_t bhn = (size_t)bh * NC + n;
        ST[bhn * 16384 + v * 128 + d] = (bf16)f2bf(st);
        st = decay * st + KV[bhn * 16384 + o];
    }
}
__global__ void __launch_bounds__(256) k_ret_out(unsigned char* ws, const float* gn_g, const float* gn_b) {
    extern __shared__ float sm[];
    float* sc = sm; float* yy = sm + 128 * 128;
    const int bhn = blockIdx.x, n = bhn % NC, h = (bhn / NC) % RH, b = bhn / (NC * RH);
    const bf16* RQ = (const bf16*)(ws + WS_RQ); const bf16* RK = (const bf16*)(ws + WS_RK); const bf16* RV = (const bf16*)(ws + WS_RV);
    const bf16* RG = (const bf16*)(ws + WS_RG); const bf16* ST = (const bf16*)(ws + WS_ST) + (size_t)bhn * 16384; bf16* AR = (bf16*)(ws + WS_AR);
    const float lg = ret_lg(h);
    const size_t t0 = (size_t)b * SEQ + (size_t)n * RC;
    for (int o = threadIdx.x; o < 128 * 128; o += 256) {
        const int i = o >> 7, j = o & 127; float s = 0.f;
        if (i >= j) { for (int d = 0; d < 128; ++d) s += bf2f(RQ[(t0 + i) * 512 + h * 128 + d]) * bf2f(RK[(t0 + j) * 512 + h * 128 + d]); s *= __expf((float)(i - j) * lg); }
        sc[o] = s;
    }
    __syncthreads();
    for (int o = threadIdx.x; o < 128 * 128; o += 256) {
        const int i = o >> 7, v = o & 127; float s = 0.f, c = 0.f;
        for (int j = 0; j <= i; ++j) s += sc[i * 128 + j] * bf2f(RV[(t0 + j) * 512 + h * 128 + v]);
        for (int d = 0; d < 128; ++d) c += bf2f(RQ[(t0 + i) * 512 + h * 128 + d]) * bf2f(ST[v * 128 + d]);
        yy[o] = s + c * __expf((float)(i + 1) * lg);
    }
    __syncthreads();
    if (threadIdx.x < 128) {
        const int i = threadIdx.x; float mu = 0.f;
        for (int v = 0; v < 128; ++v) mu += yy[i * 128 + ((v + i) & 127)];
        mu *= (1.f / 128.f); float var = 0.f;
        for (int v = 0; v < 128; ++v) { const float dd = yy[i * 128 + ((v + i) & 127)] - mu; var += dd * dd; }
        const float rstd = rsqrtf(var * (1.f / 128.f) + EPS);
        for (int v = 0; v < 128; ++v) { const int c = h * 128 + v; const float yn = (yy[i * 128 + v] - mu) * rstd * gn_g[c] + gn_b[c];
            AR[(t0 + i) * 512 + c] = (bf16)f2bf(bf2f(RG[(t0 + i) * 512 + c]) * yn); }
    }
}
__global__ void __launch_bounds__(256) k_swa(unsigned char* ws, const float* sinks) {
    const int gw = blockIdx.x * 4 + (threadIdx.x >> 6), lane = threadIdx.x & 63;
    const int t = gw >> 3, h = gw & 7, kvh = h >> 2, tpos = t & (SEQ - 1), tb = t - tpos;
    const bf16* SQ = (const bf16*)(ws + WS_SQ); const bf16* SK = (const bf16*)(ws + WS_SK); const bf16* SV = (const bf16*)(ws + WS_SV);
    const float q = bf2f(SQ[(size_t)t * 512 + h * 64 + lane]);
    const float slope2 = exp2f(-8.0f * (float)(h + 1) / 8.0f) * LOG2E;
    const float sink2 = sinks[h] * LOG2E;
    float m = sink2, l = 1.f, o = 0.f;
    const int lo = tpos - (WIN - 1) < 0 ? 0 : tpos - (WIN - 1);
    for (int kp = lo; kp <= tpos; ++kp) {
        const size_t tk = (size_t)(tb + kp);
        float s = wave_sum(q * bf2f(SK[tk * 128 + kvh * 64 + lane])) - slope2 * (float)(tpos - kp);
        const float mn = fmaxf(m, s), f = exp2f(m - mn), pp = exp2f(s - mn);
        l = l * f + pp; o = o * f + pp * bf2f(SV[tk * 128 + kvh * 64 + lane]); m = mn;
    }
    ((bf16*)(ws + WS_AS))[(size_t)t * 512 + h * 64 + lane] = (bf16)f2bf(o / l);
}
__global__ void __launch_bounds__(256) k_router(unsigned char* ws, const float* x1, const float* g, const float* wrg, const float* brg, const float* wre, const float* bre) {
    const int t = blockIdx.x * 4 + (threadIdx.x >> 6), lane = threadIdx.x & 63;
    float hv[16]; float ss = 0.f;
#pragma unroll
    for (int j = 0; j < 16; ++j) { hv[j] = x1[(size_t)t * D + j * 64 + lane]; ss += hv[j] * hv[j]; }
    const float rstd = rsqrtf(wave_sum(ss) * (1.f / D) + EPS);
#pragma unroll
    for (int j = 0; j < 16; ++j) hv[j] *= rstd * g[j * 64 + lane];
    float lgts[4], le[32];
#pragma unroll
    for (int o = 0; o < 4; ++o) { float s = 0.f;
#pragma unroll
        for (int j = 0; j < 16; ++j) s += hv[j] * wrg[(size_t)(j * 64 + lane) * 4 + o];
        lgts[o] = wave_sum(s) + brg[o]; }
#pragma unroll
    for (int o = 0; o < 32; ++o) { float s = 0.f;
#pragma unroll
        for (int j = 0; j < 16; ++j) s += hv[j] * wre[(size_t)(j * 64 + lane) * 32 + o];
        le[o] = wave_sum(s) + bre[o]; }
    float gm = lgts[0]; int gs = 0;
#pragma unroll
    for (int o = 1; o < 4; ++o) if (lgts[o] > gm) { gm = lgts[o]; gs = o; }
    float gden = 0.f;
#pragma unroll
    for (int o = 0; o < 4; ++o) gden += __expf(lgts[o] - gm);
    const float gw = 1.f / gden;
    float e8[8];
#pragma unroll
    for (int o = 0; o < 8; ++o) { e8[o] = gs == 0 ? le[o] : gs == 1 ? le[8 + o] : gs == 2 ? le[16 + o] : le[24 + o]; }
    float m1 = e8[0]; int i1 = 0;
#pragma unroll
    for (int o = 1; o < 8; ++o) if (e8[o] > m1) { m1 = e8[o]; i1 = o; }
    float m2 = -3.0e38f; int i2 = 0;
#pragma unroll
    for (int o = 0; o < 8; ++o) if (o != i1 && e8[o] > m2) { m2 = e8[o]; i2 = o; }
    const float p2 = __expf(m2 - m1), inv = 1.f / (1.f + p2);
    if (lane == 0) {
        ((float*)(ws + WS_RSTD1))[t] = rstd;
        ((int*)(ws + WS_SEL))[t * 2] = gs * 8 + i1; ((int*)(ws + WS_SEL))[t * 2 + 1] = gs * 8 + i2;
        ((float*)(ws + WS_CW))[t * 2] = gw * inv; ((float*)(ws + WS_CW))[t * 2 + 1] = gw * p2 * inv;
    }
}
__global__ void __launch_bounds__(256) k_moe_up(unsigned char* ws, const float* g, const float* wg, const float* wu) {
    const int tk = blockIdx.x, t = tk >> 1, f = threadIdx.x;
    const int e = ((const int*)(ws + WS_SEL))[tk]; const float cw = ((const float*)(ws + WS_CW))[tk], rstd = ((const float*)(ws + WS_RSTD1))[t];
    const bf16* xb = (const bf16*)(ws + WS_X1B) + (size_t)t * D;
    const float* Wg = wg + (size_t)e * D * FF; const float* Wu = wu + (size_t)e * D * FF;
    float a = 0.f, u = 0.f;
    for (int d = 0; d < D; ++d) { const float hv = bf2f(xb[d]) * g[d]; a += hv * Wg[(size_t)d * FF + f]; u += hv * Wu[(size_t)d * FF + f]; }
    a *= rstd; u *= rstd;
    ((bf16*)(ws + WS_HIDN))[(size_t)tk * FF + f] = (bf16)f2bf(a * sigmoidf_(a) * u * cw);
}
__global__ void __launch_bounds__(256) k_moe_down(unsigned char* ws, float* out, const float* wd) {
    const int t = blockIdx.x, c0 = threadIdx.x * 4;
    float4 acc = *(const float4*)(out + (size_t)t * D + c0);
    for (int k = 0; k < 2; ++k) {
        const int e = ((const int*)(ws + WS_SEL))[t * 2 + k]; const float* Wd = wd + (size_t)e * FF * D;
        const bf16* hid = (const bf16*)(ws + WS_HIDN) + (size_t)(t * 2 + k) * FF;
        for (int f = 0; f < FF; ++f) { const float hv = bf2f(hid[f]); const float4 w = *(const float4*)(Wd + (size_t)f * D + c0); acc.x += hv * w.x; acc.y += hv * w.y; acc.z += hv * w.z; acc.w += hv * w.w; }
    }
    *(float4*)(out + (size_t)t * D + c0) = acc;
}
__global__ void __launch_bounds__(256) k_x2_stats(unsigned char* ws, const float* x2) {
    const int row = blockIdx.x * 4 + (threadIdx.x >> 6), lane = threadIdx.x & 63;
    const float4* xr = (const float4*)(x2 + (size_t)row * D) + lane; float s = 0.f;
#pragma unroll
    for (int j = 0; j < 4; ++j) { const float4 v = xr[64 * j]; s += v.x * v.x + v.y * v.y + v.z * v.z + v.w * v.w;
        uint2 o; o.x = f2bf(v.x) | (f2bf(v.y) << 16); o.y = f2bf(v.z) | (f2bf(v.w) << 16); ((uint2*)((bf16*)(ws + WS_X2B) + (size_t)row * D))[lane + 64 * j] = o; }
    s = wave_sum(s);
    if (lane == 0) ((float*)(ws + WS_RSTD2))[row] = rsqrtf(s * (1.f / D) + EPS);
}
__global__ void __launch_bounds__(256) k_pp_stats(unsigned char* ws) {
    const int row = blockIdx.x * 4 + (threadIdx.x >> 6), lane = threadIdx.x & 63;
    const bf16* pr = (const bf16*)(ws + WS_PP) + (size_t)row * D; float s = 0.f;
#pragma unroll
    for (int j = 0; j < 16; ++j) { const float v = bf2f(pr[j * 64 + lane]); s += v * v; }
    s = wave_sum(s);
    if (lane == 0) ((float*)(ws + WS_RSTDP))[row] = rsqrtf(s * (1.f / D) + EPS);
}

extern "C" void kernel_launch(void* const* d_in, const int* in_sizes, int n_in, void* d_out, int out_size, void* d_ws, size_t ws_size, hipStream_t stream) {
    static int grid = 0;
    if (grid == 0) {
        if (n_in != 24 || in_sizes[0] != T * D || out_size != T * D || ws_size < WS_END) { fprintf(stderr, "kernel_launch: unexpected shapes (n_in %d, in0 %d, out %d, ws %zu); nothing launched\n", n_in, n_in > 0 ? in_sizes[0] : -1, out_size, ws_size); grid = -1; return; }
        int dev = 0, cus = 0, per_cu = 0;
        if (hipGetDevice(&dev) != hipSuccess || hipDeviceGetAttribute(&cus, hipDeviceAttributeMultiprocessorCount, dev) != hipSuccess) { grid = -1; return; }
        if (hipFuncSetAttribute((const void*)mk_fwd, hipFuncAttributeMaxDynamicSharedMemorySize, LDS_BYTES) != hipSuccess) { fprintf(stderr, "kernel_launch: hipFuncSetAttribute failed\n"); grid = -1; return; }
        if (hipOccupancyMaxActiveBlocksPerMultiprocessor(&per_cu, (const void*)mk_fwd, NWAVES * 64, LDS_BYTES) != hipSuccess || per_cu < 1) { fprintf(stderr, "kernel_launch: occupancy query says %d workgroups per CU\n", per_cu); }
        (void)hipGetLastError();
        grid = cus;
        (void)hipFuncSetAttribute((const void*)k_ret_out, hipFuncAttributeMaxDynamicSharedMemorySize, 131072);
    }
    if (grid < 0) return;
    const float* x = (const float*)d_in[0]; const float* p = (const float*)d_in[1];
    const float* gn_g = (const float*)d_in[4]; const float* gn_b = (const float*)d_in[5]; const float* w_ret_o = (const float*)d_in[6];
    const float* sinks = (const float*)d_in[9];
    const float* w_swa_o = (const float*)d_in[10]; const float* w_out = (const float*)d_in[11]; const float* ffn_g = (const float*)d_in[12];
    const float* wrg = (const float*)d_in[13]; const float* brg = (const float*)d_in[14]; const float* wre = (const float*)d_in[15]; const float* bre = (const float*)d_in[16];
    const float* weg = (const float*)d_in[17]; const float* weu = (const float*)d_in[18]; const float* wed = (const float*)d_in[19];
    const float* pg_g = (const float*)d_in[20]; const float* w_pg = (const float*)d_in[21]; const float* w_ple = (const float*)d_in[22]; const float* ple_g = (const float*)d_in[23];
    unsigned char* ws = (unsigned char*)d_ws; float* out = (float*)d_out;

    Args a{};
    for (int i = 0; i < 24; ++i) a.in[i] = (const float*)d_in[i];
    a.out = out; a.ws = ws;
#define MK(lo, hi) do { (void)hipMemsetAsync(ws + WS_CTL, 0, CTL_ZERO_BYTES, stream); a.ph_lo = (lo); a.ph_hi = (hi); hipLaunchKernelGGL(mk_fwd, dim3(grid), dim3(NWAVES * 64), LDS_BYTES, stream, a); } while (0)
    MK(0, 2);

    k_ret_kv<<<BATCH * RH * NC, 256, 0, stream>>>(ws);
    k_ret_scan<<<16 * 16384 / 256, 256, 0, stream>>>(ws);
    k_swa<<<T * SH / 4, 256, 0, stream>>>(ws, sinks);
    k_ret_out<<<BATCH * RH * NC, 256, 131072, stream>>>(ws, gn_g, gn_b);
    MK(5, 7);
    k_router<<<T / 4, 256, 0, stream>>>(ws, out, ffn_g, wrg, brg, wre, bre);
    k_moe_up<<<T * 2, 256, 0, stream>>>(ws, ffn_g, weg, weu);
    k_moe_down<<<T, 256, 0, stream>>>(ws, out, wed);
    k_x2_stats<<<T / 4, 256, 0, stream>>>(ws, out);
    MK(7, 8);
    k_pp_stats<<<T / 4, 256, 0, stream>>>(ws);
    MK(11, 12);
}
```

```cpp
#include <hip/hip_runtime.h>
#include <cstdio>
#include <cstdint>

constexpr int BATCH = 4, SEQ = 4096, T = BATCH * SEQ, D = 1024;
constexpr int PLE = 256;
constexpr float EPS = 1e-6f;
constexpr int RH = 4, RDK = 128, RC = 128, NC = SEQ / RC;
constexpr int SH = 8, SKV = 2, SG = 4, HD = 64, WIN = 128;
constexpr int NE = 32, EPG = 8, NG = 4, FF = 256;
constexpr int INW = 4864;
constexpr float LOG2E = 1.4426950408889634f;
constexpr float QSCALE = 0.125f * LOG2E;
constexpr float KSCALE = 0.08838834764831845f;

typedef unsigned short bf16;
__device__ __forceinline__ unsigned f2bf(float f) { unsigned u = __builtin_bit_cast(unsigned, f); return (u + 0x7fffu + ((u >> 16) & 1u)) >> 16; }
__device__ __forceinline__ unsigned pk2(float lo, float hi) { return f2bf(lo) | (f2bf(hi) << 16); }
__device__ __forceinline__ float bf2f(bf16 h) { return __builtin_bit_cast(float, (unsigned)h << 16); }
__device__ __forceinline__ float wave_sum(float v) {
#pragma unroll
    for (int o = 1; o < 64; o <<= 1) v += __shfl_xor(v, o);
    return v;
}
__device__ __forceinline__ float sigmoidf_(float x) { return __builtin_amdgcn_rcpf(1.f + __expf(-x)); }

constexpr size_t MiB = 1u << 20;
constexpr size_t WS_CTL = 0, CTL_ZERO_BYTES = 1 * MiB;
constexpr size_t WS_WIN = 1 * MiB;
constexpr size_t WS_WRO = 11 * MiB;
constexpr size_t WS_WSO = 12 * MiB;
constexpr size_t WS_WOUT = 13 * MiB;
constexpr size_t WS_WPG = 15 * MiB;
constexpr size_t WS_WPLE = 17 * MiB;
constexpr size_t WS_WRT = 17 * MiB + 512 * 1024;
constexpr size_t WS_XN = 18 * MiB;
constexpr size_t WS_KV = 18 * MiB;
constexpr size_t WS_MG = 18 * MiB;
constexpr size_t WS_X2B = 18 * MiB;
constexpr size_t WS_RQ = 50 * MiB, WS_RK = 66 * MiB, WS_RV = 82 * MiB, WS_RG = 98 * MiB;
constexpr size_t WS_SQ = 114 * MiB;
constexpr size_t WS_SK = 130 * MiB, WS_SV = 134 * MiB;
constexpr size_t WS_GR = 138 * MiB, WS_GS = 170 * MiB;
constexpr size_t WS_ST = 202 * MiB;
constexpr size_t WS_AS = 218 * MiB, WS_AR = 234 * MiB;
constexpr size_t WS_MISC = 250 * MiB;
constexpr size_t WS_RSTD1 = WS_MISC, WS_RSTD2 = WS_MISC + 65536, WS_RSTDP = WS_MISC + 2 * 65536;
constexpr size_t WS_SEL = WS_MISC + 3 * 65536;
constexpr size_t WS_CW = WS_SEL + 131072;
constexpr size_t WS_SSP = 251 * MiB;
constexpr size_t WS_X1B = 50 * MiB;
constexpr size_t WS_HIDN = 130 * MiB;
constexpr size_t WS_PP = 216 * MiB;
constexpr size_t WS_PB = 152 * MiB;
constexpr size_t WS_WGU = 82 * MiB;
constexpr size_t WS_WD = 114 * MiB;
constexpr size_t WS_HID = 130 * MiB;
constexpr size_t WS_Y = 152 * MiB;
constexpr size_t WS_LIST = 252 * MiB;
constexpr size_t WS_END = 256 * MiB;
constexpr int CW_CNT = 8192;
constexpr int CW_BAR = 4096;

namespace pg8 {
#define PG8_LAS __attribute__((address_space(3)))
typedef unsigned short bf16_t;
typedef short bf16x8 __attribute__((ext_vector_type(8)));
typedef float f32x4 __attribute__((ext_vector_type(4)));
typedef unsigned u32x4 __attribute__((ext_vector_type(4)));
constexpr int BM = 256, BK = 64, HALF = 128, HTB = HALF * BK * 2  , STAGE_BYTES = 8 * HTB, NXCD = 8, WGM = 8;

__host__ __device__ __forceinline__ int lds_byte(int r, int c) { const int st = (r >> 4) * 2 + (c >> 5), rr = r & 15, cc = c & 31, ob = rr * 64 + cc * 2; return st * 1024 + (ob ^ (((ob >> 9) & 1) << 5)); }
__host__ __device__ __forceinline__ void stage_rc(int b, int& R, int& C) { const int st = b / 1024, sb = b % 1024, swz = sb ^ (((sb >> 9) & 1) << 5); R = (st >> 1) * 16 + swz / 64; C = (st & 1) * 32 + (swz % 64) / 2; }
__host__ __device__ __forceinline__ int perm32(int rho) { const int n = rho >> 4, i = rho & 15; return 8 * (i >> 2) + 4 * n + (i & 3); }
struct Unit { int pm, pn; const char* a; const char* b; int tag, aux; };

__device__ __forceinline__ void tile_of(int L, int nM, int nN, int& pm, int& pn) {
    const int nwg = nM * nN; int wgid = L; { const int q = nwg / NXCD, r = nwg % NXCD, xcd = wgid % NXCD, off = wgid / NXCD; wgid = (xcd < r ? xcd * (q + 1) : r * (q + 1) + (xcd - r) * q) + off; }
    const int nig = WGM * nN, gid = wgid / nig, fm = gid * WGM, gsz = (nM - fm) < WGM ? (nM - fm) : WGM;
    pm = fm + ((wgid % nig) % gsz); pn = (wgid % nig) / gsz;
}
struct TileOrder {
    int nM, nN, nwg, G, c; const char* A; const char* Bt; size_t tstep;
    __device__ void init(const void* A_, const void* Bt_, int M, int N, int K, int G_, int c_) { nM = M / BM; nN = N / BM; nwg = nM * nN; G = G_; c = c_; A = (const char*)A_; Bt = (const char*)Bt_; tstep = (size_t)BM * K * 2; }
    __device__ bool next(int i, Unit& u) const {
        const long L = (long)i * G + c; if (L >= nwg) return false;
        tile_of((int)L, nM, nN, u.pm, u.pn); u.a = A + (size_t)u.pm * tstep; u.b = Bt + (size_t)u.pn * tstep; u.tag = 0; u.aux = 0; return true;
    }
    static constexpr bool GATHER = false;
};
struct TwoPassOrder {
    int nM, nN, nwg, G, c; const char* A0; const char* A1; const char* B0; const char* B1; size_t tstep;
    __device__ void init(const void* A0_, const void* B0_, const void* A1_, const void* B1_, int M, int N, int K, int G_, int c_) { nM = M / BM; nN = N / BM; nwg = nM * nN; G = G_; c = c_;
        A0 = (const char*)A0_; A1 = (const char*)A1_; B0 = (const char*)B0_; B1 = (const char*)B1_; tstep = (size_t)BM * K * 2; }
    __device__ bool next(int i, Unit& u) const {
        const long L = (long)(i >> 1) * G + c; if (L >= nwg) return false;
        tile_of((int)L, nM, nN, u.pm, u.pn); u.aux = 0; u.tag = i & 1; u.a = (u.tag ? A1 : A0) + (size_t)u.pm * tstep; u.b = (u.tag ? B1 : B0) + (size_t)u.pn * tstep; return true;
    }
    static constexpr bool GATHER = false;
};

__device__ __forceinline__ unsigned cvt_pk_bf16(float lo, float hi) { unsigned r; asm volatile("v_cvt_pk_bf16_f32 %0, %1, %2" : "=v"(r) : "v"(lo), "v"(hi)); return r; }
__device__ __forceinline__ u32x4 pack8(const f32x4 v0, const f32x4 v1) { u32x4 w; w.x = cvt_pk_bf16(v0[0], v0[1]); w.y = cvt_pk_bf16(v0[2], v0[3]); w.z = cvt_pk_bf16(v1[0], v1[1]); w.w = cvt_pk_bf16(v1[2], v1[3]); return w; }
__device__ __forceinline__ float sigm(float x) { return __builtin_amdgcn_rcpf(1.f + __expf(-x)); }

struct EpiZ {
    static constexpr bool PERM = true, AFTER_DRAIN = false;
    unsigned char* ws; const float* qg; const float* kg;
    __device__ __forceinline__ void operator()(const f32x4 (&acc)[2][2][4][2], const Unit& u, int wr, int wc, int fr, int fq) const {
        const int pn = u.pn; const int row0 = u.pm * BM + wr * 64 + fr;
        if (pn < 8 || pn >= 11) {
            int kind, ld, colt; bf16_t* base;
            if (pn < 8) { kind = pn >> 1; base = (bf16_t*)(ws + WS_RQ + (size_t)kind * (16 * MiB)); ld = 512; colt = (pn & 1) * 256; }
            else { const int g = pn - 11; kind = 4; base = (bf16_t*)(ws + WS_GR + (size_t)(g >> 2) * (32 * MiB)); ld = 1024; colt = (g & 3) * 256; }
            const int col0 = colt + wc * 32 + 8 * fq;
#pragma unroll
            for (int ai = 0; ai < 2; ++ai)
#pragma unroll
                for (int m = 0; m < 4; ++m) { bf16_t* rowp = base + (size_t)(row0 + ai * HALF + m * 16) * ld + col0;
#pragma unroll
                    for (int bj = 0; bj < 2; ++bj) { f32x4 v0 = acc[ai][bj][m][0], v1 = acc[ai][bj][m][1];
                        if (kind == 1) { v0 = v0 * KSCALE; v1 = v1 * KSCALE; }
                        else if (kind == 3) {
#pragma unroll
                            for (int j = 0; j < 4; ++j) { v0[j] = v0[j] * sigm(v0[j]); v1[j] = v1[j] * sigm(v1[j]); } }
                        else if (kind == 4) {
#pragma unroll
                            for (int j = 0; j < 4; ++j) { v0[j] = sigm(v0[j]); v1[j] = sigm(v1[j]); } }
                        *(u32x4*)(rowp + bj * HALF) = pack8(v0, v1); } }
        } else {
            const bool isq = pn < 10, isk = (pn == 10) && (wc < 2);
            f32x4 gv[2][2];
#pragma unroll
            for (int bj = 0; bj < 2; ++bj)
#pragma unroll
                for (int n = 0; n < 2; ++n) { const int dd = 32 * bj + 8 * fq + 4 * n;
                    gv[bj][n] = isq ? *(const f32x4*)(qg + dd) * QSCALE : isk ? *(const f32x4*)(kg + dd) : (f32x4){1.f, 1.f, 1.f, 1.f}; }
            bf16_t* base; int ld;
            if (isq) { base = (bf16_t*)(ws + WS_SQ) + (pn - 8) * 256 + 64 * wc + 8 * fq; ld = 512; }
            else if (isk) { base = (bf16_t*)(ws + WS_SK) + 64 * wc + 8 * fq; ld = 128; }
            else { base = (bf16_t*)(ws + WS_SV) + 64 * (wc - 2) + 8 * fq; ld = 128; }
#pragma unroll
            for (int ai = 0; ai < 2; ++ai)
#pragma unroll
                for (int m = 0; m < 4; ++m) {
                    float ss = 0.f;
#pragma unroll
                    for (int bj = 0; bj < 2; ++bj)
#pragma unroll
                        for (int n = 0; n < 2; ++n) { const f32x4 x = acc[ai][bj][m][n]; ss += (x[0] * x[0] + x[1] * x[1]) + (x[2] * x[2] + x[3] * x[3]); }
                    ss += __shfl_xor(ss, 16); ss += __shfl_xor(ss, 32);
                    const float rstd = (isq || isk) ? rsqrtf(ss * (1.f / 64.f) + EPS) : 1.f;
                    bf16_t* rowp = base + (size_t)(row0 + ai * HALF + m * 16) * ld;
#pragma unroll
                    for (int bj = 0; bj < 2; ++bj) *(u32x4*)(rowp + 32 * bj) = pack8(acc[ai][bj][m][0] * rstd * gv[bj][0], acc[ai][bj][m][1] * rstd * gv[bj][1]); }
        }
    }
};


__device__ __forceinline__ void unpack8(const u32x4 w, f32x4& v0, f32x4& v1) {
    v0[0] = __builtin_bit_cast(float, w.x << 16); v0[1] = __builtin_bit_cast(float, w.x & 0xffff0000u); v0[2] = __builtin_bit_cast(float, w.y << 16); v0[3] = __builtin_bit_cast(float, w.y & 0xffff0000u);
    v1[0] = __builtin_bit_cast(float, w.z << 16); v1[1] = __builtin_bit_cast(float, w.z & 0xffff0000u); v1[2] = __builtin_bit_cast(float, w.w << 16); v1[3] = __builtin_bit_cast(float, w.w & 0xffff0000u);
}
typedef unsigned u32x2 __attribute__((ext_vector_type(2)));
__device__ __forceinline__ f32x4 unpack4(const u32x2 w) { f32x4 v; v[0] = __builtin_bit_cast(float, w.x << 16); v[1] = __builtin_bit_cast(float, w.x & 0xffff0000u); v[2] = __builtin_bit_cast(float, w.y << 16); v[3] = __builtin_bit_cast(float, w.y & 0xffff0000u); return v; }

struct EpiMerge {
    static constexpr bool PERM = true, AFTER_DRAIN = false;
    const bf16_t* GR; const bf16_t* GS; bf16_t* MG;
    __device__ __forceinline__ void operator()(const f32x4 (&acc)[2][2][4][2], const Unit& u, int wr, int wc, int fr, int fq) const {
        const int row0 = u.pm * BM + wr * 64 + fr, col0 = u.pn * BM + wc * 32 + 8 * fq; const bf16_t* G = u.tag ? GS : GR;
#pragma unroll
        for (int ai = 0; ai < 2; ++ai)
#pragma unroll
            for (int m = 0; m < 4; ++m) { const size_t off = (size_t)(row0 + ai * HALF + m * 16) * D + col0;
#pragma unroll
                for (int bj = 0; bj < 2; ++bj) { f32x4 g0, g1; unpack8(*(const u32x4*)(G + off + bj * HALF), g0, g1);
                    f32x4 v0 = acc[ai][bj][m][0] * g0, v1 = acc[ai][bj][m][1] * g1;
                    if (u.tag) { f32x4 p0, p1; unpack8(*(const u32x4*)(MG + off + bj * HALF), p0, p1); v0 = v0 + p0; v1 = v1 + p1; }
                    *(u32x4*)(MG + off + bj * HALF) = pack8(v0, v1); } }
    }
};
struct EpiX1 {
    static constexpr bool PERM = false, AFTER_DRAIN = false;
    const float* x; float* out; bf16_t* xb;
    __device__ __forceinline__ void operator()(const f32x4 (&acc)[2][2][4][2], const Unit& u, int wr, int wc, int fr, int fq) const {
        const int row0 = u.pm * BM + wr * 64 + fr, col0 = u.pn * BM + wc * 32 + 4 * fq;
#pragma unroll
        for (int ai = 0; ai < 2; ++ai)
#pragma unroll
            for (int m = 0; m < 4; ++m) { const size_t off = (size_t)(row0 + ai * HALF + m * 16) * D + col0;
#pragma unroll
                for (int bj = 0; bj < 2; ++bj)
#pragma unroll
                    for (int n = 0; n < 2; ++n) { const size_t o = off + bj * HALF + n * 16; const f32x4 v = *(const f32x4*)(x + o) + acc[ai][bj][m][n];
                        *(f32x4*)(out + o) = v; u32x2 w; w.x = cvt_pk_bf16(v[0], v[1]); w.y = cvt_pk_bf16(v[2], v[3]); *(u32x2*)(xb + o) = w; } }
    }
};
struct EpiPP {
    static constexpr bool PERM = true, AFTER_DRAIN = false;
    bf16_t* PP; float* SSP;
    __device__ __forceinline__ void operator()(const f32x4 (&acc)[2][2][4][2], const Unit& u, int wr, int wc, int fr, int fq) const {
        const int row0 = u.pm * BM + wr * 64 + fr, col0 = u.pn * BM + wc * 32 + 8 * fq;
#pragma unroll
        for (int ai = 0; ai < 2; ++ai)
#pragma unroll
            for (int m = 0; m < 4; ++m) { const int row = row0 + ai * HALF + m * 16; float ss = 0.f;
#pragma unroll
                for (int bj = 0; bj < 2; ++bj) { const f32x4 a = acc[ai][bj][m][0], b = acc[ai][bj][m][1];
                    ss += (a[0] * a[0] + a[1] * a[1]) + (a[2] * a[2] + a[3] * a[3]) + (b[0] * b[0] + b[1] * b[1]) + (b[2] * b[2] + b[3] * b[3]);
                    *(u32x4*)(PP + (size_t)row * D + col0 + bj * HALF) = pack8(a, b); }
                ss += __shfl_xor(ss, 16); ss += __shfl_xor(ss, 32);
                if (fq == 0) SSP[(size_t)row * 16 + u.pn * 4 + wc] = ss; }
    }
};
struct EpiFinal {
    static constexpr bool PERM = false, AFTER_DRAIN = false;
    float* out; const bf16_t* PP; const float* rstd2; const float* rstdp; const float* pleg;
    __device__ __forceinline__ void operator()(const f32x4 (&acc)[2][2][4][2], const Unit& u, int wr, int wc, int fr, int fq) const {
        const int row0 = u.pm * BM + wr * 64 + fr, col0 = u.pn * BM + wc * 32 + 4 * fq;
        f32x4 gv[2][2];
#pragma unroll
        for (int bj = 0; bj < 2; ++bj)
#pragma unroll
            for (int n = 0; n < 2; ++n) gv[bj][n] = *(const f32x4*)(pleg + col0 + bj * HALF + n * 16);
#pragma unroll
        for (int ai = 0; ai < 2; ++ai)
#pragma unroll
            for (int m = 0; m < 4; ++m) { const int row = row0 + ai * HALF + m * 16; const size_t off = (size_t)row * D + col0; const float r2 = rstd2[row], rp = rstdp[row];
#pragma unroll
                for (int bj = 0; bj < 2; ++bj)
#pragma unroll
                    for (int n = 0; n < 2; ++n) { const size_t o = off + bj * HALF + n * 16; const f32x4 x2 = *(const f32x4*)(out + o); const f32x4 pp = unpack4(*(const u32x2*)(PP + o)); const f32x4 a = acc[ai][bj][m][n];
                        f32x4 r;
#pragma unroll
                        for (int j = 0; j < 4; ++j) r[j] = x2[j] + sigm(r2 * a[j]) * (pp[j] * rp * gv[bj][n][j]);
                        *(f32x4*)(out + o) = r; } }
    }
};


struct MoeTables { const PG8_LAS int* cnt; const PG8_LAS int* pre; };
struct MoeUpOrder {
    MoeTables tb; int G, c; const char* X1B; const char* WGU; const int* LIST;
    __device__ bool next(int i, Unit& u) const {
        const int L = i * G + c; if (L >= tb.pre[32] * 2) return false;
        const int rtg = L >> 1; int e = 0; while (tb.pre[e + 1] <= rtg) ++e;
        u.pm = rtg - tb.pre[e]; u.pn = L & 1; u.tag = e; u.aux = rtg * 256; u.a = X1B; u.b = WGU + (size_t)e * (512 * 1024 * 2) + (size_t)u.pn * (256 * 1024 * 2); return true;
    }
    static constexpr bool GATHER = true;
    __device__ __forceinline__ void a_off(const Unit& u, int tid, int K, PG8_LAS unsigned short* tab) const {
        const int cnt = tb.cnt[u.tag]; const int* lst = LIST + u.tag * 16384;
#pragma unroll
        for (int i = 0; i < 2; ++i) { int R, C; stage_rc(tid * 16 + i * 8192, R, C); const int s0 = u.pm * 256 + R, s1 = s0 + HALF;
            const int t0 = s0 < cnt ? lst[s0] >> 1 : 0, t1 = s1 < cnt ? lst[s1] >> 1 : 0;
            tab[(0 * 2 + i) * 512] = (unsigned short)t0; tab[(1 * 2 + i) * 512] = (unsigned short)t1; }
    }
};
struct MoeDownOrder {
    MoeTables tb; int G, c; const char* HID; const char* WD;
    __device__ bool next(int i, Unit& u) const {
        const int L = i * G + c; if (L >= tb.pre[32] * 4) return false;
        const int rtg = L >> 2; int e = 0; while (tb.pre[e + 1] <= rtg) ++e;
        u.pm = rtg; u.pn = L & 3; u.tag = e; u.aux = rtg - tb.pre[e]; u.a = HID + (size_t)rtg * (256 * 256 * 2); u.b = WD + (size_t)e * (1024 * 256 * 2) + (size_t)u.pn * (256 * 256 * 2); return true;
    }
    static constexpr bool GATHER = false;
};
struct EpiUp {
    static constexpr bool PERM = true, AFTER_DRAIN = false;
    MoeTables tb; const int* LIST; const float* RSTD1; const float* CW; bf16_t* HID;
    __device__ __forceinline__ void operator()(const f32x4 (&acc)[2][2][4][2], const Unit& u, int wr, int wc, int fr, int fq) const {
        const int cnt = tb.cnt[u.tag]; const int* lst = LIST + u.tag * 16384 + u.pm * 256;
#pragma unroll
        for (int ai = 0; ai < 2; ++ai)
#pragma unroll
            for (int m = 0; m < 4; ++m) { const int r = ai * HALF + wr * 64 + m * 16 + fr; const bool valid = u.pm * 256 + r < cnt;
                const int tk = valid ? lst[r] : 0; const float rs = RSTD1[tk >> 1], cw = valid ? CW[tk] : 0.f;
                f32x4 h0, h1;
#pragma unroll
                for (int j = 0; j < 4; ++j) { const float g0 = acc[ai][0][m][0][j] * rs, g1 = acc[ai][0][m][1][j] * rs;
                    h0[j] = g0 * sigm(g0) * (acc[ai][1][m][0][j] * rs) * cw; h1[j] = g1 * sigm(g1) * (acc[ai][1][m][1][j] * rs) * cw; }
                *(u32x4*)(HID + (size_t)(u.aux + r) * 256 + 128 * u.pn + 32 * wc + 8 * fq) = pack8(h0, h1); }
    }
};
struct EpiDown {
    static constexpr bool PERM = true, AFTER_DRAIN = false;
    MoeTables tb; const int* LIST; bf16_t* Y;
    __device__ __forceinline__ void operator()(const f32x4 (&acc)[2][2][4][2], const Unit& u, int wr, int wc, int fr, int fq) const {
        const int cnt = tb.cnt[u.tag]; const int* lst = LIST + u.tag * 16384 + u.aux * 256; const int col0 = u.pn * BM + wc * 32 + 8 * fq;
#pragma unroll
        for (int ai = 0; ai < 2; ++ai)
#pragma unroll
            for (int m = 0; m < 4; ++m) { const int r = ai * HALF + wr * 64 + m * 16 + fr; const bool valid = u.aux * 256 + r < cnt;
                if (valid) { bf16_t* rowp = Y + (size_t)lst[r] * D + col0;
#pragma unroll
                    for (int bj = 0; bj < 2; ++bj) *(u32x4*)(rowp + bj * HALF) = pack8(acc[ai][bj][m][0], acc[ai][bj][m][1]); } }
    }
};

template <class Epi, class Sched>
__device__ __forceinline__ void gemm_phase(PG8_LAS unsigned char* lds, const int K, const Sched& S, const Epi& E, PG8_LAS unsigned short* gtab = nullptr) {
    constexpr bool GATHER = Sched::GATHER;
    const int tid = threadIdx.x, wid = __builtin_amdgcn_readfirstlane(tid >> 6), lane = tid & 63, wr = wid >> 2, wc = wid & 3, fr = lane & 15, fq = lane >> 4;
    const int nt = K / BK;
    unsigned voffA[2], voffB[2], cA2[2];
#pragma unroll
    for (int i = 0; i < 2; ++i) { int R, C; stage_rc(tid * 16 + i * 8192, R, C); const int Rb = Epi::PERM ? ((R & ~31) + perm32(R & 31)) : R;
        voffA[i] = (unsigned)(R * K + C) * 2u; cA2[i] = (unsigned)C * 2u; voffB[i] = (unsigned)(Rb * K + C) * 2u; }
    const size_t kstep = (size_t)(BK * 2);
    const size_t hstep = (size_t)HALF * K * 2;
    const unsigned ldsw = (unsigned)wid * 1024u;
    const int aoff = lds_byte(wr * 64 + fr, fq * 8), boff = lds_byte(wc * 32 + fr, fq * 8);
#define PG8_SA(b, h) (((b) * 2 + (h)) * HTB)
#define PG8_SB(b, h) ((4 + (b) * 2 + (h)) * HTB)
#define PG8_STAGE(bufoff, gbase, voff) do { _Pragma("unroll") for (int _i = 0; _i < 2; ++_i) \
        __builtin_amdgcn_global_load_lds((const unsigned*)((const char*)(gbase) + (voff)[_i]), (PG8_LAS unsigned*)(lds + (bufoff) + ldsw + _i * 8192), 16, 0, 0); } while (0)
#define PG8_STAGE_A(bufoff, gbase, un, h) do { if constexpr (GATHER) { unsigned _o[2]; _o[0] = (unsigned)gtab[((((ui + (un)) & 1) * 2 + (h)) * 2 + 0) * 512 + tid] * (unsigned)(K * 2) + cA2[0]; _o[1] = (unsigned)gtab[((((ui + (un)) & 1) * 2 + (h)) * 2 + 1) * 512 + tid] * (unsigned)(K * 2) + cA2[1]; PG8_STAGE(bufoff, gbase, _o); } \
        else { PG8_STAGE(bufoff, (gbase) + (h) * hstep, voffA); } } while (0)
#define PG8_LDA(dst, b, h) do { _Pragma("unroll") for (int m = 0; m < 4; ++m) _Pragma("unroll") for (int k = 0; k < 2; ++k) dst[m][k] = *(const PG8_LAS bf16x8*)(lds + PG8_SA(b, h) + aoff + m * 2048 + k * 1024); } while (0)
#define PG8_LDB(dst, b, h) do { _Pragma("unroll") for (int n = 0; n < 2; ++n) _Pragma("unroll") for (int k = 0; k < 2; ++k) dst[n][k] = *(const PG8_LAS bf16x8*)(lds + PG8_SB(b, h) + boff + n * 2048 + k * 1024); } while (0)
#define PG8_MMA(ai, bj, At, Bt) do { __builtin_amdgcn_s_setprio(1); _Pragma("unroll") for (int m = 0; m < 4; ++m) _Pragma("unroll") for (int n = 0; n < 2; ++n) _Pragma("unroll") for (int k = 0; k < 2; ++k) \
        acc[ai][bj][m][n] = __builtin_amdgcn_mfma_f32_16x16x32_bf16(Bt[n][k], At[m][k], acc[ai][bj][m][n], 0, 0, 0); __builtin_amdgcn_s_setprio(0); } while (0)
#define PG8_WAIT_V(n) asm volatile("s_waitcnt vmcnt(" #n ")" ::: "memory")
#define PG8_WAIT_L(n) asm volatile("s_waitcnt lgkmcnt(" #n ")" ::: "memory")
#define PG8_BAR __builtin_amdgcn_s_barrier()
#define PG8_SCHED __builtin_amdgcn_sched_barrier(0)
    Unit cur, nxt; int ui = 0;
    if (!S.next(0, cur)) return;
    f32x4 acc[2][2][4][2];
#pragma unroll
    for (int a = 0; a < 2; ++a)
#pragma unroll
        for (int b = 0; b < 2; ++b)
#pragma unroll
            for (int m = 0; m < 4; ++m)
#pragma unroll
                for (int n = 0; n < 2; ++n) acc[a][b][m][n] = (f32x4){0.f, 0.f, 0.f, 0.f};
    bf16x8 At[4][2], B0[2][2], B1[2][2];
    const char* cA = cur.a; const char* cB = cur.b;
    if constexpr (GATHER) S.a_off(cur, tid, K, gtab + 0 * 2048 + tid);
    PG8_STAGE(PG8_SB(0, 0), cB, voffB); PG8_STAGE(PG8_SB(0, 1), cB + hstep, voffB); PG8_STAGE_A(PG8_SA(0, 0), cA, 0, 0); PG8_STAGE_A(PG8_SA(0, 1), cA, 0, 1);
    if (wr == 1) PG8_BAR;
    PG8_WAIT_V(2); PG8_BAR;
    PG8_STAGE(PG8_SB(1, 0), cB + kstep, voffB); PG8_STAGE_A(PG8_SA(1, 0), cA + kstep, 0, 0); PG8_STAGE(PG8_SB(1, 1), cB + hstep + kstep, voffB);
    PG8_WAIT_V(6); PG8_BAR;
    for (;;) {
        const bool has_next = S.next(ui + 1, nxt);
        if constexpr (GATHER) S.a_off(has_next ? nxt : cur, tid, K, gtab + ((ui + 1) & 1) * 2048 + tid);
        const char* nA = has_next ? nxt.a : cA; const char* nB = has_next ? nxt.b : cB;
        for (int t = 0; t < nt; t += 2) {
            const bool last = (t == nt - 2);
            const char* a1 = cA + (size_t)(t + 1) * kstep;
            const char* a2 = last ? nA : cA + (size_t)(t + 2) * kstep; const char* b2 = last ? nB : cB + (size_t)(t + 2) * kstep;
            const char* a3 = a2 + kstep; const char* b3 = b2 + kstep;
            const int un = last ? 1 : 0;
            PG8_LDB(B0, 0, 0); PG8_LDB(B1, 0, 1); PG8_SCHED; PG8_LDA(At, 0, 0); PG8_STAGE_A(PG8_SA(1, 1), a1, 0, 1);
            PG8_WAIT_V(8); PG8_WAIT_L(0); PG8_BAR; PG8_MMA(0, 0, At, B0); PG8_MMA(0, 1, At, B1); PG8_BAR; PG8_SCHED;
            PG8_LDA(At, 0, 1); PG8_STAGE(PG8_SB(0, 0), b2, voffB); PG8_STAGE(PG8_SB(0, 1), b2 + hstep, voffB); PG8_STAGE_A(PG8_SA(0, 0), a2, un, 0);
            PG8_WAIT_V(8); PG8_WAIT_L(0); PG8_BAR; PG8_MMA(1, 0, At, B0); PG8_MMA(1, 1, At, B1); PG8_BAR; PG8_SCHED;
            PG8_LDB(B0, 1, 0); PG8_LDB(B1, 1, 1); PG8_SCHED; PG8_LDA(At, 1, 0); PG8_STAGE_A(PG8_SA(0, 1), a2, un, 1);
            PG8_WAIT_V(8); PG8_WAIT_L(0); PG8_BAR; PG8_MMA(0, 0, At, B0); PG8_MMA(0, 1, At, B1); PG8_BAR; PG8_SCHED;
            PG8_LDA(At, 1, 1); PG8_STAGE(PG8_SB(1, 0), b3, voffB); PG8_STAGE(PG8_SB(1, 1), b3 + hstep, voffB); PG8_STAGE_A(PG8_SA(1, 0), a3, un, 0);
            PG8_WAIT_V(8); PG8_WAIT_L(0); PG8_BAR; PG8_MMA(1, 0, At, B0); PG8_MMA(1, 1, At, B1); PG8_BAR; PG8_SCHED;
        }
        if (wr == 0) PG8_BAR;
        E(acc, cur, wr, wc, fr, fq);
        if (!has_next) break;
#pragma unroll
        for (int a = 0; a < 2; ++a)
#pragma unroll
            for (int b = 0; b < 2; ++b)
#pragma unroll
                for (int m = 0; m < 4; ++m)
#pragma unroll
                    for (int n = 0; n < 2; ++n) acc[a][b][m][n] = (f32x4){0.f, 0.f, 0.f, 0.f};
        cur = nxt; cA = nA; cB = nB; ++ui;
        if (wr == 1) PG8_BAR;
    }
    PG8_WAIT_V(0);
    PG8_BAR;
#undef PG8_SA
#undef PG8_SB
#undef PG8_STAGE
#undef PG8_STAGE_A
#undef PG8_LDA
#undef PG8_LDB
#undef PG8_MMA
#undef PG8_WAIT_V
#undef PG8_WAIT_L
#undef PG8_BAR
#undef PG8_SCHED
}
}
#define GAS __attribute__((address_space(1)))
#define LAS __attribute__((address_space(3)))
typedef unsigned v4u __attribute__((ext_vector_type(4)));
typedef float f32x4 __attribute__((ext_vector_type(4)));
typedef short bf16x8 __attribute__((ext_vector_type(8)));
typedef GAS unsigned gu32;
typedef GAS unsigned long long gu64;
#define RLX_AGENT __ATOMIC_RELAXED, __HIP_MEMORY_SCOPE_AGENT
#define LDS_WAIT() asm volatile("s_waitcnt lgkmcnt(0)" ::: "memory")
#define VM_WAIT() asm volatile("s_waitcnt vmcnt(0)" ::: "memory")
__device__ __forceinline__ unsigned long long rt() { return __builtin_amdgcn_s_memrealtime(); }


#define XB_TMO      128
#define XB_XCNT(j)  (256  + 64 * (j))
#define XB_XSUB(j)  (1280 + 64 * (j))
#define XB_XGEN(j)  (2304 + 64 * (j))
#define XB_TOP      3328
#define XB_TOPGEN   3392
#define XCD_BAR_WORDS 3456
#define XB_SPIN_CAP (1u << 18)

__device__ __forceinline__ unsigned xb_ld(unsigned* p)              { return __hip_atomic_load(p, __ATOMIC_RELAXED, __HIP_MEMORY_SCOPE_AGENT); }
__device__ __forceinline__ unsigned xb_add(unsigned* p, unsigned v) { return __hip_atomic_fetch_add(p, v, __ATOMIC_RELAXED, __HIP_MEMORY_SCOPE_AGENT); }
__device__ __forceinline__ unsigned xb_xcc_id() { return (unsigned)__builtin_amdgcn_s_getreg((3 << 11) | 20) & 0xFu; }
#define XB_SPIN(cond, bar) do { unsigned _sp = 0; while (cond) { __builtin_amdgcn_s_sleep(1); \
    if ((++_sp & 255u) == 0u) { if (xb_ld(&(bar)[XB_TMO])) break; if (_sp > XB_SPIN_CAP) { atomicAdd(&(bar)[XB_TMO], 1u); break; } } } } while (0)

struct XcdBarrier {
    unsigned* bar; unsigned x;
    volatile LAS unsigned* st;
};

__device__ __forceinline__ XcdBarrier xcd_barrier_post(unsigned* bar, volatile LAS unsigned* st) {
    XcdBarrier b; b.bar = bar; b.x = xb_xcc_id(); b.st = st;
    if (threadIdx.x == 0) (void)xb_add(&bar[XB_XCNT(b.x)], 1u);
    return b;
}
__device__ __forceinline__ void xcd_barrier_complete(unsigned* bar, unsigned x, unsigned& nloc, unsigned& nx) {
    const unsigned G = gridDim.x * gridDim.y * gridDim.z;
    unsigned sum, cnt, mine, sp = 0u;
    for (;;) {
        sum = 0u; cnt = 0u; mine = 0u;
#pragma unroll
        for (unsigned j = 0; j < 16; ++j) { const unsigned c = xb_ld(&bar[XB_XCNT(j)]); sum += c; cnt += (c > 0u) ? 1u : 0u; mine = (j == x) ? c : mine; }
        if (sum == G) break;
        __builtin_amdgcn_s_sleep(1);
        if ((++sp & 255u) == 0u) { if (xb_ld(&bar[XB_TMO])) break; if (sp > XB_SPIN_CAP) { atomicAdd(&bar[XB_TMO], 1u); break; } }
    }
    nloc = mine > 0u ? mine : 1u; nx = cnt > 0u ? cnt : 1u;
}

__device__ __forceinline__ void xcd_barrier(const XcdBarrier& b) {
    asm volatile("s_waitcnt vmcnt(0)" ::: "memory");
    __syncthreads();
    if (threadIdx.x == 0) {
        unsigned* bar = b.bar;
        __builtin_amdgcn_s_waitcnt(0);
        unsigned nloc = b.st[0], nx = b.st[1];
        if (nloc == 0u) { xcd_barrier_complete(bar, b.x, nloc, nx); b.st[0] = nloc; b.st[1] = nx; }
        const unsigned old = xb_add(&bar[XB_XSUB(b.x)], 1u);
        const unsigned gen = old / nloc;
        if (old + 1u == (gen + 1u) * nloc) {
            __builtin_amdgcn_fence(__ATOMIC_RELEASE, "agent");
            asm volatile("s_waitcnt vmcnt(0)" ::: "memory");
            const unsigned og = xb_add(&bar[XB_TOP], 1u);
            const unsigned tg = og / nx;
            if (og + 1u == (tg + 1u) * nx) xb_add(&bar[XB_TOPGEN], 1u);
            else XB_SPIN(xb_ld(&bar[XB_TOPGEN]) == tg, bar);
            __builtin_amdgcn_fence(__ATOMIC_ACQUIRE, "agent");
            xb_add(&bar[XB_XGEN(b.x)], 1u);
            asm volatile("s_waitcnt vmcnt(0)" ::: "memory");
        } else {
            XB_SPIN(xb_ld(&bar[XB_XGEN(b.x)]) == gen, bar);
            __builtin_amdgcn_fence(__ATOMIC_ACQUIRE, "agent");
            asm volatile("s_waitcnt vmcnt(0)" ::: "memory");
        }
    }
    __syncthreads();
}
constexpr int NWAVES = 8;
constexpr int RING_OFF = 0, RING_BYTES = 131072;
constexpr int LDSCTL_OFF = RING_BYTES, MISC_OFF = LDSCTL_OFF + 320;
constexpr int GTAB_OFF = LDSCTL_OFF + 2048;
constexpr int LDS_BYTES = 147456;

__device__ __forceinline__ void p0_transpose_item(const float* W, int ldw, int k0, int ns0, bf16* WT, int ldt, int nd0, const float* ks, LAS float* scr, int lane) {
#pragma unroll 8
    for (int i = 0; i < 32; ++i) { const int kk = 2 * i + (lane >> 5); scr[kk * 33 + (lane & 31)] = W[(size_t)(k0 + kk) * ldw + ns0 + (lane & 31)]; }
    LDS_WAIT(); asm volatile("" ::: "memory");
    const int c = lane & 7;
    float sc[8];
#pragma unroll
    for (int i = 0; i < 8; ++i) sc[i] = ks ? ks[k0 + 8 * c + i] : 1.f;
#pragma unroll
    for (int j = 0; j < 4; ++j) { const int n = (lane >> 3) + 8 * j; const LAS float* s = scr + (8 * c) * 33 + n;
        v4u o; o.x = pk2(s[0 * 33] * sc[0], s[1 * 33] * sc[1]); o.y = pk2(s[2 * 33] * sc[2], s[3 * 33] * sc[3]); o.z = pk2(s[4 * 33] * sc[4], s[5 * 33] * sc[5]); o.w = pk2(s[6 * 33] * sc[6], s[7 * 33] * sc[7]);
        *(GAS v4u*)(WT + (size_t)(nd0 + n) * ldt + k0 + 8 * c) = o; }
    LDS_WAIT(); asm volatile("" ::: "memory");
}
__device__ __forceinline__ void rms_row_to_bf16(const float* xrow, const float* g, bf16* orow, int lane) {
    const GAS f32x4* xr = (const GAS f32x4*)xrow + lane;
    f32x4 v[4]; float s = 0.f;
#pragma unroll
    for (int j = 0; j < 4; ++j) { v[j] = xr[64 * j]; s += (v[j].x * v[j].x + v[j].y * v[j].y) + (v[j].z * v[j].z + v[j].w * v[j].w); }
    const float rstd = rsqrtf(wave_sum(s) * (1.f / D) + EPS);
    GAS unsigned long long* o8 = (GAS unsigned long long*)orow + lane;
#pragma unroll
    for (int j = 0; j < 4; ++j) { const f32x4 gg = ((const GAS f32x4*)g)[lane + 64 * j];
        o8[64 * j] = (unsigned long long)pk2(v[j].x * rstd * gg.x, v[j].y * rstd * gg.y) | ((unsigned long long)pk2(v[j].z * rstd * gg.z, v[j].w * rstd * gg.w) << 32); }
}

struct Args { const float* in[24]; float* out; unsigned char* ws; int ph_lo, ph_hi; };
enum { I_X = 0, I_P, I_MIXG, I_WIN, I_GNG, I_GNB, I_WRO, I_QG, I_KG, I_SINK, I_WSO, I_WOUT, I_FFNG, I_WRG, I_BRG, I_WRE, I_BRE, I_WEG, I_WEU, I_WED, I_PGG, I_WPG, I_WPLE, I_PLEG };

__device__ __forceinline__ void p0_prologue(const Args& A, LAS unsigned char* lds, int vcu, int G, int wave, int lane) {
    LAS float* scr = (LAS float*)(lds + RING_OFF + wave * 16384);
    unsigned char* ws = A.ws;
    const int gw = vcu * NWAVES + wave, NGW = G * NWAVES;
    constexpr int I_IN = 16 * 152, I_RO = 8 * 32, I_SO = 8 * 32, I_OUT = 16 * 32, I_PG = 16 * 32, I_PL = 4 * 32;
    constexpr int NITEMS = I_IN + I_RO + I_SO + I_OUT + I_PG + I_PL;
    for (int it = gw; it < NITEMS; it += NGW) {
        int r = it;
        if (r < I_IN) { const int kb = r / 152, nb = r % 152, pn = nb >> 3, q = nb & 7; int ns0 = 32 * nb;
            if (pn >= 8 && pn <= 10) ns0 = 256 * pn + 32 * (((q & 3) << 1) | (q >> 2));
            p0_transpose_item(A.in[I_WIN], INW, 64 * kb, ns0, (bf16*)(ws + WS_WIN), D, 32 * nb, nullptr, scr, lane); continue; } r -= I_IN;
        if (r < I_RO) { p0_transpose_item(A.in[I_WRO], D, 64 * (r / 32), 32 * (r % 32), (bf16*)(ws + WS_WRO), 512, 32 * (r % 32), nullptr, scr, lane); continue; } r -= I_RO;
        if (r < I_SO) { p0_transpose_item(A.in[I_WSO], D, 64 * (r / 32), 32 * (r % 32), (bf16*)(ws + WS_WSO), 512, 32 * (r % 32), nullptr, scr, lane); continue; } r -= I_SO;
        if (r < I_OUT) { p0_transpose_item(A.in[I_WOUT], D, 64 * (r / 32), 32 * (r % 32), (bf16*)(ws + WS_WOUT), D, 32 * (r % 32), nullptr, scr, lane); continue; } r -= I_OUT;
        if (r < I_PG) { p0_transpose_item(A.in[I_WPG], D, 64 * (r / 32), 32 * (r % 32), (bf16*)(ws + WS_WPG), D, 32 * (r % 32), A.in[I_PGG], scr, lane); continue; } r -= I_PG;
        p0_transpose_item(A.in[I_WPLE], D, 64 * (r / 32), 32 * (r % 32), (bf16*)(ws + WS_WPLE), PLE, 32 * (r % 32), nullptr, scr, lane);
    }
    { const float* g = A.in[I_FFNG]; const float* wrg = A.in[I_WRG]; const float* wre = A.in[I_WRE]; float* wrt = (float*)(ws + WS_WRT);
      for (int idx = gw * 64 + lane; idx < 36 * D; idx += NGW * 64) { const int o = idx >> 10, k = idx & 1023; wrt[idx] = g[k] * (o < 4 ? wrg[k * 4 + o] : wre[k * 32 + (o - 4)]); } }
    for (int m = gw; m < T; m += NGW) rms_row_to_bf16(A.in[I_X] + (size_t)m * D, A.in[I_MIXG], (bf16*)(ws + WS_XN) + (size_t)m * D, lane);
}


__device__ __forceinline__ void router_block(const Args& A, LAS unsigned char* sc, int rb, int tid, int wave, int lane) {
    unsigned char* ws = A.ws;
    LAS float* dots = (LAS float*)sc; LAS float* rsl = (LAS float*)(sc + 9216); LAS unsigned* lcnt = (LAS unsigned*)(sc + 9216 + 256); LAS unsigned* lbase = lcnt + 32;
    const float* x1 = A.out; const float* wrt = (const float*)(ws + WS_WRT);
    if (tid < 32) lcnt[tid] = 0u;
    const int row0 = rb * 64 + wave * 8;
    float xv[8][16];
#pragma unroll
    for (int r = 0; r < 8; ++r) { float ss = 0.f;
#pragma unroll
        for (int j = 0; j < 16; ++j) { xv[r][j] = x1[(size_t)(row0 + r) * D + j * 64 + lane]; ss += xv[r][j] * xv[r][j]; }
        ss = wave_sum(ss); if (lane == 0) rsl[wave * 8 + r] = rsqrtf(ss * (1.f / D) + EPS); }
    const int myr = ((lane >> 5) & 1) * 4 + ((lane >> 4) & 1) * 2 + ((lane >> 3) & 1);
    for (int o = 0; o < 36; ++o) {
        float w[16], acc[8];
#pragma unroll
        for (int j = 0; j < 16; ++j) w[j] = wrt[o * D + j * 64 + lane];
#pragma unroll
        for (int r = 0; r < 8; ++r) { float s = 0.f;
#pragma unroll
            for (int j = 0; j < 16; ++j) s += xv[r][j] * w[j];
            acc[r] = s; }
        { const bool up = (lane & 32) != 0;
#pragma unroll
          for (int i = 0; i < 4; ++i) { const float keep = up ? acc[i + 4] : acc[i], send = up ? acc[i] : acc[i + 4]; acc[i] = keep + __shfl_xor(send, 32); } }
        { const bool up = (lane & 16) != 0;
#pragma unroll
          for (int i = 0; i < 2; ++i) { const float keep = up ? acc[i + 2] : acc[i], send = up ? acc[i] : acc[i + 2]; acc[i] = keep + __shfl_xor(send, 16); } }
        { const bool up = (lane & 8) != 0; const float keep = up ? acc[1] : acc[0], send = up ? acc[0] : acc[1]; acc[0] = keep + __shfl_xor(send, 8); }
        float v = acc[0]; v += __shfl_xor(v, 4); v += __shfl_xor(v, 2); v += __shfl_xor(v, 1);
        if ((lane & 7) == 0) dots[(wave * 8 + myr) * 36 + o] = v;
    }
    __syncthreads();
    int e1 = 0, e2 = 0; unsigned lp1 = 0, lp2 = 0; const int row = row0 + lane;
    if (lane < 8) {
        const float rstd = rsl[wave * 8 + lane]; const LAS float* dr = dots + (wave * 8 + lane) * 36;
        float lg[4], le[32];
#pragma unroll
        for (int o = 0; o < 4; ++o) lg[o] = dr[o] * rstd + A.in[I_BRG][o];
#pragma unroll
        for (int o = 0; o < 32; ++o) le[o] = dr[4 + o] * rstd + A.in[I_BRE][o];
        float gm = lg[0]; int gs = 0;
#pragma unroll
        for (int o = 1; o < 4; ++o) if (lg[o] > gm) { gm = lg[o]; gs = o; }
        float gden = 0.f;
#pragma unroll
        for (int o = 0; o < 4; ++o) gden += __expf(lg[o] - gm);
        const float gw = 1.f / gden;
        float e8[8];
#pragma unroll
        for (int o = 0; o < 8; ++o) e8[o] = gs == 0 ? le[o] : gs == 1 ? le[8 + o] : gs == 2 ? le[16 + o] : le[24 + o];
        float m1 = e8[0]; int i1 = 0;
#pragma unroll
        for (int o = 1; o < 8; ++o) if (e8[o] > m1) { m1 = e8[o]; i1 = o; }
        float m2 = -3.0e38f; int i2 = 0;
#pragma unroll
        for (int o = 0; o < 8; ++o) if (o != i1 && e8[o] > m2) { m2 = e8[o]; i2 = o; }
        const float p2 = __expf(m2 - m1), inv = 1.f / (1.f + p2);
        e1 = gs * 8 + i1; e2 = gs * 8 + i2;
        ((float*)(ws + WS_RSTD1))[row] = rstd;
        ((float*)(ws + WS_CW))[row * 2] = gw * inv; ((float*)(ws + WS_CW))[row * 2 + 1] = gw * p2 * inv;
        lp1 = __hip_atomic_fetch_add(lcnt + e1, 1u, __ATOMIC_RELAXED, __HIP_MEMORY_SCOPE_WORKGROUP);
        lp2 = __hip_atomic_fetch_add(lcnt + e2, 1u, __ATOMIC_RELAXED, __HIP_MEMORY_SCOPE_WORKGROUP);
    }
    __syncthreads();
    if (tid < 32) { const unsigned n = lcnt[tid]; lbase[tid] = n ? __hip_atomic_fetch_add((unsigned*)(ws + WS_CTL) + CW_CNT + 64 * tid, n, __ATOMIC_RELAXED, __HIP_MEMORY_SCOPE_AGENT) : 0u; }
    __syncthreads();
    if (lane < 8) { int* LIST = (int*)(ws + WS_LIST);
        LIST[e1 * 16384 + (int)(lbase[e1] + lp1)] = row * 2; LIST[e2 * 16384 + (int)(lbase[e2] + lp2)] = row * 2 + 1; }
    __syncthreads();
}
__device__ __forceinline__ void p7_expert_weights(const Args& A, LAS unsigned char* lds, int vcu, int G, int wave, int lane) {
    LAS float* scr = (LAS float*)(lds + RING_OFF + wave * 16384);
    unsigned char* ws = A.ws; const int gw = vcu * NWAVES + wave, NGW = G * NWAVES;
    constexpr int I_GU = NE * 16 * 16, I_DN = NE * 4 * 32;
    for (int it = gw; it < I_GU + I_DN; it += NGW) {
        if (it < I_GU) { const int e = it >> 8, r = it & 255, kb = r >> 4, nbd = r & 15, pn = nbd >> 3, bj = (nbd >> 2) & 1, jb = nbd & 3;
            const float* W = (bj ? A.in[I_WEU] : A.in[I_WEG]) + (size_t)e * D * FF;
            p0_transpose_item(W, FF, 64 * kb, 128 * pn + 32 * jb, (bf16*)(ws + WS_WGU) + (size_t)e * 512 * D, D, 32 * nbd, A.in[I_FFNG], scr, lane); }
        else { const int r2 = it - I_GU, e = r2 >> 7, r = r2 & 127, kb = r >> 5, nb = r & 31;
            p0_transpose_item(A.in[I_WED] + (size_t)e * FF * D, D, 64 * kb, 32 * nb, (bf16*)(ws + WS_WD) + (size_t)e * D * FF, FF, 32 * nb, nullptr, scr, lane); }
    }
}
__device__ __forceinline__ pg8::MoeTables moe_tables(unsigned char* ws, LAS unsigned char* tb, int tid) {
    LAS int* cnt = (LAS int*)tb; LAS int* pre = cnt + 32;
    if (tid < 32) cnt[tid] = (int)__hip_atomic_load((unsigned*)(ws + WS_CTL) + CW_CNT + 64 * tid, __ATOMIC_RELAXED, __HIP_MEMORY_SCOPE_AGENT);
    __syncthreads();
    if (tid == 0) { int s = 0; for (int e = 0; e < 32; ++e) { pre[e] = s; s += (cnt[e] + 255) >> 8; } pre[32] = s; }
    __syncthreads();
    return pg8::MoeTables{cnt, pre};
}
__device__ __forceinline__ void combine_row(const Args& A, int t, int lane) {
    unsigned char* ws = A.ws;
    GAS f32x4* xr = (GAS f32x4*)(A.out + (size_t)t * D) + lane;
    const GAS pg8::u32x2* y0 = (const GAS pg8::u32x2*)((const bf16*)(ws + WS_Y) + (size_t)(2 * t) * D) + lane; const GAS pg8::u32x2* y1 = y0 + D / 4;
    GAS pg8::u32x2* xb = (GAS pg8::u32x2*)((bf16*)(ws + WS_X2B) + (size_t)t * D) + lane;
    float s = 0.f;
#pragma unroll
    for (int j = 0; j < 4; ++j) { const f32x4 v = xr[64 * j] + pg8::unpack4(y0[64 * j]) + pg8::unpack4(y1[64 * j]);
        s += (v.x * v.x + v.y * v.y) + (v.z * v.z + v.w * v.w); xr[64 * j] = v;
        pg8::u32x2 w; w.x = pk2(v.x, v.y); w.y = pk2(v.z, v.w); xb[64 * j] = w; }
    s = wave_sum(s);
    float sp = lane < 16 ? ((const float*)(ws + WS_SSP))[(size_t)t * 16 + lane] : 0.f; sp = wave_sum(sp);
    if (lane == 0) { ((float*)(ws + WS_RSTD2))[t] = rsqrtf(s * (1.f / D) + EPS); ((float*)(ws + WS_RSTDP))[t] = rsqrtf(sp * (1.f / D) + EPS); }
}

constexpr int N_PHASES = 12;
__global__ void __launch_bounds__(NWAVES * 64, 2) mk_fwd(Args args) {
    extern __shared__ __attribute__((aligned(16))) unsigned char lds_raw[];
    LAS unsigned char* lds = (LAS unsigned char*)lds_raw;
    volatile LAS unsigned* MISC = (volatile LAS unsigned*)(lds + MISC_OFF);
    const int tid = threadIdx.x, lane = tid & 63, wave = __builtin_amdgcn_readfirstlane(tid >> 6);
    const int G = gridDim.x; const int bx = blockIdx.x; const int vcu = (G % 8 == 0) ? (bx % 8) * (G / 8) + bx / 8 : bx;
    unsigned char* ws = args.ws;
    gu32* ctl = (gu32*)(ws + WS_CTL);
    for (int u = tid; u < (LDS_BYTES - LDSCTL_OFF) / 4; u += NWAVES * 64) ((LAS unsigned*)(lds + LDSCTL_OFF))[u] = 0u;
    __syncthreads();
    XcdBarrier bar = xcd_barrier_post((unsigned*)(ctl + CW_BAR), MISC + 8);
    const int lo = args.ph_lo, hi = args.ph_hi;
#define IN(k) (lo <= (k) && (k) < hi)
#define BOTH(k) (IN(k) && IN((k) + 1))
#define GRID_BAR() xcd_barrier(bar)

    if (IN(0)) { p0_prologue(args, lds, vcu, G, wave, lane); if (BOTH(0)) GRID_BAR(); }

    if (IN(1)) {
        pg8::TileOrder S; S.init(ws + WS_XN, ws + WS_WIN, T, INW, D, G, bx);
        pg8::EpiZ E{ws, args.in[I_QG], args.in[I_KG]};
        pg8::gemm_phase<pg8::EpiZ, pg8::TileOrder>(lds + RING_OFF, D, S, E);
        if (BOTH(1)) GRID_BAR();
    }

    if (IN(5)) {
        pg8::TwoPassOrder S; S.init(ws + WS_AR, ws + WS_WRO, ws + WS_AS, ws + WS_WSO, T, D, 512, G, bx);
        pg8::EpiMerge E{(const bf16*)(ws + WS_GR), (const bf16*)(ws + WS_GS), (bf16*)(ws + WS_MG)};
        pg8::gemm_phase<pg8::EpiMerge, pg8::TwoPassOrder>(lds + RING_OFF, 512, S, E);
        if (BOTH(5)) GRID_BAR();
    }
    if (IN(6)) {
        { const int gw = vcu * NWAVES + wave, NGW = G * NWAVES;
          for (int m = gw; m < T; m += NGW) { const f32x4 v = ((const GAS f32x4*)(args.in[I_P] + (size_t)m * PLE))[lane];
              ((GAS unsigned long long*)((bf16*)(ws + WS_PB) + (size_t)m * PLE))[lane] = (unsigned long long)pk2(v.x, v.y) | ((unsigned long long)pk2(v.z, v.w) << 32); } }
        pg8::TileOrder S; S.init(ws + WS_MG, ws + WS_WOUT, T, D, D, G, bx);
        pg8::EpiX1 E{args.in[I_X], args.out, (bf16*)(ws + WS_X1B)};
        pg8::gemm_phase<pg8::EpiX1, pg8::TileOrder>(lds + RING_OFF, D, S, E);
        if (BOTH(6)) GRID_BAR();
    }
    if (IN(7)) {
        for (int rb = bx; rb < T / 64; rb += G) router_block(args, lds + RING_OFF, rb, tid, wave, lane);
        p7_expert_weights(args, lds, vcu, G, wave, lane);
        __syncthreads();
        pg8::TileOrder S; S.init(ws + WS_PB, ws + WS_WPLE, T, D, PLE, G, bx);
        pg8::EpiPP E{(bf16*)(ws + WS_PP), (float*)(ws + WS_SSP)};
        pg8::gemm_phase<pg8::EpiPP, pg8::TileOrder>(lds + RING_OFF, PLE, S, E);
        if (BOTH(7)) GRID_BAR();
    }
    if (IN(8)) {
        const pg8::MoeTables tb = moe_tables(ws, lds + LDSCTL_OFF + 1024, tid);
        pg8::MoeUpOrder S{tb, G, bx, (const char*)(ws + WS_X1B), (const char*)(ws + WS_WGU), (const int*)(ws + WS_LIST)};
        pg8::EpiUp E{tb, (const int*)(ws + WS_LIST), (const float*)(ws + WS_RSTD1), (const float*)(ws + WS_CW), (bf16*)(ws + WS_HID)};
        pg8::gemm_phase<pg8::EpiUp, pg8::MoeUpOrder>(lds + RING_OFF, D, S, E, (LAS unsigned short*)(lds + GTAB_OFF));
        if (BOTH(8)) GRID_BAR();
    }
    if (IN(9)) {
        const pg8::MoeTables tb = moe_tables(ws, lds + LDSCTL_OFF + 1024, tid);
        pg8::MoeDownOrder S{tb, G, bx, (const char*)(ws + WS_HID), (const char*)(ws + WS_WD)};
        pg8::EpiDown E{tb, (const int*)(ws + WS_LIST), (bf16*)(ws + WS_Y)};
        pg8::gemm_phase<pg8::EpiDown, pg8::MoeDownOrder>(lds + RING_OFF, FF, S, E);
        if (BOTH(9)) GRID_BAR();
    }
    if (IN(10)) {
        const int gw = vcu * NWAVES + wave, NGW = G * NWAVES;
        for (int t = gw; t < T; t += NGW) combine_row(args, t, lane);
        if (BOTH(10)) GRID_BAR();
    }
    if (IN(11)) {
        pg8::TileOrder S; S.init(ws + WS_X2B, ws + WS_WPG, T, D, D, G, bx);
        pg8::EpiFinal E{args.out, (const bf16*)(ws + WS_PP), (const float*)(ws + WS_RSTD2), (const float*)(ws + WS_RSTDP), args.in[I_PLEG]};
        pg8::gemm_phase<pg8::EpiFinal, pg8::TileOrder>(lds + RING_OFF, D, S, E);
    }
#undef IN
#undef BOTH
#undef GRID_BAR
}

__global__ void __launch_bounds__(256) k_rmsnorm_bf16(const float* x, const float* g, bf16* out) {
    const int row = blockIdx.x * 4 + (threadIdx.x >> 6), lane = threadIdx.x & 63;
    const float4* xr = (const float4*)(x + (size_t)row * D) + lane;
    float4 v[4]; float s = 0.f;
#pragma unroll
    for (int j = 0; j < 4; ++j) { v[j] = xr[64 * j]; s += v[j].x * v[j].x + v[j].y * v[j].y + v[j].z * v[j].z + v[j].w * v[j].w; }
    const float rstd = rsqrtf(wave_sum(s) * (1.f / D) + EPS);
#pragma unroll
    for (int j = 0; j < 4; ++j) { const float4 gg = ((const float4*)g)[lane + 64 * j];
        uint2 o; o.x = f2bf(v[j].x * rstd * gg.x) | (f2bf(v[j].y * rstd * gg.y) << 16); o.y = f2bf(v[j].z * rstd * gg.z) | (f2bf(v[j].w * rstd * gg.w) << 16);
        ((uint2*)(out + (size_t)row * D))[lane + 64 * j] = o; }
}

struct NG_Args {
    const void* A; int lda; int a_is_f32; const float* B; int ldb; const float* kscale; int M, N, K;
    const void* A2; const float* B2;
    unsigned char* ws; const float* x; float* out; const float* aux0;
};
enum { MODE_Z = 1, MODE_MERGE = 2, MODE_X1 = 3, MODE_PP = 4, MODE_FINAL = 5 };

template <int MODE> __device__ __forceinline__ void ng_store(const NG_Args& a, int row, int col, float v, float v2) {
    unsigned char* ws = a.ws;
    if (MODE == MODE_Z) {
        if (col < 512) ((bf16*)(ws + WS_RQ))[(size_t)row * 512 + col] = (bf16)f2bf(v);
        else if (col < 1024) ((bf16*)(ws + WS_RK))[(size_t)row * 512 + col - 512] = (bf16)f2bf(v * 0.08838834764831845f);
        else if (col < 1536) ((bf16*)(ws + WS_RV))[(size_t)row * 512 + col - 1024] = (bf16)f2bf(v);
        else if (col < 2048) ((bf16*)(ws + WS_RG))[(size_t)row * 512 + col - 1536] = (bf16)f2bf(v * sigmoidf_(v));
        else if (col < 2816) ((bf16*)(ws + WS_SV))[(size_t)row * 128 + col - 2688] = (bf16)f2bf(v);
        else if (col < 3840) ((bf16*)(ws + WS_GR))[(size_t)row * 1024 + col - 2816] = (bf16)f2bf(sigmoidf_(v));
        else ((bf16*)(ws + WS_GS))[(size_t)row * 1024 + col - 3840] = (bf16)f2bf(sigmoidf_(v));
    } else if (MODE == MODE_MERGE) {
        const float gr = bf2f(((const bf16*)(ws + WS_GR))[(size_t)row * 1024 + col]), gs = bf2f(((const bf16*)(ws + WS_GS))[(size_t)row * 1024 + col]);
        ((bf16*)(ws + WS_MG))[(size_t)row * 1024 + col] = (bf16)f2bf(gr * v + gs * v2);
    } else if (MODE == MODE_X1) {
        const float x1 = a.x[(size_t)row * 1024 + col] + v;
        a.out[(size_t)row * 1024 + col] = x1; ((bf16*)(ws + WS_X1B))[(size_t)row * 1024 + col] = (bf16)f2bf(x1);
    } else if (MODE == MODE_PP) {
        ((bf16*)(ws + WS_PP))[(size_t)row * 1024 + col] = (bf16)f2bf(v);
    } else if (MODE == MODE_FINAL) {
        const float rstd2 = ((const float*)(ws + WS_RSTD2))[row], rstdp = ((const float*)(ws + WS_RSTDP))[row];
        const float ple = bf2f(((const bf16*)(ws + WS_PP))[(size_t)row * 1024 + col]) * rstdp * a.aux0[col];
        const float x2 = a.out[(size_t)row * 1024 + col];
        a.out[(size_t)row * 1024 + col] = x2 + sigmoidf_(rstd2 * v) * ple;
    }
}

template <int MODE> __global__ void __launch_bounds__(256) k_gemm_naive(NG_Args a) {
    __shared__ float As[16][68], Bs[16][68], As2[16][68], Bs2[16][68];
    const int tid = threadIdx.x, tx = tid & 15, ty = tid >> 4;
    const int m0 = blockIdx.y * 64, n0 = blockIdx.x * 64;
    float acc[4][4], acc2[4][4];
#pragma unroll
    for (int i = 0; i < 4; ++i)
#pragma unroll
        for (int j = 0; j < 4; ++j) { acc[i][j] = 0.f; acc2[i][j] = 0.f; }
    const int ar = tid >> 2, ak = (tid & 3) * 4;
    const int bk = tid >> 4, bn = (tid & 15) * 4;
    for (int k0 = 0; k0 < a.K; k0 += 16) {
        float av[4];
        if (a.a_is_f32) { const float4 t = *(const float4*)((const float*)a.A + (size_t)(m0 + ar) * a.lda + k0 + ak); av[0] = t.x; av[1] = t.y; av[2] = t.z; av[3] = t.w; }
        else { const uint2 t = *(const uint2*)((const bf16*)a.A + (size_t)(m0 + ar) * a.lda + k0 + ak); av[0] = bf2f(t.x & 0xffff); av[1] = bf2f(t.x >> 16); av[2] = bf2f(t.y & 0xffff); av[3] = bf2f(t.y >> 16); }
        float4 bv = *(const float4*)(a.B + (size_t)(k0 + bk) * a.ldb + n0 + bn);
        if (a.kscale) { const float s = a.kscale[k0 + bk]; bv.x *= s; bv.y *= s; bv.z *= s; bv.w *= s; }
#pragma unroll
        for (int i = 0; i < 4; ++i) As[ak + i][ar] = av[i];
        Bs[bk][bn] = bv.x; Bs[bk][bn + 1] = bv.y; Bs[bk][bn + 2] = bv.z; Bs[bk][bn + 3] = bv.w;
        if (MODE == MODE_MERGE) {
            const uint2 t = *(const uint2*)((const bf16*)a.A2 + (size_t)(m0 + ar) * a.lda + k0 + ak);
            As2[ak][ar] = bf2f(t.x & 0xffff); As2[ak + 1][ar] = bf2f(t.x >> 16); As2[ak + 2][ar] = bf2f(t.y & 0xffff); As2[ak + 3][ar] = bf2f(t.y >> 16);
            const float4 b2 = *(const float4*)(a.B2 + (size_t)(k0 + bk) * a.ldb + n0 + bn);
            Bs2[bk][bn] = b2.x; Bs2[bk][bn + 1] = b2.y; Bs2[bk][bn + 2] = b2.z; Bs2[bk][bn + 3] = b2.w;
        }
        __syncthreads();
#pragma unroll
        for (int kk = 0; kk < 16; ++kk) {
            float ra[4], rb[4];
#pragma unroll
            for (int i = 0; i < 4; ++i) { ra[i] = As[kk][ty * 4 + i]; rb[i] = Bs[kk][tx * 4 + i]; }
#pragma unroll
            for (int i = 0; i < 4; ++i)
#pragma unroll
                for (int j = 0; j < 4; ++j) acc[i][j] += ra[i] * rb[j];
            if (MODE == MODE_MERGE) {
#pragma unroll
                for (int i = 0; i < 4; ++i) { ra[i] = As2[kk][ty * 4 + i]; rb[i] = Bs2[kk][tx * 4 + i]; }
#pragma unroll
                for (int i = 0; i < 4; ++i)
#pragma unroll
                    for (int j = 0; j < 4; ++j) acc2[i][j] += ra[i] * rb[j];
            }
        }
        __syncthreads();
    }
#pragma unroll
    for (int i = 0; i < 4; ++i)
#pragma unroll
        for (int j = 0; j < 4; ++j) ng_store<MODE>(a, m0 + ty * 4 + i, n0 + tx * 4 + j, acc[i][j], acc2[i][j]);
}

__device__ __forceinline__ float ret_lg(int h) { return log1pf(-exp2f(-5.0f - (float)h)); }

__global__ void __launch_bounds__(256) k_ret_kv(unsigned char* ws) {
    const int bhn = blockIdx.x, n = bhn % NC, h = (bhn / NC) % RH, b = bhn / (NC * RH);
    const bf16* RK = (const bf16*)(ws + WS_RK); const bf16* RV = (const bf16*)(ws + WS_RV);
    float* KV = (float*)(ws + WS_KV) + (size_t)bhn * 128 * 128;
    const float lg = ret_lg(h);
    const size_t t0 = (size_t)b * SEQ + (size_t)n * RC;
    for (int o = threadIdx.x; o < 128 * 128; o += 256) {
        const int d = o >> 7, v = o & 127; float s = 0.f;
        for (int j = 0; j < 128; ++j) s += bf2f(RK[(t0 + j) * 512 + h * 128 + d]) * __expf((127.f - (float)j) * lg) * bf2f(RV[(t0 + j) * 512 + h * 128 + v]);
        KV[o] = s;
    }
}
__global__ void __launch_bounds__(256) k_ret_scan(unsigned char* ws) {
    const int gid = blockIdx.x * 256 + threadIdx.x;
    const int bh = gid >> 14, o = gid & 16383, d = o >> 7, v = o & 127, h = bh % RH;
    const float decay = __expf(128.f * ret_lg(h));
    const float* KV = (const float*)(ws + WS_KV); bf16* ST = (bf16*)(ws + WS_ST);
    float st = 0.f;
    for (int n = 0; n < NC; ++n) {
        const size_t bhn = (size_t)bh * NC + n;
        ST[bhn * 16384 + v * 128 + d] = (bf16)f2bf(st);
        st = decay * st + KV[bhn * 16384 + o];
    }
}
__global__ void __launch_bounds__(256) k_ret_out(unsigned char* ws, const float* gn_g, const float* gn_b) {
    extern __shared__ float sm[];
    float* sc = sm; float* yy = sm + 128 * 128;
    const int bhn = blockIdx.x, n = bhn % NC, h = (bhn / NC) % RH, b = bhn / (NC * RH);
    const bf16* RQ = (const bf16*)(ws + WS_RQ); const bf16* RK = (const bf16*)(ws + WS_RK); const bf16* RV = (const bf16*)(ws + WS_RV);
    const bf16* RG = (const bf16*)(ws + WS_RG); const bf16* ST = (const bf16*)(ws + WS_ST) + (size_t)bhn * 16384; bf16* AR = (bf16*)(ws + WS_AR);
    const float lg = ret_lg(h);
    const size_t t0 = (size_t)b * SEQ + (size_t)n * RC;
    for (int o = threadIdx.x; o < 128 * 128; o += 256) {
        const int i = o >> 7, j = o & 127; float s = 0.f;
        if (i >= j) { for (int d = 0; d < 128; ++d) s += bf2f(RQ[(t0 + i) * 512 + h * 128 + d]) * bf2f(RK[(t0 + j) * 512 + h * 128 + d]); s *= __expf((float)(i - j) * lg); }
        sc[o] = s;
    }
    __syncthreads();
    for (int o = threadIdx.x; o < 128 * 128; o += 256) {
        const int i = o >> 7, v = o & 127; float s = 0.f, c = 0.f;
        for (int j = 0; j <= i; ++j) s += sc[i * 128 + j] * bf2f(RV[(t0 + j) * 512 + h * 128 + v]);
        for (int d = 0; d < 128; ++d) c += bf2f(RQ[(t0 + i) * 512 + h * 128 + d]) * bf2f(ST[v * 128 + d]);
        yy[o] = s + c * __expf((float)(i + 1) * lg);
    }
    __syncthreads();
    if (threadIdx.x < 128) {
        const int i = threadIdx.x; float mu = 0.f;
        for (int v = 0; v < 128; ++v) mu += yy[i * 128 + ((v + i) & 127)];
        mu *= (1.f / 128.f); float var = 0.f;
        for (int v = 0; v < 128; ++v) { const float dd = yy[i * 128 + ((v + i) & 127)] - mu; var += dd * dd; }
        const float rstd = rsqrtf(var * (1.f / 128.f) + EPS);
        for (int v = 0; v < 128; ++v) { const int c = h * 128 + v; const float yn = (yy[i * 128 + v] - mu) * rstd * gn_g[c] + gn_b[c];
            AR[(t0 + i) * 512 + c] = (bf16)f2bf(bf2f(RG[(t0 + i) * 512 + c]) * yn); }
    }
}
__global__ void __launch_bounds__(256) k_swa(unsigned char* ws, const float* sinks) {
    const int gw = blockIdx.x * 4 + (threadIdx.x >> 6), lane = threadIdx.x & 63;
    const int t = gw >> 3, h = gw & 7, kvh = h >> 2, tpos = t & (SEQ - 1), tb = t - tpos;
    const bf16* SQ = (const bf16*)(ws + WS_SQ); const bf16* SK = (const bf16*)(ws + WS_SK); const bf16* SV = (const bf16*)(ws + WS_SV);
    const float q = bf2f(SQ[(size_t)t * 512 + h * 64 + lane]);
    const float slope2 = exp2f(-8.0f * (float)(h + 1) / 8.0f) * LOG2E;
    const float sink2 = sinks[h] * LOG2E;
    float m = sink2, l = 1.f, o = 0.f;
    const int lo = tpos - (WIN - 1) < 0 ? 0 : tpos - (WIN - 1);
    for (int kp = lo; kp <= tpos; ++kp) {
        const size_t tk = (size_t)(tb + kp);
        float s = wave_sum(q * bf2f(SK[tk * 128 + kvh * 64 + lane])) - slope2 * (float)(tpos - kp);
        const float mn = fmaxf(m, s), f = exp2f(m - mn), pp = exp2f(s - mn);
        l = l * f + pp; o = o * f + pp * bf2f(SV[tk * 128 + kvh * 64 + lane]); m = mn;
    }
    ((bf16*)(ws + WS_AS))[(size_t)t * 512 + h * 64 + lane] = (bf16)f2bf(o / l);
}
__global__ void __launch_bounds__(256) k_router(unsigned char* ws, const float* x1, const float* g, const float* wrg, const float* brg, const float* wre, const float* bre) {
    const int t = blockIdx.x * 4 + (threadIdx.x >> 6), lane = threadIdx.x & 63;
    float hv[16]; float ss = 0.f;
#pragma unroll
    for (int j = 0; j < 16; ++j) { hv[j] = x1[(size_t)t * D + j * 64 + lane]; ss += hv[j] * hv[j]; }
    const float rstd = rsqrtf(wave_sum(ss) * (1.f / D) + EPS);
#pragma unroll
    for (int j = 0; j < 16; ++j) hv[j] *= rstd * g[j * 64 + lane];
    float lgts[4], le[32];
#pragma unroll
    for (int o = 0; o < 4; ++o) { float s = 0.f;
#pragma unroll
        for (int j = 0; j < 16; ++j) s += hv[j] * wrg[(size_t)(j * 64 + lane) * 4 + o];
        lgts[o] = wave_sum(s) + brg[o]; }
#pragma unroll
    for (int o = 0; o < 32; ++o) { float s = 0.f;
#pragma unroll
        for (int j = 0; j < 16; ++j) s += hv[j] * wre[(size_t)(j * 64 + lane) * 32 + o];
        le[o] = wave_sum(s) + bre[o]; }
    float gm = lgts[0]; int gs = 0;
#pragma unroll
    for (int o = 1; o < 4; ++o) if (lgts[o] > gm) { gm = lgts[o]; gs = o; }
    float gden = 0.f;
#pragma unroll
    for (int o = 0; o < 4; ++o) gden += __expf(lgts[o] - gm);
    const float gw = 1.f / gden;
    float e8[8];
#pragma unroll
    for (int o = 0; o < 8; ++o) { e8[o] = gs == 0 ? le[o] : gs == 1 ? le[8 + o] : gs == 2 ? le[16 + o] : le[24 + o]; }
    float m1 = e8[0]; int i1 = 0;
#pragma unroll
    for (int o = 1; o < 8; ++o) if (e8[o] > m1) { m1 = e8[o]; i1 = o; }
    float m2 = -3.0e38f; int i2 = 0;
#pragma unroll
    for (int o = 0; o < 8; ++o) if (o != i1 && e8[o] > m2) { m2 = e8[o]; i2 = o; }
    const float p2 = __expf(m2 - m1), inv = 1.f / (1.f + p2);
    if (lane == 0) {
        ((float*)(ws + WS_RSTD1))[t] = rstd;
        ((int*)(ws + WS_SEL))[t * 2] = gs * 8 + i1; ((int*)(ws + WS_SEL))[t * 2 + 1] = gs * 8 + i2;
        ((float*)(ws + WS_CW))[t * 2] = gw * inv; ((float*)(ws + WS_CW))[t * 2 + 1] = gw * p2 * inv;
    }
}
__global__ void __launch_bounds__(256) k_moe_up(unsigned char* ws, const float* g, const float* wg, const float* wu) {
    const int tk = blockIdx.x, t = tk >> 1, f = threadIdx.x;
    const int e = ((const int*)(ws + WS_SEL))[tk]; const float cw = ((const float*)(ws + WS_CW))[tk], rstd = ((const float*)(ws + WS_RSTD1))[t];
    const bf16* xb = (const bf16*)(ws + WS_X1B) + (size_t)t * D;
    const float* Wg = wg + (size_t)e * D * FF; const float* Wu = wu + (size_t)e * D * FF;
    float a = 0.f, u = 0.f;
    for (int d = 0; d < D; ++d) { const float hv = bf2f(xb[d]) * g[d]; a += hv * Wg[(size_t)d * FF + f]; u += hv * Wu[(size_t)d * FF + f]; }
    a *= rstd; u *= rstd;
    ((bf16*)(ws + WS_HIDN))[(size_t)tk * FF + f] = (bf16)f2bf(a * sigmoidf_(a) * u * cw);
}
__global__ void __launch_bounds__(256) k_moe_down(unsigned char* ws, float* out, const float* wd) {
    const int t = blockIdx.x, c0 = threadIdx.x * 4;
    float4 acc = *(const float4*)(out + (size_t)t * D + c0);
    for (int k = 0; k < 2; ++k) {
        const int e = ((const int*)(ws + WS_SEL))[t * 2 + k]; const float* Wd = wd + (size_t)e * FF * D;
        const bf16* hid = (const bf16*)(ws + WS_HIDN) + (size_t)(t * 2 + k) * FF;
        for (int f = 0; f < FF; ++f) { const float hv = bf2f(hid[f]); const float4 w = *(const float4*)(Wd + (size_t)f * D + c0); acc.x += hv * w.x; acc.y += hv * w.y; acc.z += hv * w.z; acc.w += hv * w.w; }
    }
    *(float4*)(out + (size_t)t * D + c0) = acc;
}
__global__ void __launch_bounds__(256) k_x2_stats(unsigned char* ws, const float* x2) {
    const int row = blockIdx.x * 4 + (threadIdx.x >> 6), lane = threadIdx.x & 63;
    const float4* xr = (const float4*)(x2 + (size_t)row * D) + lane; float s = 0.f;
#pragma unroll
    for (int j = 0; j < 4; ++j) { const float4 v = xr[64 * j]; s += v.x * v.x + v.y * v.y + v.z * v.z + v.w * v.w;
        uint2 o; o.x = f2bf(v.x) | (f2bf(v.y) << 16); o.y = f2bf(v.z) | (f2bf(v.w) << 16); ((uint2*)((bf16*)(ws + WS_X2B) + (size_t)row * D))[lane + 64 * j] = o; }
    s = wave_sum(s);
    if (lane == 0) ((float*)(ws + WS_RSTD2))[row] = rsqrtf(s * (1.f / D) + EPS);
}
__global__ void __launch_bounds__(256) k_pp_stats(unsigned char* ws) {
    const int row = blockIdx.x * 4 + (threadIdx.x >> 6), lane = threadIdx.x & 63;
    const bf16* pr = (const bf16*)(ws + WS_PP) + (size_t)row * D; float s = 0.f;
#pragma unroll
    for (int j = 0; j < 16; ++j) { const float v = bf2f(pr[j * 64 + lane]); s += v * v; }
    s = wave_sum(s);
    if (lane == 0) ((float*)(ws + WS_RSTDP))[row] = rsqrtf(s * (1.f / D) + EPS);
}

extern "C" void kernel_launch(void* const* d_in, const int* in_sizes, int n_in, void* d_out, int out_size, void* d_ws, size_t ws_size, hipStream_t stream) {
    static int grid = 0;
    if (grid == 0) {
        if (n_in != 24 || in_sizes[0] != T * D || out_size != T * D || ws_size < WS_END) { fprintf(stderr, "kernel_launch: unexpected shapes (n_in %d, in0 %d, out %d, ws %zu); nothing launched\n", n_in, n_in > 0 ? in_sizes[0] : -1, out_size, ws_size); grid = -1; return; }
        int dev = 0, cus = 0, per_cu = 0;
        if (hipGetDevice(&dev) != hipSuccess || hipDeviceGetAttribute(&cus, hipDeviceAttributeMultiprocessorCount, dev) != hipSuccess) { grid = -1; return; }
        if (hipFuncSetAttribute((const void*)mk_fwd, hipFuncAttributeMaxDynamicSharedMemorySize, LDS_BYTES) != hipSuccess) { fprintf(stderr, "kernel_launch: hipFuncSetAttribute failed\n"); grid = -1; return; }
        if (hipOccupancyMaxActiveBlocksPerMultiprocessor(&per_cu, (const void*)mk_fwd, NWAVES * 64, LDS_BYTES) != hipSuccess || per_cu < 1) { fprintf(stderr, "kernel_launch: occupancy query says %d workgroups per CU\n", per_cu); }
        (void)hipGetLastError();
        grid = cus;
        (void)hipFuncSetAttribute((const void*)k_ret_out, hipFuncAttributeMaxDynamicSharedMemorySize, 131072);
    }
    if (grid < 0) return;
    const float* x = (const float*)d_in[0]; const float* p = (const float*)d_in[1];
    const float* gn_g = (const float*)d_in[4]; const float* gn_b = (const float*)d_in[5]; const float* w_ret_o = (const float*)d_in[6];
    const float* sinks = (const float*)d_in[9];
    const float* w_swa_o = (const float*)d_in[10]; const float* w_out = (const float*)d_in[11]; const float* ffn_g = (const float*)d_in[12];
    const float* wrg = (const float*)d_in[13]; const float* brg = (const float*)d_in[14]; const float* wre = (const float*)d_in[15]; const float* bre = (const float*)d_in[16];
    const float* weg = (const float*)d_in[17]; const float* weu = (const float*)d_in[18]; const float* wed = (const float*)d_in[19];
    const float* pg_g = (const float*)d_in[20]; const float* w_pg = (const float*)d_in[21]; const float* w_ple = (const float*)d_in[22]; const float* ple_g = (const float*)d_in[23];
    unsigned char* ws = (unsigned char*)d_ws; float* out = (float*)d_out;

    Args a{};
    for (int i = 0; i < 24; ++i) a.in[i] = (const float*)d_in[i];
    a.out = out; a.ws = ws;
#define MK(lo, hi) do { (void)hipMemsetAsync(ws + WS_CTL, 0, CTL_ZERO_BYTES, stream); a.ph_lo = (lo); a.ph_hi = (hi); hipLaunchKernelGGL(mk_fwd, dim3(grid), dim3(NWAVES * 64), LDS_BYTES, stream, a); } while (0)
    MK(0, 2);

    k_ret_kv<<<BATCH * RH * NC, 256, 0, stream>>>(ws);
    k_ret_scan<<<16 * 16384 / 256, 256, 0, stream>>>(ws);
    k_swa<<<T * SH / 4, 256, 0, stream>>>(ws, sinks);
    k_ret_out<<<BATCH * RH * NC, 256, 131072, stream>>>(ws, gn_g, gn_b);
    MK(5, 7);
    MK(7, 11);
    MK(11, 12);
}
```

```cpp
#include <hip/hip_runtime.h>
#include <cstdio>
#include <cstdint>

constexpr int BATCH = 4, SEQ = 4096, T = BATCH * SEQ, D = 1024;
constexpr int PLE = 256;
constexpr float EPS = 1e-6f;
constexpr int RH = 4, RDK = 128, RC = 128, NC = SEQ / RC;
constexpr int SH = 8, SKV = 2, SG = 4, HD = 64, WIN = 128;
constexpr int NE = 32, EPG = 8, NG = 4, FF = 256;
constexpr int INW = 4864;
constexpr float LOG2E = 1.4426950408889634f;
constexpr float QSCALE = 0.125f * LOG2E;
constexpr float KSCALE = 0.08838834764831845f;

typedef unsigned short bf16;
__device__ __forceinline__ unsigned f2bf(float f) { unsigned u = __builtin_bit_cast(unsigned, f); return (u + 0x7fffu + ((u >> 16) & 1u)) >> 16; }
__device__ __forceinline__ unsigned pk2(float lo, float hi) { return f2bf(lo) | (f2bf(hi) << 16); }
__device__ __forceinline__ float bf2f(bf16 h) { return __builtin_bit_cast(float, (unsigned)h << 16); }
__device__ __forceinline__ float wave_sum(float v) {
#pragma unroll
    for (int o = 1; o < 64; o <<= 1) v += __shfl_xor(v, o);
    return v;
}
__device__ __forceinline__ float sigmoidf_(float x) { return __builtin_amdgcn_rcpf(1.f + __expf(-x)); }

constexpr size_t MiB = 1u << 20;
constexpr size_t WS_CTL = 0, CTL_ZERO_BYTES = 1 * MiB;
constexpr size_t WS_WIN = 1 * MiB;
constexpr size_t WS_WRO = 11 * MiB;
constexpr size_t WS_WSO = 12 * MiB;
constexpr size_t WS_WOUT = 13 * MiB;
constexpr size_t WS_WPG = 15 * MiB;
constexpr size_t WS_WPLE = 17 * MiB;
constexpr size_t WS_WRT = 17 * MiB + 512 * 1024;
constexpr size_t WS_XN = 18 * MiB;
constexpr size_t WS_KV = 18 * MiB;
constexpr size_t WS_MG = 18 * MiB;
constexpr size_t WS_X2B = 18 * MiB;
constexpr size_t WS_RQ = 50 * MiB, WS_RK = 66 * MiB, WS_RV = 82 * MiB, WS_RG = 98 * MiB;
constexpr size_t WS_SQ = 114 * MiB;
constexpr size_t WS_SK = 130 * MiB, WS_SV = 134 * MiB;
constexpr size_t WS_GR = 138 * MiB, WS_GS = 170 * MiB;
constexpr size_t WS_ST = 202 * MiB;
constexpr size_t WS_AS = 218 * MiB, WS_AR = 234 * MiB;
constexpr size_t WS_MISC = 250 * MiB;
constexpr size_t WS_RSTD1 = WS_MISC, WS_RSTD2 = WS_MISC + 65536, WS_RSTDP = WS_MISC + 2 * 65536;
constexpr size_t WS_SEL = WS_MISC + 3 * 65536;
constexpr size_t WS_CW = WS_SEL + 131072;
constexpr size_t WS_SSP = 251 * MiB;
constexpr size_t WS_X1B = 50 * MiB;
constexpr size_t WS_HIDN = 130 * MiB;
constexpr size_t WS_PP = 216 * MiB;
constexpr size_t WS_PB = 152 * MiB;
constexpr size_t WS_WGU = 82 * MiB;
constexpr size_t WS_WD = 114 * MiB;
constexpr size_t WS_HID = 130 * MiB;
constexpr size_t WS_Y = 152 * MiB;
constexpr size_t WS_LIST = 252 * MiB;
constexpr size_t WS_END = 256 * MiB;
constexpr int CW_CNT = 8192;
constexpr int CW_BAR = 4096;

namespace pg8 {
#define PG8_LAS __attribute__((address_space(3)))
typedef unsigned short bf16_t;
typedef short bf16x8 __attribute__((ext_vector_type(8)));
typedef float f32x4 __attribute__((ext_vector_type(4)));
typedef unsigned u32x4 __attribute__((ext_vector_type(4)));
constexpr int BM = 256, BK = 64, HALF = 128, HTB = HALF * BK * 2  , STAGE_BYTES = 8 * HTB, NXCD = 8, WGM = 8;

__host__ __device__ __forceinline__ int lds_byte(int r, int c) { const int st = (r >> 4) * 2 + (c >> 5), rr = r & 15, cc = c & 31, ob = rr * 64 + cc * 2; return st * 1024 + (ob ^ (((ob >> 9) & 1) << 5)); }
__host__ __device__ __forceinline__ void stage_rc(int b, int& R, int& C) { const int st = b / 1024, sb = b % 1024, swz = sb ^ (((sb >> 9) & 1) << 5); R = (st >> 1) * 16 + swz / 64; C = (st & 1) * 32 + (swz % 64) / 2; }
__host__ __device__ __forceinline__ int perm32(int rho) { const int n = rho >> 4, i = rho & 15; return 8 * (i >> 2) + 4 * n + (i & 3); }
struct Unit { int pm, pn; const char* a; const char* b; int tag, aux; };

__device__ __forceinline__ void tile_of(int L, int nM, int nN, int& pm, int& pn) {
    const int nwg = nM * nN; int wgid = L; { const int q = nwg / NXCD, r = nwg % NXCD, xcd = wgid % NXCD, off = wgid / NXCD; wgid = (xcd < r ? xcd * (q + 1) : r * (q + 1) + (xcd - r) * q) + off; }
    const int nig = WGM * nN, gid = wgid / nig, fm = gid * WGM, gsz = (nM - fm) < WGM ? (nM - fm) : WGM;
    pm = fm + ((wgid % nig) % gsz); pn = (wgid % nig) / gsz;
}
struct TileOrder {
    int nM, nN, nwg, G, c; const char* A; const char* Bt; size_t tstep;
    __device__ void init(const void* A_, const void* Bt_, int M, int N, int K, int G_, int c_) { nM = M / BM; nN = N / BM; nwg = nM * nN; G = G_; c = c_; A = (const char*)A_; Bt = (const char*)Bt_; tstep = (size_t)BM * K * 2; }
    __device__ bool next(int i, Unit& u) const {
        const long L = (long)i * G + c; if (L >= nwg) return false;
        tile_of((int)L, nM, nN, u.pm, u.pn); u.a = A + (size_t)u.pm * tstep; u.b = Bt + (size_t)u.pn * tstep; u.tag = 0; u.aux = 0; return true;
    }
    static constexpr bool GATHER = false;
};
struct TwoPassOrder {
    int nM, nN, nwg, G, c; const char* A0; const char* A1; const char* B0; const char* B1; size_t tstep;
    __device__ void init(const void* A0_, const void* B0_, const void* A1_, const void* B1_, int M, int N, int K, int G_, int c_) { nM = M / BM; nN = N / BM; nwg = nM * nN; G = G_; c = c_;
        A0 = (const char*)A0_; A1 = (const char*)A1_; B0 = (const char*)B0_; B1 = (const char*)B1_; tstep = (size_t)BM * K * 2; }
    __device__ bool next(int i, Unit& u) const {
        const long L = (long)(i >> 1) * G + c; if (L >= nwg) return false;
        tile_of((int)L, nM, nN, u.pm, u.pn); u.aux = 0; u.tag = i & 1; u.a = (u.tag ? A1 : A0) + (size_t)u.pm * tstep; u.b = (u.tag ? B1 : B0) + (size_t)u.pn * tstep; return true;
    }
    static constexpr bool GATHER = false;
};

__device__ __forceinline__ unsigned cvt_pk_bf16(float lo, float hi) { unsigned r; asm volatile("v_cvt_pk_bf16_f32 %0, %1, %2" : "=v"(r) : "v"(lo), "v"(hi)); return r; }
__device__ __forceinline__ u32x4 pack8(const f32x4 v0, const f32x4 v1) { u32x4 w; w.x = cvt_pk_bf16(v0[0], v0[1]); w.y = cvt_pk_bf16(v0[2], v0[3]); w.z = cvt_pk_bf16(v1[0], v1[1]); w.w = cvt_pk_bf16(v1[2], v1[3]); return w; }
__device__ __forceinline__ float sigm(float x) { return __builtin_amdgcn_rcpf(1.f + __expf(-x)); }

struct EpiZ {
    static constexpr bool PERM = true, AFTER_DRAIN = false;
    unsigned char* ws; const float* qg; const float* kg;
    __device__ __forceinline__ void operator()(const f32x4 (&acc)[2][2][4][2], const Unit& u, int wr, int wc, int fr, int fq) const {
        const int pn = u.pn; const int row0 = u.pm * BM + wr * 64 + fr;
        if (pn < 8 || pn >= 11) {
            int kind, ld, colt; bf16_t* base;
            if (pn < 8) { kind = pn >> 1; base = (bf16_t*)(ws + WS_RQ + (size_t)kind * (16 * MiB)); ld = 512; colt = (pn & 1) * 256; }
            else { const int g = pn - 11; kind = 4; base = (bf16_t*)(ws + WS_GR + (size_t)(g >> 2) * (32 * MiB)); ld = 1024; colt = (g & 3) * 256; }
            const int col0 = colt + wc * 32 + 8 * fq;
#pragma unroll
            for (int ai = 0; ai < 2; ++ai)
#pragma unroll
                for (int m = 0; m < 4; ++m) { bf16_t* rowp = base + (size_t)(row0 + ai * HALF + m * 16) * ld + col0;
#pragma unroll
                    for (int bj = 0; bj < 2; ++bj) { f32x4 v0 = acc[ai][bj][m][0], v1 = acc[ai][bj][m][1];
                        if (kind == 1) { v0 = v0 * KSCALE; v1 = v1 * KSCALE; }
                        else if (kind == 3) {
#pragma unroll
                            for (int j = 0; j < 4; ++j) { v0[j] = v0[j] * sigm(v0[j]); v1[j] = v1[j] * sigm(v1[j]); } }
                        else if (kind == 4) {
#pragma unroll
                            for (int j = 0; j < 4; ++j) { v0[j] = sigm(v0[j]); v1[j] = sigm(v1[j]); } }
                        *(u32x4*)(rowp + bj * HALF) = pack8(v0, v1); } }
        } else {
            const bool isq = pn < 10, isk = (pn == 10) && (wc < 2);
            f32x4 gv[2][2];
#pragma unroll
            for (int bj = 0; bj < 2; ++bj)
#pragma unroll
                for (int n = 0; n < 2; ++n) { const int dd = 32 * bj + 8 * fq + 4 * n;
                    gv[bj][n] = isq ? *(const f32x4*)(qg + dd) * QSCALE : isk ? *(const f32x4*)(kg + dd) : (f32x4){1.f, 1.f, 1.f, 1.f}; }
            bf16_t* base; int ld;
            if (isq) { base = (bf16_t*)(ws + WS_SQ) + (pn - 8) * 256 + 64 * wc + 8 * fq; ld = 512; }
            else if (isk) { base = (bf16_t*)(ws + WS_SK) + 64 * wc + 8 * fq; ld = 128; }
            else { base = (bf16_t*)(ws + WS_SV) + 64 * (wc - 2) + 8 * fq; ld = 128; }
#pragma unroll
            for (int ai = 0; ai < 2; ++ai)
#pragma unroll
                for (int m = 0; m < 4; ++m) {
                    float ss = 0.f;
#pragma unroll
                    for (int bj = 0; bj < 2; ++bj)
#pragma unroll
                        for (int n = 0; n < 2; ++n) { const f32x4 x = acc[ai][bj][m][n]; ss += (x[0] * x[0] + x[1] * x[1]) + (x[2] * x[2] + x[3] * x[3]); }
                    ss += __shfl_xor(ss, 16); ss += __shfl_xor(ss, 32);
                    const float rstd = (isq || isk) ? rsqrtf(ss * (1.f / 64.f) + EPS) : 1.f;
                    bf16_t* rowp = base + (size_t)(row0 + ai * HALF + m * 16) * ld;
#pragma unroll
                    for (int bj = 0; bj < 2; ++bj) *(u32x4*)(rowp + 32 * bj) = pack8(acc[ai][bj][m][0] * rstd * gv[bj][0], acc[ai][bj][m][1] * rstd * gv[bj][1]); }
        }
    }
};


__device__ __forceinline__ void unpack8(const u32x4 w, f32x4& v0, f32x4& v1) {
    v0[0] = __builtin_bit_cast(float, w.x << 16); v0[1] = __builtin_bit_cast(float, w.x & 0xffff0000u); v0[2] = __builtin_bit_cast(float, w.y << 16); v0[3] = __builtin_bit_cast(float, w.y & 0xffff0000u);
    v1[0] = __builtin_bit_cast(float, w.z << 16); v1[1] = __builtin_bit_cast(float, w.z & 0xffff0000u); v1[2] = __builtin_bit_cast(float, w.w << 16); v1[3] = __builtin_bit_cast(float, w.w & 0xffff0000u);
}
typedef unsigned u32x2 __attribute__((ext_vector_type(2)));
__device__ __forceinline__ f32x4 unpack4(const u32x2 w) { f32x4 v; v[0] = __builtin_bit_cast(float, w.x << 16); v[1] = __builtin_bit_cast(float, w.x & 0xffff0000u); v[2] = __builtin_bit_cast(float, w.y << 16); v[3] = __builtin_bit_cast(float, w.y & 0xffff0000u); return v; }

struct EpiMerge {
    static constexpr bool PERM = true, AFTER_DRAIN = false;
    const bf16_t* GR; const bf16_t* GS; bf16_t* MG;
    __device__ __forceinline__ void operator()(const f32x4 (&acc)[2][2][4][2], const Unit& u, int wr, int wc, int fr, int fq) const {
        const int row0 = u.pm * BM + wr * 64 + fr, col0 = u.pn * BM + wc * 32 + 8 * fq; const bf16_t* G = u.tag ? GS : GR;
#pragma unroll
        for (int ai = 0; ai < 2; ++ai)
#pragma unroll
            for (int m = 0; m < 4; ++m) { const size_t off = (size_t)(row0 + ai * HALF + m * 16) * D + col0;
#pragma unroll
                for (int bj = 0; bj < 2; ++bj) { f32x4 g0, g1; unpack8(*(const u32x4*)(G + off + bj * HALF), g0, g1);
                    f32x4 v0 = acc[ai][bj][m][0] * g0, v1 = acc[ai][bj][m][1] * g1;
                    if (u.tag) { f32x4 p0, p1; unpack8(*(const u32x4*)(MG + off + bj * HALF), p0, p1); v0 = v0 + p0; v1 = v1 + p1; }
                    *(u32x4*)(MG + off + bj * HALF) = pack8(v0, v1); } }
    }
};
struct EpiX1 {
    static constexpr bool PERM = false, AFTER_DRAIN = false;
    const float* x; float* out; bf16_t* xb;
    __device__ __forceinline__ void operator()(const f32x4 (&acc)[2][2][4][2], const Unit& u, int wr, int wc, int fr, int fq) const {
        const int row0 = u.pm * BM + wr * 64 + fr, col0 = u.pn * BM + wc * 32 + 4 * fq;
#pragma unroll
        for (int ai = 0; ai < 2; ++ai)
#pragma unroll
            for (int m = 0; m < 4; ++m) { const size_t off = (size_t)(row0 + ai * HALF + m * 16) * D + col0;
#pragma unroll
                for (int bj = 0; bj < 2; ++bj)
#pragma unroll
                    for (int n = 0; n < 2; ++n) { const size_t o = off + bj * HALF + n * 16; const f32x4 v = *(const f32x4*)(x + o) + acc[ai][bj][m][n];
                        *(f32x4*)(out + o) = v; u32x2 w; w.x = cvt_pk_bf16(v[0], v[1]); w.y = cvt_pk_bf16(v[2], v[3]); *(u32x2*)(xb + o) = w; } }
    }
};
struct EpiPP {
    static constexpr bool PERM = true, AFTER_DRAIN = false;
    bf16_t* PP; float* SSP;
    __device__ __forceinline__ void operator()(const f32x4 (&acc)[2][2][4][2], const Unit& u, int wr, int wc, int fr, int fq) const {
        const int row0 = u.pm * BM + wr * 64 + fr, col0 = u.pn * BM + wc * 32 + 8 * fq;
#pragma unroll
        for (int ai = 0; ai < 2; ++ai)
#pragma unroll
            for (int m = 0; m < 4; ++m) { const int row = row0 + ai * HALF + m * 16; float ss = 0.f;
#pragma unroll
                for (int bj = 0; bj < 2; ++bj) { const f32x4 a = acc[ai][bj][m][0], b = acc[ai][bj][m][1];
                    ss += (a[0] * a[0] + a[1] * a[1]) + (a[2] * a[2] + a[3] * a[3]) + (b[0] * b[0] + b[1] * b[1]) + (b[2] * b[2] + b[3] * b[3]);
                    *(u32x4*)(PP + (size_t)row * D + col0 + bj * HALF) = pack8(a, b); }
                ss += __shfl_xor(ss, 16); ss += __shfl_xor(ss, 32);
                if (fq == 0) SSP[(size_t)row * 16 + u.pn * 4 + wc] = ss; }
    }
};
struct EpiFinal {
    static constexpr bool PERM = false, AFTER_DRAIN = false;
    float* out; const bf16_t* PP; const float* rstd2; const float* rstdp; const float* pleg;
    __device__ __forceinline__ void operator()(const f32x4 (&acc)[2][2][4][2], const Unit& u, int wr, int wc, int fr, int fq) const {
        const int row0 = u.pm * BM + wr * 64 + fr, col0 = u.pn * BM + wc * 32 + 4 * fq;
        f32x4 gv[2][2];
#pragma unroll
        for (int bj = 0; bj < 2; ++bj)
#pragma unroll
            for (int n = 0; n < 2; ++n) gv[bj][n] = *(const f32x4*)(pleg + col0 + bj * HALF + n * 16);
#pragma unroll
        for (int ai = 0; ai < 2; ++ai)
#pragma unroll
            for (int m = 0; m < 4; ++m) { const int row = row0 + ai * HALF + m * 16; const size_t off = (size_t)row * D + col0; const float r2 = rstd2[row], rp = rstdp[row];
#pragma unroll
                for (int bj = 0; bj < 2; ++bj)
#pragma unroll
                    for (int n = 0; n < 2; ++n) { const size_t o = off + bj * HALF + n * 16; const f32x4 x2 = *(const f32x4*)(out + o); const f32x4 pp = unpack4(*(const u32x2*)(PP + o)); const f32x4 a = acc[ai][bj][m][n];
                        f32x4 r;
#pragma unroll
                        for (int j = 0; j < 4; ++j) r[j] = x2[j] + sigm(r2 * a[j]) * (pp[j] * rp * gv[bj][n][j]);
                        *(f32x4*)(out + o) = r; } }
    }
};


struct MoeTables { const PG8_LAS int* cnt; const PG8_LAS int* pre; };
struct MoeUpOrder {
    MoeTables tb; int G, c; const char* X1B; const char* WGU; const int* LIST;
    __device__ bool next(int i, Unit& u) const {
        const int L = i * G + c; if (L >= tb.pre[32] * 2) return false;
        const int rtg = L >> 1; int e = 0; while (tb.pre[e + 1] <= rtg) ++e;
        u.pm = rtg - tb.pre[e]; u.pn = L & 1; u.tag = e; u.aux = rtg * 256; u.a = X1B; u.b = WGU + (size_t)e * (512 * 1024 * 2) + (size_t)u.pn * (256 * 1024 * 2); return true;
    }
    static constexpr bool GATHER = true;
    __device__ __forceinline__ void a_off(const Unit& u, int tid, int K, PG8_LAS unsigned short* tab) const {
        const int cnt = tb.cnt[u.tag]; const int* lst = LIST + u.tag * 16384;
#pragma unroll
        for (int i = 0; i < 2; ++i) { int R, C; stage_rc(tid * 16 + i * 8192, R, C); const int s0 = u.pm * 256 + R, s1 = s0 + HALF;
            const int t0 = s0 < cnt ? lst[s0] >> 1 : 0, t1 = s1 < cnt ? lst[s1] >> 1 : 0;
            tab[(0 * 2 + i) * 512] = (unsigned short)t0; tab[(1 * 2 + i) * 512] = (unsigned short)t1; }
    }
};
struct MoeDownOrder {
    MoeTables tb; int G, c; const char* HID; const char* WD;
    __device__ bool next(int i, Unit& u) const {
        const int L = i * G + c; if (L >= tb.pre[32] * 4) return false;
        const int rtg = L >> 2; int e = 0; while (tb.pre[e + 1] <= rtg) ++e;
        u.pm = rtg; u.pn = L & 3; u.tag = e; u.aux = rtg - tb.pre[e]; u.a = HID + (size_t)rtg * (256 * 256 * 2); u.b = WD + (size_t)e * (1024 * 256 * 2) + (size_t)u.pn * (256 * 256 * 2); return true;
    }
    static constexpr bool GATHER = false;
};
struct EpiUp {
    static constexpr bool PERM = true, AFTER_DRAIN = false;
    MoeTables tb; const int* LIST; const float* RSTD1; const float* CW; bf16_t* HID;
    __device__ __forceinline__ void operator()(const f32x4 (&acc)[2][2][4][2], const Unit& u, int wr, int wc, int fr, int fq) const {
        const int cnt = tb.cnt[u.tag]; const int* lst = LIST + u.tag * 16384 + u.pm * 256;
#pragma unroll
        for (int ai = 0; ai < 2; ++ai)
#pragma unroll
            for (int m = 0; m < 4; ++m) { const int r = ai * HALF + wr * 64 + m * 16 + fr; const bool valid = u.pm * 256 + r < cnt;
                const int tk = valid ? lst[r] : 0; const float rs = RSTD1[tk >> 1], cw = valid ? CW[tk] : 0.f;
                f32x4 h0, h1;
#pragma unroll
                for (int j = 0; j < 4; ++j) { const float g0 = acc[ai][0][m][0][j] * rs, g1 = acc[ai][0][m][1][j] * rs;
                    h0[j] = g0 * sigm(g0) * (acc[ai][1][m][0][j] * rs) * cw; h1[j] = g1 * sigm(g1) * (acc[ai][1][m][1][j] * rs) * cw; }
                *(u32x4*)(HID + (size_t)(u.aux + r) * 256 + 128 * u.pn + 32 * wc + 8 * fq) = pack8(h0, h1); }
    }
};
struct EpiDown {
    static constexpr bool PERM = true, AFTER_DRAIN = false;
    MoeTables tb; const int* LIST; bf16_t* Y;
    __device__ __forceinline__ void operator()(const f32x4 (&acc)[2][2][4][2], const Unit& u, int wr, int wc, int fr, int fq) const {
        const int cnt = tb.cnt[u.tag]; const int* lst = LIST + u.tag * 16384 + u.aux * 256; const int col0 = u.pn * BM + wc * 32 + 8 * fq;
#pragma unroll
        for (int ai = 0; ai < 2; ++ai)
#pragma unroll
            for (int m = 0; m < 4; ++m) { const int r = ai * HALF + wr * 64 + m * 16 + fr; const bool valid = u.aux * 256 + r < cnt;
                if (valid) { bf16_t* rowp = Y + (size_t)lst[r] * D + col0;
#pragma unroll
                    for (int bj = 0; bj < 2; ++bj) *(u32x4*)(rowp + bj * HALF) = pack8(acc[ai][bj][m][0], acc[ai][bj][m][1]); } }
    }
};

template <class Epi, class Sched>
__device__ __forceinline__ void gemm_phase(PG8_LAS unsigned char* lds, const int K, const Sched& S, const Epi& E, PG8_LAS unsigned short* gtab = nullptr) {
    constexpr bool GATHER = Sched::GATHER;
    const int tid = threadIdx.x, wid = __builtin_amdgcn_readfirstlane(tid >> 6), lane = tid & 63, wr = wid >> 2, wc = wid & 3, fr = lane & 15, fq = lane >> 4;
    const int nt = K / BK;
    unsigned voffA[2], voffB[2], cA2[2];
#pragma unroll
    for (int i = 0; i < 2; ++i) { int R, C; stage_rc(tid * 16 + i * 8192, R, C); const int Rb = Epi::PERM ? ((R & ~31) + perm32(R & 31)) : R;
        voffA[i] = (unsigned)(R * K + C) * 2u; cA2[i] = (unsigned)C * 2u; voffB[i] = (unsigned)(Rb * K + C) * 2u; }
    const size_t kstep = (size_t)(BK * 2);
    const size_t hstep = (size_t)HALF * K * 2;
    const unsigned ldsw = (unsigned)wid * 1024u;
    const int aoff = lds_byte(wr * 64 + fr, fq * 8), boff = lds_byte(wc * 32 + fr, fq * 8);
#define PG8_SA(b, h) (((b) * 2 + (h)) * HTB)
#define PG8_SB(b, h) ((4 + (b) * 2 + (h)) * HTB)
#define PG8_STAGE(bufoff, gbase, voff) do { _Pragma("unroll") for (int _i = 0; _i < 2; ++_i) \
        __builtin_amdgcn_global_load_lds((const unsigned*)((const char*)(gbase) + (voff)[_i]), (PG8_LAS unsigned*)(lds + (bufoff) + ldsw + _i * 8192), 16, 0, 0); } while (0)
#define PG8_STAGE_A(bufoff, gbase, un, h) do { if constexpr (GATHER) { unsigned _o[2]; _o[0] = (unsigned)gtab[((((ui + (un)) & 1) * 2 + (h)) * 2 + 0) * 512 + tid] * (unsigned)(K * 2) + cA2[0]; _o[1] = (unsigned)gtab[((((ui + (un)) & 1) * 2 + (h)) * 2 + 1) * 512 + tid] * (unsigned)(K * 2) + cA2[1]; PG8_STAGE(bufoff, gbase, _o); } \
        else { PG8_STAGE(bufoff, (gbase) + (h) * hstep, voffA); } } while (0)
#define PG8_LDA(dst, b, h) do { _Pragma("unroll") for (int m = 0; m < 4; ++m) _Pragma("unroll") for (int k = 0; k < 2; ++k) dst[m][k] = *(const PG8_LAS bf16x8*)(lds + PG8_SA(b, h) + aoff + m * 2048 + k * 1024); } while (0)
#define PG8_LDB(dst, b, h) do { _Pragma("unroll") for (int n = 0; n < 2; ++n) _Pragma("unroll") for (int k = 0; k < 2; ++k) dst[n][k] = *(const PG8_LAS bf16x8*)(lds + PG8_SB(b, h) + boff + n * 2048 + k * 1024); } while (0)
#define PG8_MMA(ai, bj, At, Bt) do { __builtin_amdgcn_s_setprio(1); _Pragma("unroll") for (int m = 0; m < 4; ++m) _Pragma("unroll") for (int n = 0; n < 2; ++n) _Pragma("unroll") for (int k = 0; k < 2; ++k) \
        acc[ai][bj][m][n] = __builtin_amdgcn_mfma_f32_16x16x32_bf16(Bt[n][k], At[m][k], acc[ai][bj][m][n], 0, 0, 0); __builtin_amdgcn_s_setprio(0); } while (0)
#define PG8_WAIT_V(n) asm volatile("s_waitcnt vmcnt(" #n ")" ::: "memory")
#define PG8_WAIT_L(n) asm volatile("s_waitcnt lgkmcnt(" #n ")" ::: "memory")
#define PG8_BAR __builtin_amdgcn_s_barrier()
#define PG8_SCHED __builtin_amdgcn_sched_barrier(0)
    Unit cur, nxt; int ui = 0;
    if (!S.next(0, cur)) return;
    f32x4 acc[2][2][4][2];
#pragma unroll
    for (int a = 0; a < 2; ++a)
#pragma unroll
        for (int b = 0; b < 2; ++b)
#pragma unroll
            for (int m = 0; m < 4; ++m)
#pragma unroll
                for (int n = 0; n < 2; ++n) acc[a][b][m][n] = (f32x4){0.f, 0.f, 0.f, 0.f};
    bf16x8 At[4][2], B0[2][2], B1[2][2];
    const char* cA = cur.a; const char* cB = cur.b;
    if constexpr (GATHER) S.a_off(cur, tid, K, gtab + 0 * 2048 + tid);
    PG8_STAGE(PG8_SB(0, 0), cB, voffB); PG8_STAGE(PG8_SB(0, 1), cB + hstep, voffB); PG8_STAGE_A(PG8_SA(0, 0), cA, 0, 0); PG8_STAGE_A(PG8_SA(0, 1), cA, 0, 1);
    if (wr == 1) PG8_BAR;
    PG8_WAIT_V(2); PG8_BAR;
    PG8_STAGE(PG8_SB(1, 0), cB + kstep, voffB); PG8_STAGE_A(PG8_SA(1, 0), cA + kstep, 0, 0); PG8_STAGE(PG8_SB(1, 1), cB + hstep + kstep, voffB);
    PG8_WAIT_V(6); PG8_BAR;
    for (;;) {
        const bool has_next = S.next(ui + 1, nxt);
        if constexpr (GATHER) S.a_off(has_next ? nxt : cur, tid, K, gtab + ((ui + 1) & 1) * 2048 + tid);
        const char* nA = has_next ? nxt.a : cA; const char* nB = has_next ? nxt.b : cB;
        for (int t = 0; t < nt; t += 2) {
            const bool last = (t == nt - 2);
            const char* a1 = cA + (size_t)(t + 1) * kstep;
            const char* a2 = last ? nA : cA + (size_t)(t + 2) * kstep; const char* b2 = last ? nB : cB + (size_t)(t + 2) * kstep;
            const char* a3 = a2 + kstep; const char* b3 = b2 + kstep;
            const int un = last ? 1 : 0;
            PG8_LDB(B0, 0, 0); PG8_LDB(B1, 0, 1); PG8_SCHED; PG8_LDA(At, 0, 0); PG8_STAGE_A(PG8_SA(1, 1), a1, 0, 1);
            PG8_WAIT_V(8); PG8_WAIT_L(0); PG8_BAR; PG8_MMA(0, 0, At, B0); PG8_MMA(0, 1, At, B1); PG8_BAR; PG8_SCHED;
            PG8_LDA(At, 0, 1); PG8_STAGE(PG8_SB(0, 0), b2, voffB); PG8_STAGE(PG8_SB(0, 1), b2 + hstep, voffB); PG8_STAGE_A(PG8_SA(0, 0), a2, un, 0);
            PG8_WAIT_V(8); PG8_WAIT_L(0); PG8_BAR; PG8_MMA(1, 0, At, B0); PG8_MMA(1, 1, At, B1); PG8_BAR; PG8_SCHED;
            PG8_LDB(B0, 1, 0); PG8_LDB(B1, 1, 1); PG8_SCHED; PG8_LDA(At, 1, 0); PG8_STAGE_A(PG8_SA(0, 1), a2, un, 1);
            PG8_WAIT_V(8); PG8_WAIT_L(0); PG8_BAR; PG8_MMA(0, 0, At, B0); PG8_MMA(0, 1, At, B1); PG8_BAR; PG8_SCHED;
            PG8_LDA(At, 1, 1); PG8_STAGE(PG8_SB(1, 0), b3, voffB); PG8_STAGE(PG8_SB(1, 1), b3 + hstep, voffB); PG8_STAGE_A(PG8_SA(1, 0), a3, un, 0);
            PG8_WAIT_V(8); PG8_WAIT_L(0); PG8_BAR; PG8_MMA(1, 0, At, B0); PG8_MMA(1, 1, At, B1); PG8_BAR; PG8_SCHED;
        }
        if (wr == 0) PG8_BAR;
        E(acc, cur, wr, wc, fr, fq);
        if (!has_next) break;
#pragma unroll
        for (int a = 0; a < 2; ++a)
#pragma unroll
            for (int b = 0; b < 2; ++b)
#pragma unroll
                for (int m = 0; m < 4; ++m)
#pragma unroll
                    for (int n = 0; n < 2; ++n) acc[a][b][m][n] = (f32x4){0.f, 0.f, 0.f, 0.f};
        cur = nxt; cA = nA; cB = nB; ++ui;
        if (wr == 1) PG8_BAR;
    }
    PG8_WAIT_V(0);
    PG8_BAR;
#undef PG8_SA
#undef PG8_SB
#undef PG8_STAGE
#undef PG8_STAGE_A
#undef PG8_LDA
#undef PG8_LDB
#undef PG8_MMA
#undef PG8_WAIT_V
#undef PG8_WAIT_L
#undef PG8_BAR
#undef PG8_SCHED
}
}
#define GAS __attribute__((address_space(1)))
#define LAS __attribute__((address_space(3)))
typedef unsigned v4u __attribute__((ext_vector_type(4)));
typedef float f32x4 __attribute__((ext_vector_type(4)));
typedef short bf16x8 __attribute__((ext_vector_type(8)));
typedef GAS unsigned gu32;
typedef GAS unsigned long long gu64;
#define RLX_AGENT __ATOMIC_RELAXED, __HIP_MEMORY_SCOPE_AGENT
#define LDS_WAIT() asm volatile("s_waitcnt lgkmcnt(0)" ::: "memory")
#define VM_WAIT() asm volatile("s_waitcnt vmcnt(0)" ::: "memory")
__device__ __forceinline__ unsigned long long rt() { return __builtin_amdgcn_s_memrealtime(); }


#define XB_TMO      128
#define XB_XCNT(j)  (256  + 64 * (j))
#define XB_XSUB(j)  (1280 + 64 * (j))
#define XB_XGEN(j)  (2304 + 64 * (j))
#define XB_TOP      3328
#define XB_TOPGEN   3392
#define XCD_BAR_WORDS 3456
#define XB_SPIN_CAP (1u << 18)

__device__ __forceinline__ unsigned xb_ld(unsigned* p)              { return __hip_atomic_load(p, __ATOMIC_RELAXED, __HIP_MEMORY_SCOPE_AGENT); }
__device__ __forceinline__ unsigned xb_add(unsigned* p, unsigned v) { return __hip_atomic_fetch_add(p, v, __ATOMIC_RELAXED, __HIP_MEMORY_SCOPE_AGENT); }
__device__ __forceinline__ unsigned xb_xcc_id() { return (unsigned)__builtin_amdgcn_s_getreg((3 << 11) | 20) & 0xFu; }
#define XB_SPIN(cond, bar) do { unsigned _sp = 0; while (cond) { __builtin_amdgcn_s_sleep(1); \
    if ((++_sp & 255u) == 0u) { if (xb_ld(&(bar)[XB_TMO])) break; if (_sp > XB_SPIN_CAP) { atomicAdd(&(bar)[XB_TMO], 1u); break; } } } } while (0)

struct XcdBarrier {
    unsigned* bar; unsigned x;
    volatile LAS unsigned* st;
};

__device__ __forceinline__ XcdBarrier xcd_barrier_post(unsigned* bar, volatile LAS unsigned* st) {
    XcdBarrier b; b.bar = bar; b.x = xb_xcc_id(); b.st = st;
    if (threadIdx.x == 0) (void)xb_add(&bar[XB_XCNT(b.x)], 1u);
    return b;
}
__device__ __forceinline__ void xcd_barrier_complete(unsigned* bar, unsigned x, unsigned& nloc, unsigned& nx) {
    const unsigned G = gridDim.x * gridDim.y * gridDim.z;
    unsigned sum, cnt, mine, sp = 0u;
    for (;;) {
        sum = 0u; cnt = 0u; mine = 0u;
#pragma unroll
        for (unsigned j = 0; j < 16; ++j) { const unsigned c = xb_ld(&bar[XB_XCNT(j)]); sum += c; cnt += (c > 0u) ? 1u : 0u; mine = (j == x) ? c : mine; }
        if (sum == G) break;
        __builtin_amdgcn_s_sleep(1);
        if ((++sp & 255u) == 0u) { if (xb_ld(&bar[XB_TMO])) break; if (sp > XB_SPIN_CAP) { atomicAdd(&bar[XB_TMO], 1u); break; } }
    }
    nloc = mine > 0u ? mine : 1u; nx = cnt > 0u ? cnt : 1u;
}

__device__ __forceinline__ void xcd_barrier(const XcdBarrier& b) {
    asm volatile("s_waitcnt vmcnt(0)" ::: "memory");
    __syncthreads();
    if (threadIdx.x == 0) {
        unsigned* bar = b.bar;
        __builtin_amdgcn_s_waitcnt(0);
        unsigned nloc = b.st[0], nx = b.st[1];
        if (nloc == 0u) { xcd_barrier_complete(bar, b.x, nloc, nx); b.st[0] = nloc; b.st[1] = nx; }
        const unsigned old = xb_add(&bar[XB_XSUB(b.x)], 1u);
        const unsigned gen = old / nloc;
        if (old + 1u == (gen + 1u) * nloc) {
            __builtin_amdgcn_fence(__ATOMIC_RELEASE, "agent");
            asm volatile("s_waitcnt vmcnt(0)" ::: "memory");
            const unsigned og = xb_add(&bar[XB_TOP], 1u);
            const unsigned tg = og / nx;
            if (og + 1u == (tg + 1u) * nx) xb_add(&bar[XB_TOPGEN], 1u);
            else XB_SPIN(xb_ld(&bar[XB_TOPGEN]) == tg, bar);
            __builtin_amdgcn_fence(__ATOMIC_ACQUIRE, "agent");
            xb_add(&bar[XB_XGEN(b.x)], 1u);
            asm volatile("s_waitcnt vmcnt(0)" ::: "memory");
        } else {
            XB_SPIN(xb_ld(&bar[XB_XGEN(b.x)]) == gen, bar);
            __builtin_amdgcn_fence(__ATOMIC_ACQUIRE, "agent");
            asm volatile("s_waitcnt vmcnt(0)" ::: "memory");
        }
    }
    __syncthreads();
}
namespace mx {
typedef short bf16x8 __attribute__((ext_vector_type(8)));
typedef short s16x4 __attribute__((ext_vector_type(4)));
typedef float f32x16 __attribute__((ext_vector_type(16)));
typedef LAS const char* lcp;
__device__ __forceinline__ int crow(int r, int hi) { return (r & 3) + 8 * (r >> 2) + 4 * hi; }
__device__ __forceinline__ s16x4 trr(lcp p) { return __builtin_bit_cast(s16x4, __builtin_amdgcn_ds_read_tr16_b64_v4i16((LAS s16x4*)p)); }
__device__ __forceinline__ bf16x8 trfrag(lcp tb, int stride, int rA, int rB, int c0) {
    const s16x4 a = trr(tb + rA * stride + c0 * 2), b = trr(tb + rB * stride + c0 * 2);
    return (bf16x8){a[0], a[1], a[2], a[3], b[0], b[1], b[2], b[3]};
}
__device__ __forceinline__ lcp tr_base(lcp tile, int stride, int lane) { const int i16 = lane & 15, g16 = (lane >> 4) & 1; return tile + (i16 >> 2) * stride + (16 * g16 + 4 * (i16 & 3)) * 2; }
__device__ __forceinline__ unsigned cvtpk(float lo, float hi) { unsigned r; asm volatile("v_cvt_pk_bf16_f32 %0, %1, %2" : "=v"(r) : "v"(lo), "v"(hi)); return r; }
__device__ __forceinline__ bf16x8 accfrag(const f32x16& x, int s) {
    v4u w; w.x = cvtpk(x[8 * s + 0], x[8 * s + 1]); w.y = cvtpk(x[8 * s + 2], x[8 * s + 3]); w.z = cvtpk(x[8 * s + 4], x[8 * s + 5]); w.w = cvtpk(x[8 * s + 6], x[8 * s + 7]);
    return __builtin_bit_cast(bf16x8, w);
}
__device__ __forceinline__ float ret_lg2(int h) { return log1pf(-exp2f(-5.0f - (float)h)) * LOG2E; }
#define MFMA32(a, b, c) __builtin_amdgcn_mfma_f32_32x32x16_bf16((a), (b), (c), 0, 0, 0)

constexpr int TS = 320;
constexpr int KS = 272;

__device__ __forceinline__ void ret_kv_unit(unsigned char* ws, LAS unsigned char* lds, int bhn, int tid, int wave, int lane) {
    const int n = bhn % NC, h = (bhn / NC) % RH, b = bhn / (NC * RH);
    const size_t t0 = (size_t)b * SEQ + (size_t)n * RC;
    const bf16* RK = (const bf16*)(ws + WS_RK) + t0 * 512 + h * 128; const bf16* RV = (const bf16*)(ws + WS_RV) + t0 * 512 + h * 128;
    LAS unsigned char* Kt = lds; LAS unsigned char* Vt = lds + 128 * TS;
    const float lg2 = ret_lg2(h);
    for (int c = tid; c < 2048; c += 512) { const int row = c >> 4, ch = c & 15;
        const v4u kq = *(const GAS v4u*)(RK + (size_t)row * 512 + ch * 8), vq = *(const GAS v4u*)(RV + (size_t)row * 512 + ch * 8);
        const float z = __builtin_amdgcn_exp2f((127.f - (float)row) * lg2);
        v4u ko; ko.x = pk2(bf2f(kq.x & 0xffff) * z, bf2f(kq.x >> 16) * z); ko.y = pk2(bf2f(kq.y & 0xffff) * z, bf2f(kq.y >> 16) * z); ko.z = pk2(bf2f(kq.z & 0xffff) * z, bf2f(kq.z >> 16) * z); ko.w = pk2(bf2f(kq.w & 0xffff) * z, bf2f(kq.w >> 16) * z);
        *(LAS v4u*)(Kt + row * TS + ch * 16) = ko; *(LAS v4u*)(Vt + row * TS + ch * 16) = vq; }
    __syncthreads();
    const int hi = lane >> 5, dt = wave >> 1, vh = wave & 1;
    const lcp kb = tr_base((lcp)Kt, TS, lane), vb = tr_base((lcp)Vt, TS, lane);
    f32x16 a0 = {}, a1 = {};
#pragma unroll
    for (int ks = 0; ks < 8; ++ks) { const int rA = 16 * ks + 4 * hi, rB = rA + 8;
        const bf16x8 A = trfrag(kb, TS, rA, rB, 32 * dt), B0 = trfrag(vb, TS, rA, rB, 64 * vh), B1 = trfrag(vb, TS, rA, rB, 64 * vh + 32);
        a0 = MFMA32(A, B0, a0); a1 = MFMA32(A, B1, a1); }
    float* KV = (float*)(ws + WS_KV) + (size_t)bhn * 16384;
#pragma unroll
    for (int r = 0; r < 16; ++r) { const int d = 32 * dt + crow(r, hi); KV[d * 128 + 64 * vh + (lane & 31)] = a0[r]; KV[d * 128 + 64 * vh + 32 + (lane & 31)] = a1[r]; }
    __syncthreads();
}
__device__ __forceinline__ void ret_scan(unsigned char* ws, int gtid, int nthreads) {
    const float* KV = (const float*)(ws + WS_KV); bf16* ST = (bf16*)(ws + WS_ST);
    for (int c = gtid; c < BATCH * RH * 16384; c += nthreads) { const int bh = c >> 14, o = c & 16383, h = bh % RH;
        const float decay = __builtin_amdgcn_exp2f(128.f * ret_lg2(h));
        float kv[NC];
#pragma unroll
        for (int n = 0; n < NC; ++n) kv[n] = KV[((size_t)bh * NC + n) * 16384 + o];
        float st = 0.f;
#pragma unroll
        for (int n = 0; n < NC; ++n) { ST[((size_t)bh * NC + n) * 16384 + o] = (bf16)f2bf(st); st = decay * st + kv[n]; } }
}
constexpr int SKS = 144, SVS = 192;
__device__ __forceinline__ void swa_unit(unsigned char* ws, LAS unsigned char* lds, const float* sinks, int unit, int tid, int wave, int lane) {
    const int kvh = unit & 1, nb = (unit >> 1) & 31, b = unit >> 6;
    const size_t tb0 = (size_t)b * SEQ + (size_t)nb * WIN;
    LAS unsigned char* Kt = lds; LAS unsigned char* Vt = lds + 256 * SKS;
    { const bf16* SK = (const bf16*)(ws + WS_SK) + kvh * 64; const bf16* SV = (const bf16*)(ws + WS_SV) + kvh * 64;
      for (int c = tid; c < 2048; c += 512) { const int row = c >> 3, ch = c & 7; v4u kq = {0u, 0u, 0u, 0u}, vq = {0u, 0u, 0u, 0u};
          if (nb > 0 || row >= WIN) { const size_t tk = tb0 - WIN + row; kq = *(const GAS v4u*)(SK + tk * 128 + ch * 8); vq = *(const GAS v4u*)(SV + tk * 128 + ch * 8); }
          *(LAS v4u*)(Kt + row * SKS + ch * 16) = kq; *(LAS v4u*)(Vt + row * SVS + ch * 16) = vq; } }
    __syncthreads();
    const int hi = lane >> 5, r32 = lane & 31, g = wave >> 1, qh = wave & 1, head = kvh * 4 + g;
    const float slope2 = __builtin_amdgcn_exp2f(-(float)(head + 1)) * LOG2E, sink2 = sinks[head] * LOG2E;
    const lcp vb = tr_base((lcp)Vt, SVS, lane);
    const bf16* SQ = (const bf16*)(ws + WS_SQ); bf16* AS = (bf16*)(ws + WS_AS);
#pragma unroll 1
    for (int qt = 0; qt < 2; ++qt) {
        const int q0 = qh * 64 + qt * 32, q = q0 + r32, kt0 = q0 >> 5;
        bf16x8 qf[4];
#pragma unroll
        for (int ks = 0; ks < 4; ++ks) qf[ks] = *(const GAS bf16x8*)(SQ + (tb0 + q) * 512 + head * 64 + 16 * ks + 8 * hi);
        f32x16 p[5];
#pragma unroll
        for (int j = 0; j < 5; ++j) { p[j] = (f32x16){};
            const lcp kr = (lcp)Kt + (32 * (kt0 + j) + r32) * SKS + 16 * hi;
#pragma unroll
            for (int ks = 0; ks < 4; ++ks) p[j] = MFMA32(*(const LAS bf16x8*)(kr + 32 * ks), qf[ks], p[j]); }
        float m = sink2; const int lim = nb > 0 ? WIN - 1 : (q < WIN - 1 ? q : WIN - 1);
#pragma unroll
        for (int j = 0; j < 5; ++j) { const int relb = q + WIN - 32 * (kt0 + j) - 4 * hi;
#pragma unroll
            for (int r = 0; r < 16; ++r) { const int rel = relb - ((r & 3) + 8 * (r >> 2));
                const float v = (unsigned)rel <= (unsigned)lim ? p[j][r] - slope2 * (float)rel : -__builtin_inff(); p[j][r] = v; m = fmaxf(m, v); } }
        m = fmaxf(m, __shfl_xor(m, 32));
        float l = 0.f;
#pragma unroll
        for (int j = 0; j < 5; ++j)
#pragma unroll
            for (int r = 0; r < 16; ++r) { const float e = __builtin_amdgcn_exp2f(p[j][r] - m); p[j][r] = e; l += e; }
        l += __shfl_xor(l, 32); l += __builtin_amdgcn_exp2f(sink2 - m);
        const float rl = 1.f / l;
        f32x16 o0 = {}, o1 = {};
#pragma unroll
        for (int j = 0; j < 5; ++j)
#pragma unroll
            for (int s = 0; s < 2; ++s) { const int rA = 32 * (kt0 + j) + 16 * s + 4 * hi, rB = rA + 8; const bf16x8 P = accfrag(p[j], s);
                o0 = MFMA32(trfrag(vb, SVS, rA, rB, 0), P, o0); o1 = MFMA32(trfrag(vb, SVS, rA, rB, 32), P, o1); }
        bf16* orow = AS + (tb0 + q) * 512 + head * 64;
#pragma unroll
        for (int rg = 0; rg < 4; ++rg) { const int d = 8 * rg + 4 * hi;
            pg8::u32x2 w0, w1; w0.x = cvtpk(o0[4 * rg] * rl, o0[4 * rg + 1] * rl); w0.y = cvtpk(o0[4 * rg + 2] * rl, o0[4 * rg + 3] * rl); w1.x = cvtpk(o1[4 * rg] * rl, o1[4 * rg + 1] * rl); w1.y = cvtpk(o1[4 * rg + 2] * rl, o1[4 * rg + 3] * rl);
            *(GAS pg8::u32x2*)(orow + d) = w0; *(GAS pg8::u32x2*)(orow + 32 + d) = w1; }
    }
    __syncthreads();
}
__device__ __forceinline__ void ret_out_unit(unsigned char* ws, LAS unsigned char* lds, const float* gn_g, const float* gn_b, int bhn, int tid, int wave, int lane) {
    const int n = bhn % NC, h = (bhn / NC) % RH, b = bhn / (NC * RH);
    const size_t t0 = (size_t)b * SEQ + (size_t)n * RC;
    const bf16* RQ = (const bf16*)(ws + WS_RQ) + t0 * 512 + h * 128; const bf16* RK = (const bf16*)(ws + WS_RK) + t0 * 512 + h * 128; const bf16* RV = (const bf16*)(ws + WS_RV) + t0 * 512 + h * 128;
    const bf16* ST = (const bf16*)(ws + WS_ST) + (size_t)bhn * 16384;
    LAS unsigned char* Kt = lds; LAS unsigned char* Vt = lds + 128 * KS; LAS unsigned char* St = Vt + 128 * TS; LAS float* xs = (LAS float*)(St + 128 * TS);
    for (int c = tid; c < 2048; c += 512) { const int row = c >> 4, ch = c & 15;
        *(LAS v4u*)(Kt + row * KS + ch * 16) = *(const GAS v4u*)(RK + (size_t)row * 512 + ch * 8);
        *(LAS v4u*)(Vt + row * TS + ch * 16) = *(const GAS v4u*)(RV + (size_t)row * 512 + ch * 8);
        *(LAS v4u*)(St + row * TS + ch * 16) = *(const GAS v4u*)(ST + (size_t)row * 128 + ch * 8); }
    __syncthreads();
    const int hi = lane >> 5, r32 = lane & 31, it = wave >> 1, vh = wave & 1, i = 32 * it + r32;
    const float lg2 = ret_lg2(h);
    bf16x8 qf[8];
#pragma unroll
    for (int ks = 0; ks < 8; ++ks) qf[ks] = *(const GAS bf16x8*)(RQ + (size_t)i * 512 + 16 * ks + 8 * hi);
    const lcp vb = tr_base((lcp)Vt, TS, lane), sb = tr_base((lcp)St, TS, lane);
    f32x16 y0 = {}, y1 = {};
#pragma unroll
    for (int ks = 0; ks < 8; ++ks) { const int rA = 16 * ks + 8 * hi, rB = rA + 4;
        y0 = MFMA32(trfrag(sb, TS, rA, rB, 64 * vh), qf[ks], y0); y1 = MFMA32(trfrag(sb, TS, rA, rB, 64 * vh + 32), qf[ks], y1); }
    { const float xi = __builtin_amdgcn_exp2f((float)(i + 1) * lg2);
#pragma unroll
      for (int r = 0; r < 16; ++r) { y0[r] *= xi; y1[r] *= xi; } }
#pragma unroll 1
    for (int jt = 0; jt <= it; ++jt) {
        f32x16 p = {};
        const lcp kr = (lcp)Kt + (32 * jt + r32) * KS + 16 * hi;
#pragma unroll
        for (int ks = 0; ks < 8; ++ks) p = MFMA32(*(const LAS bf16x8*)(kr + 32 * ks), qf[ks], p);
#pragma unroll
        for (int r = 0; r < 16; ++r) { const int dj = i - (32 * jt + crow(r, hi)); p[r] = dj >= 0 ? p[r] * __builtin_amdgcn_exp2f((float)dj * lg2) : 0.f; }
#pragma unroll
        for (int s = 0; s < 2; ++s) { const int rA = 32 * jt + 16 * s + 4 * hi, rB = rA + 8; const bf16x8 P = accfrag(p, s);
            y0 = MFMA32(trfrag(vb, TS, rA, rB, 64 * vh), P, y0); y1 = MFMA32(trfrag(vb, TS, rA, rB, 64 * vh + 32), P, y1); }
    }
    float s1 = 0.f, s2 = 0.f;
#pragma unroll
    for (int r = 0; r < 16; ++r) { s1 += y0[r] + y1[r]; s2 += y0[r] * y0[r] + y1[r] * y1[r]; }
    s1 += __shfl_xor(s1, 32); s2 += __shfl_xor(s2, 32);
    if (hi == 0) { xs[(i * 2 + vh) * 2] = s1; xs[(i * 2 + vh) * 2 + 1] = s2; }
    __syncthreads();
    { const float o1 = xs[(i * 2 + (vh ^ 1)) * 2], o2 = xs[(i * 2 + (vh ^ 1)) * 2 + 1]; s1 += o1; s2 += o2; }
    const float mu = s1 * (1.f / 128.f), var = fmaxf(s2 * (1.f / 128.f) - mu * mu, 0.f), rstd = rsqrtf(var + EPS);
    const bf16* RG = (const bf16*)(ws + WS_RG) + (t0 + i) * 512 + h * 128; bf16* AR = (bf16*)(ws + WS_AR) + (t0 + i) * 512 + h * 128;
#pragma unroll
    for (int rg = 0; rg < 4; ++rg)
#pragma unroll
        for (int half = 0; half < 2; ++half) { const int v = 64 * vh + 32 * half + 8 * rg + 4 * hi;
            const f32x4 gg = *(const GAS f32x4*)(gn_g + h * 128 + v), bb = *(const GAS f32x4*)(gn_b + h * 128 + v); const f32x4 sg = pg8::unpack4(*(const GAS pg8::u32x2*)(RG + v));
            float o[4];
#pragma unroll
            for (int e = 0; e < 4; ++e) { const float yv = half ? y1[4 * rg + e] : y0[4 * rg + e]; o[e] = sg[e] * ((yv - mu) * rstd * gg[e] + bb[e]); }
            pg8::u32x2 w; w.x = cvtpk(o[0], o[1]); w.y = cvtpk(o[2], o[3]); *(GAS pg8::u32x2*)(AR + v) = w; }
    __syncthreads();
}
#undef MFMA32
}

constexpr int NWAVES = 8;
constexpr int RING_OFF = 0, RING_BYTES = 131072;
constexpr int LDSCTL_OFF = RING_BYTES, MISC_OFF = LDSCTL_OFF + 320;
constexpr int GTAB_OFF = LDSCTL_OFF + 2048;
constexpr int LDS_BYTES = 147456;

__device__ __forceinline__ void p0_transpose_item(const float* W, int ldw, int k0, int ns0, bf16* WT, int ldt, int nd0, const float* ks, LAS float* scr, int lane) {
#pragma unroll 8
    for (int i = 0; i < 32; ++i) { const int kk = 2 * i + (lane >> 5); scr[kk * 33 + (lane & 31)] = W[(size_t)(k0 + kk) * ldw + ns0 + (lane & 31)]; }
    LDS_WAIT(); asm volatile("" ::: "memory");
    const int c = lane & 7;
    float sc[8];
#pragma unroll
    for (int i = 0; i < 8; ++i) sc[i] = ks ? ks[k0 + 8 * c + i] : 1.f;
#pragma unroll
    for (int j = 0; j < 4; ++j) { const int n = (lane >> 3) + 8 * j; const LAS float* s = scr + (8 * c) * 33 + n;
        v4u o; o.x = pk2(s[0 * 33] * sc[0], s[1 * 33] * sc[1]); o.y = pk2(s[2 * 33] * sc[2], s[3 * 33] * sc[3]); o.z = pk2(s[4 * 33] * sc[4], s[5 * 33] * sc[5]); o.w = pk2(s[6 * 33] * sc[6], s[7 * 33] * sc[7]);
        *(GAS v4u*)(WT + (size_t)(nd0 + n) * ldt + k0 + 8 * c) = o; }
    LDS_WAIT(); asm volatile("" ::: "memory");
}
__device__ __forceinline__ void rms_row_to_bf16(const float* xrow, const float* g, bf16* orow, int lane) {
    const GAS f32x4* xr = (const GAS f32x4*)xrow + lane;
    f32x4 v[4]; float s = 0.f;
#pragma unroll
    for (int j = 0; j < 4; ++j) { v[j] = xr[64 * j]; s += (v[j].x * v[j].x + v[j].y * v[j].y) + (v[j].z * v[j].z + v[j].w * v[j].w); }
    const float rstd = rsqrtf(wave_sum(s) * (1.f / D) + EPS);
    GAS unsigned long long* o8 = (GAS unsigned long long*)orow + lane;
#pragma unroll
    for (int j = 0; j < 4; ++j) { const f32x4 gg = ((const GAS f32x4*)g)[lane + 64 * j];
        o8[64 * j] = (unsigned long long)pk2(v[j].x * rstd * gg.x, v[j].y * rstd * gg.y) | ((unsigned long long)pk2(v[j].z * rstd * gg.z, v[j].w * rstd * gg.w) << 32); }
}

struct Args { const float* in[24]; float* out; unsigned char* ws; int ph_lo, ph_hi; };
template <int I> __device__ __forceinline__ const float* karg() {
    unsigned long long v; asm volatile("s_load_dwordx2 %0, %1, %2\n\ts_waitcnt lgkmcnt(0)" : "=s"(v) : "s"(__builtin_amdgcn_kernarg_segment_ptr()), "i"(I * 8)); return (const float*)v; }
enum { I_X = 0, I_P, I_MIXG, I_WIN, I_GNG, I_GNB, I_WRO, I_QG, I_KG, I_SINK, I_WSO, I_WOUT, I_FFNG, I_WRG, I_BRG, I_WRE, I_BRE, I_WEG, I_WEU, I_WED, I_PGG, I_WPG, I_WPLE, I_PLEG };

__device__ __forceinline__ void p0_prologue(unsigned char* ws, LAS unsigned char* lds, int vcu, int G, int wave, int lane) {
    LAS float* scr = (LAS float*)(lds + RING_OFF + wave * 16384);
    const int gw = vcu * NWAVES + wave, NGW = G * NWAVES;
    const float* a_win = karg<I_WIN>(); const float* a_wro = karg<I_WRO>(); const float* a_wso = karg<I_WSO>(); const float* a_wout = karg<I_WOUT>(); const float* a_wpg = karg<I_WPG>(); const float* a_pgg = karg<I_PGG>(); const float* a_wple = karg<I_WPLE>();
    constexpr int I_IN = 16 * 152, I_RO = 8 * 32, I_SO = 8 * 32, I_OUT = 16 * 32, I_PG = 16 * 32, I_PL = 4 * 32;
    constexpr int NITEMS = I_IN + I_RO + I_SO + I_OUT + I_PG + I_PL;
    for (int it = gw; it < NITEMS; it += NGW) {
        int r = it;
        if (r < I_IN) { const int kb = r / 152, nb = r % 152, pn = nb >> 3, q = nb & 7; int ns0 = 32 * nb;
            if (pn >= 8 && pn <= 10) ns0 = 256 * pn + 32 * (((q & 3) << 1) | (q >> 2));
            p0_transpose_item(a_win, INW, 64 * kb, ns0, (bf16*)(ws + WS_WIN), D, 32 * nb, nullptr, scr, lane); continue; } r -= I_IN;
        if (r < I_RO) { p0_transpose_item(a_wro, D, 64 * (r / 32), 32 * (r % 32), (bf16*)(ws + WS_WRO), 512, 32 * (r % 32), nullptr, scr, lane); continue; } r -= I_RO;
        if (r < I_SO) { p0_transpose_item(a_wso, D, 64 * (r / 32), 32 * (r % 32), (bf16*)(ws + WS_WSO), 512, 32 * (r % 32), nullptr, scr, lane); continue; } r -= I_SO;
        if (r < I_OUT) { p0_transpose_item(a_wout, D, 64 * (r / 32), 32 * (r % 32), (bf16*)(ws + WS_WOUT), D, 32 * (r % 32), nullptr, scr, lane); continue; } r -= I_OUT;
        if (r < I_PG) { p0_transpose_item(a_wpg, D, 64 * (r / 32), 32 * (r % 32), (bf16*)(ws + WS_WPG), D, 32 * (r % 32), a_pgg, scr, lane); continue; } r -= I_PG;
        p0_transpose_item(a_wple, D, 64 * (r / 32), 32 * (r % 32), (bf16*)(ws + WS_WPLE), PLE, 32 * (r % 32), nullptr, scr, lane);
    }
    { const float* g = karg<I_FFNG>(); const float* wrg = karg<I_WRG>(); const float* wre = karg<I_WRE>(); float* wrt = (float*)(ws + WS_WRT);
      for (int idx = gw * 64 + lane; idx < 36 * D; idx += NGW * 64) { const int o = idx >> 10, k = idx & 1023; wrt[idx] = g[k] * (o < 4 ? wrg[k * 4 + o] : wre[k * 32 + (o - 4)]); } }
    { const float* xx = karg<I_X>(); const float* mg = karg<I_MIXG>();
      for (int m = gw; m < T; m += NGW) rms_row_to_bf16(xx + (size_t)m * D, mg, (bf16*)(ws + WS_XN) + (size_t)m * D, lane); }
}


__device__ __forceinline__ void router_block(unsigned char* ws, const float* x1, const float* brg, const float* bre, LAS unsigned char* sc, int rb, int tid, int wave, int lane) {
    LAS float* dots = (LAS float*)sc; LAS float* rsl = (LAS float*)(sc + 9216); LAS unsigned* lcnt = (LAS unsigned*)(sc + 9216 + 256); LAS unsigned* lbase = lcnt + 32;
    const float* wrt = (const float*)(ws + WS_WRT);
    if (tid < 32) lcnt[tid] = 0u;
    const int row0 = rb * 64 + wave * 8;
    float xv[8][16];
#pragma unroll
    for (int r = 0; r < 8; ++r) { float ss = 0.f;
#pragma unroll
        for (int j = 0; j < 16; ++j) { xv[r][j] = x1[(size_t)(row0 + r) * D + j * 64 + lane]; ss += xv[r][j] * xv[r][j]; }
        ss = wave_sum(ss); if (lane == 0) rsl[wave * 8 + r] = rsqrtf(ss * (1.f / D) + EPS); }
    const int myr = ((lane >> 5) & 1) * 4 + ((lane >> 4) & 1) * 2 + ((lane >> 3) & 1);
    for (int o = 0; o < 36; ++o) {
        float w[16], acc[8];
#pragma unroll
        for (int j = 0; j < 16; ++j) w[j] = wrt[o * D + j * 64 + lane];
#pragma unroll
        for (int r = 0; r < 8; ++r) { float s = 0.f;
#pragma unroll
            for (int j = 0; j < 16; ++j) s += xv[r][j] * w[j];
            acc[r] = s; }
        { const bool up = (lane & 32) != 0;
#pragma unroll
          for (int i = 0; i < 4; ++i) { const float keep = up ? acc[i + 4] : acc[i], send = up ? acc[i] : acc[i + 4]; acc[i] = keep + __shfl_xor(send, 32); } }
        { const bool up = (lane & 16) != 0;
#pragma unroll
          for (int i = 0; i < 2; ++i) { const float keep = up ? acc[i + 2] : acc[i], send = up ? acc[i] : acc[i + 2]; acc[i] = keep + __shfl_xor(send, 16); } }
        { const bool up = (lane & 8) != 0; const float keep = up ? acc[1] : acc[0], send = up ? acc[0] : acc[1]; acc[0] = keep + __shfl_xor(send, 8); }
        float v = acc[0]; v += __shfl_xor(v, 4); v += __shfl_xor(v, 2); v += __shfl_xor(v, 1);
        if ((lane & 7) == 0) dots[(wave * 8 + myr) * 36 + o] = v;
    }
    __syncthreads();
    int e1 = 0, e2 = 0; unsigned lp1 = 0, lp2 = 0; const int row = row0 + lane;
    if (lane < 8) {
        const float rstd = rsl[wave * 8 + lane]; const LAS float* dr = dots + (wave * 8 + lane) * 36;
        float lg[4], le[32];
#pragma unroll
        for (int o = 0; o < 4; ++o) lg[o] = dr[o] * rstd + brg[o];
#pragma unroll
        for (int o = 0; o < 32; ++o) le[o] = dr[4 + o] * rstd + bre[o];
        float gm = lg[0]; int gs = 0;
#pragma unroll
        for (int o = 1; o < 4; ++o) if (lg[o] > gm) { gm = lg[o]; gs = o; }
        float gden = 0.f;
#pragma unroll
        for (int o = 0; o < 4; ++o) gden += __expf(lg[o] - gm);
        const float gw = 1.f / gden;
        float e8[8];
#pragma unroll
        for (int o = 0; o < 8; ++o) e8[o] = gs == 0 ? le[o] : gs == 1 ? le[8 + o] : gs == 2 ? le[16 + o] : le[24 + o];
        float m1 = e8[0]; int i1 = 0;
#pragma unroll
        for (int o = 1; o < 8; ++o) if (e8[o] > m1) { m1 = e8[o]; i1 = o; }
        float m2 = -3.0e38f; int i2 = 0;
#pragma unroll
        for (int o = 0; o < 8; ++o) if (o != i1 && e8[o] > m2) { m2 = e8[o]; i2 = o; }
        const float p2 = __expf(m2 - m1), inv = 1.f / (1.f + p2);
        e1 = gs * 8 + i1; e2 = gs * 8 + i2;
        ((float*)(ws + WS_RSTD1))[row] = rstd;
        ((float*)(ws + WS_CW))[row * 2] = gw * inv; ((float*)(ws + WS_CW))[row * 2 + 1] = gw * p2 * inv;
        lp1 = __hip_atomic_fetch_add(lcnt + e1, 1u, __ATOMIC_RELAXED, __HIP_MEMORY_SCOPE_WORKGROUP);
        lp2 = __hip_atomic_fetch_add(lcnt + e2, 1u, __ATOMIC_RELAXED, __HIP_MEMORY_SCOPE_WORKGROUP);
    }
    __syncthreads();
    if (tid < 32) { const unsigned n = lcnt[tid]; lbase[tid] = n ? __hip_atomic_fetch_add((unsigned*)(ws + WS_CTL) + CW_CNT + 64 * tid, n, __ATOMIC_RELAXED, __HIP_MEMORY_SCOPE_AGENT) : 0u; }
    __syncthreads();
    if (lane < 8) { int* LIST = (int*)(ws + WS_LIST);
        LIST[e1 * 16384 + (int)(lbase[e1] + lp1)] = row * 2; LIST[e2 * 16384 + (int)(lbase[e2] + lp2)] = row * 2 + 1; }
    __syncthreads();
}
__device__ __forceinline__ void p7_expert_weights(unsigned char* ws, LAS unsigned char* lds, int vcu, int G, int wave, int lane) {
    LAS float* scr = (LAS float*)(lds + RING_OFF + wave * 16384);
    const float* weg = karg<I_WEG>(); const float* weu = karg<I_WEU>(); const float* wed = karg<I_WED>(); const float* ffg = karg<I_FFNG>();
    const int gw = vcu * NWAVES + wave, NGW = G * NWAVES;
    constexpr int I_GU = NE * 16 * 16, I_DN = NE * 4 * 32;
    for (int it = gw; it < I_GU + I_DN; it += NGW) {
        if (it < I_GU) { const int e = it >> 8, r = it & 255, kb = r >> 4, nbd = r & 15, pn = nbd >> 3, bj = (nbd >> 2) & 1, jb = nbd & 3;
            const float* W = (bj ? weu : weg) + (size_t)e * D * FF;
            p0_transpose_item(W, FF, 64 * kb, 128 * pn + 32 * jb, (bf16*)(ws + WS_WGU) + (size_t)e * 512 * D, D, 32 * nbd, ffg, scr, lane); }
        else { const int r2 = it - I_GU, e = r2 >> 7, r = r2 & 127, kb = r >> 5, nb = r & 31;
            p0_transpose_item(wed + (size_t)e * FF * D, D, 64 * kb, 32 * nb, (bf16*)(ws + WS_WD) + (size_t)e * D * FF, FF, 32 * nb, nullptr, scr, lane); }
    }
}
__device__ __forceinline__ pg8::MoeTables moe_tables(unsigned char* ws, LAS unsigned char* tb, int tid) {
    LAS int* cnt = (LAS int*)tb; LAS int* pre = cnt + 32;
    if (tid < 32) cnt[tid] = (int)__hip_atomic_load((unsigned*)(ws + WS_CTL) + CW_CNT + 64 * tid, __ATOMIC_RELAXED, __HIP_MEMORY_SCOPE_AGENT);
    __syncthreads();
    if (tid == 0) { int s = 0; for (int e = 0; e < 32; ++e) { pre[e] = s; s += (cnt[e] + 255) >> 8; } pre[32] = s; }
    __syncthreads();
    return pg8::MoeTables{cnt, pre};
}
__device__ __forceinline__ void combine_row(unsigned char* ws, float* out, int t, int lane) {
    GAS f32x4* xr = (GAS f32x4*)(out + (size_t)t * D) + lane;
    const GAS pg8::u32x2* y0 = (const GAS pg8::u32x2*)((const bf16*)(ws + WS_Y) + (size_t)(2 * t) * D) + lane; const GAS pg8::u32x2* y1 = y0 + D / 4;
    GAS pg8::u32x2* xb = (GAS pg8::u32x2*)((bf16*)(ws + WS_X2B) + (size_t)t * D) + lane;
    float s = 0.f;
#pragma unroll
    for (int j = 0; j < 4; ++j) { const f32x4 v = xr[64 * j] + pg8::unpack4(y0[64 * j]) + pg8::unpack4(y1[64 * j]);
        s += (v.x * v.x + v.y * v.y) + (v.z * v.z + v.w * v.w); xr[64 * j] = v;
        pg8::u32x2 w; w.x = pk2(v.x, v.y); w.y = pk2(v.z, v.w); xb[64 * j] = w; }
    s = wave_sum(s);
    float sp = lane < 16 ? ((const float*)(ws + WS_SSP))[(size_t)t * 16 + lane] : 0.f; sp = wave_sum(sp);
    if (lane == 0) { ((float*)(ws + WS_RSTD2))[t] = rsqrtf(s * (1.f / D) + EPS); ((float*)(ws + WS_RSTDP))[t] = rsqrtf(sp * (1.f / D) + EPS); }
}

constexpr int N_PHASES = 12;
__global__ void __launch_bounds__(NWAVES * 64, 2) mk_fwd(Args args) {
    extern __shared__ __attribute__((aligned(16))) unsigned char lds_raw[];
    LAS unsigned char* lds = (LAS unsigned char*)lds_raw;
    volatile LAS unsigned* MISC = (volatile LAS unsigned*)(lds + MISC_OFF);
#define PH_IDS int tid = threadIdx.x; asm volatile("" : "+v"(tid)); const int lane = tid & 63, wave = __builtin_amdgcn_readfirstlane(tid >> 6); (void)lane; (void)wave
    const int G = gridDim.x; const int bx = blockIdx.x; const int vcu = (G % 8 == 0) ? (bx % 8) * (G / 8) + bx / 8 : bx;
    unsigned char* ws = args.ws;
    gu32* ctl = (gu32*)(ws + WS_CTL);
    for (int u = threadIdx.x; u < (LDS_BYTES - LDSCTL_OFF) / 4; u += NWAVES * 64) ((LAS unsigned*)(lds + LDSCTL_OFF))[u] = 0u;
    __syncthreads();
    XcdBarrier bar = xcd_barrier_post((unsigned*)(ctl + CW_BAR), MISC + 8);
    const int lo = args.ph_lo, hi = args.ph_hi;
#define IN(k) (lo <= (k) && (k) < hi)
#define BOTH(k) (IN(k) && IN((k) + 1))
#define GRID_BAR() xcd_barrier(bar)

    if (IN(0)) { PH_IDS; p0_prologue(ws, lds, vcu, G, wave, lane); if (BOTH(0)) GRID_BAR(); }

    if (IN(1)) { PH_IDS;
        pg8::TileOrder S; S.init(ws + WS_XN, ws + WS_WIN, T, INW, D, G, bx);
        pg8::EpiZ E{ws, karg<I_QG>(), karg<I_KG>()};
        pg8::gemm_phase<pg8::EpiZ, pg8::TileOrder>(lds + RING_OFF, D, S, E);
        if (BOTH(1)) GRID_BAR();
    }

    if (IN(2)) { PH_IDS;
        for (int u = bx; u < BATCH * RH * NC; u += G) mx::ret_kv_unit(ws, lds + RING_OFF, u, tid, wave, lane);
        if (BOTH(2)) GRID_BAR();
    }
    if (IN(3)) { PH_IDS;
        mx::ret_scan(ws, bx * (NWAVES * 64) + tid, G * NWAVES * 64);
        for (int u = bx; u < BATCH * (SEQ / WIN) * SKV; u += G) mx::swa_unit(ws, lds + RING_OFF, karg<I_SINK>(), u, tid, wave, lane);
        if (BOTH(3)) GRID_BAR();
    }
    if (IN(4)) { PH_IDS;
        for (int u = bx; u < BATCH * RH * NC; u += G) mx::ret_out_unit(ws, lds + RING_OFF, karg<I_GNG>(), karg<I_GNB>(), u, tid, wave, lane);
        if (BOTH(4)) GRID_BAR();
    }
    if (IN(5)) { PH_IDS;
        pg8::TwoPassOrder S; S.init(ws + WS_AR, ws + WS_WRO, ws + WS_AS, ws + WS_WSO, T, D, 512, G, bx);
        pg8::EpiMerge E{(const bf16*)(ws + WS_GR), (const bf16*)(ws + WS_GS), (bf16*)(ws + WS_MG)};
        pg8::gemm_phase<pg8::EpiMerge, pg8::TwoPassOrder>(lds + RING_OFF, 512, S, E);
        if (BOTH(5)) GRID_BAR();
    }
    if (IN(6)) { PH_IDS;
        { const int gw = vcu * NWAVES + wave, NGW = G * NWAVES;
          const float* pp_ = karg<I_P>();
          for (int m = gw; m < T; m += NGW) { const f32x4 v = ((const GAS f32x4*)(pp_ + (size_t)m * PLE))[lane];
              ((GAS unsigned long long*)((bf16*)(ws + WS_PB) + (size_t)m * PLE))[lane] = (unsigned long long)pk2(v.x, v.y) | ((unsigned long long)pk2(v.z, v.w) << 32); } }
        pg8::TileOrder S; S.init(ws + WS_MG, ws + WS_WOUT, T, D, D, G, bx);
        pg8::EpiX1 E{karg<I_X>(), args.out, (bf16*)(ws + WS_X1B)};
        pg8::gemm_phase<pg8::EpiX1, pg8::TileOrder>(lds + RING_OFF, D, S, E);
        if (BOTH(6)) GRID_BAR();
    }
    if (IN(7)) { PH_IDS;
        { const float* brg = karg<I_BRG>(); const float* bre = karg<I_BRE>();
          for (int rb = bx; rb < T / 64; rb += G) router_block(ws, args.out, brg, bre, lds + RING_OFF, rb, tid, wave, lane); }
        p7_expert_weights(ws, lds, vcu, G, wave, lane);
        __syncthreads();
        pg8::TileOrder S; S.init(ws + WS_PB, ws + WS_WPLE, T, D, PLE, G, bx);
        pg8::EpiPP E{(bf16*)(ws + WS_PP), (float*)(ws + WS_SSP)};
        pg8::gemm_phase<pg8::EpiPP, pg8::TileOrder>(lds + RING_OFF, PLE, S, E);
        if (BOTH(7)) GRID_BAR();
    }
    if (IN(8)) { PH_IDS;
        const pg8::MoeTables tb = moe_tables(ws, lds + LDSCTL_OFF + 1024, tid);
        pg8::MoeUpOrder S{tb, G, bx, (const char*)(ws + WS_X1B), (const char*)(ws + WS_WGU), (const int*)(ws + WS_LIST)};
        pg8::EpiUp E{tb, (const int*)(ws + WS_LIST), (const float*)(ws + WS_RSTD1), (const float*)(ws + WS_CW), (bf16*)(ws + WS_HID)};
        pg8::gemm_phase<pg8::EpiUp, pg8::MoeUpOrder>(lds + RING_OFF, D, S, E, (LAS unsigned short*)(lds + GTAB_OFF));
        if (BOTH(8)) GRID_BAR();
    }
    if (IN(9)) { PH_IDS;
        const pg8::MoeTables tb = moe_tables(ws, lds + LDSCTL_OFF + 1024, tid);
        pg8::MoeDownOrder S{tb, G, bx, (const char*)(ws + WS_HID), (const char*)(ws + WS_WD)};
        pg8::EpiDown E{tb, (const int*)(ws + WS_LIST), (bf16*)(ws + WS_Y)};
        pg8::gemm_phase<pg8::EpiDown, pg8::MoeDownOrder>(lds + RING_OFF, FF, S, E);
        if (BOTH(9)) GRID_BAR();
    }
    if (IN(10)) { PH_IDS;
        const int gw = vcu * NWAVES + wave, NGW = G * NWAVES;
        for (int t = gw; t < T; t += NGW) combine_row(ws, args.out, t, lane);
        if (BOTH(10)) GRID_BAR();
    }
    if (IN(11)) { PH_IDS;
        pg8::TileOrder S; S.init(ws + WS_X2B, ws + WS_WPG, T, D, D, G, bx);
        pg8::EpiFinal E{args.out, (const bf16*)(ws + WS_PP), (const float*)(ws + WS_RSTD2), (const float*)(ws + WS_RSTDP), karg<I_PLEG>()};
        pg8::gemm_phase<pg8::EpiFinal, pg8::TileOrder>(lds + RING_OFF, D, S, E);
    }
#undef IN
#undef BOTH
#undef GRID_BAR
}

__global__ void __launch_bounds__(256) k_rmsnorm_bf16(const float* x, const float* g, bf16* out) {
    const int row = blockIdx.x * 4 + (threadIdx.x >> 6), lane = threadIdx.x & 63;
    const float4* xr = (const float4*)(x + (size_t)row * D) + lane;
    float4 v[4]; float s = 0.f;
#pragma unroll
    for (int j = 0; j < 4; ++j) { v[j] = xr[64 * j]; s += v[j].x * v[j].x + v[j].y * v[j].y + v[j].z * v[j].z + v[j].w * v[j].w; }
    const float rstd = rsqrtf(wave_sum(s) * (1.f / D) + EPS);
#pragma unroll
    for (int j = 0; j < 4; ++j) { const float4 gg = ((const float4*)g)[lane + 64 * j];
        uint2 o; o.x = f2bf(v[j].x * rstd * gg.x) | (f2bf(v[j].y * rstd * gg.y) << 16); o.y = f2bf(v[j].z * rstd * gg.z) | (f2bf(v[j].w * rstd * gg.w) << 16);
        ((uint2*)(out + (size_t)row * D))[lane + 64 * j] = o; }
}

struct NG_Args {
    const void* A; int lda; int a_is_f32; const float* B; int ldb; const float* kscale; int M, N, K;
    const void* A2; const float* B2;
    unsigned char* ws; const float* x; float* out; const float* aux0;
};
enum { MODE_Z = 1, MODE_MERGE = 2, MODE_X1 = 3, MODE_PP = 4, MODE_FINAL = 5 };

template <int MODE> __device__ __forceinline__ void ng_store(const NG_Args& a, int row, int col, float v, float v2) {
    unsigned char* ws = a.ws;
    if (MODE == MODE_Z) {
        if (col < 512) ((bf16*)(ws + WS_RQ))[(size_t)row * 512 + col] = (bf16)f2bf(v);
        else if (col < 1024) ((bf16*)(ws + WS_RK))[(size_t)row * 512 + col - 512] = (bf16)f2bf(v * 0.08838834764831845f);
        else if (col < 1536) ((bf16*)(ws + WS_RV))[(size_t)row * 512 + col - 1024] = (bf16)f2bf(v);
        else if (col < 2048) ((bf16*)(ws + WS_RG))[(size_t)row * 512 + col - 1536] = (bf16)f2bf(v * sigmoidf_(v));
        else if (col < 2816) ((bf16*)(ws + WS_SV))[(size_t)row * 128 + col - 2688] = (bf16)f2bf(v);
        else if (col < 3840) ((bf16*)(ws + WS_GR))[(size_t)row * 1024 + col - 2816] = (bf16)f2bf(sigmoidf_(v));
        else ((bf16*)(ws + WS_GS))[(size_t)row * 1024 + col - 3840] = (bf16)f2bf(sigmoidf_(v));
    } else if (MODE == MODE_MERGE) {
        const float gr = bf2f(((const bf16*)(ws + WS_GR))[(size_t)row * 1024 + col]), gs = bf2f(((const bf16*)(ws + WS_GS))[(size_t)row * 1024 + col]);
        ((bf16*)(ws + WS_MG))[(size_t)row * 1024 + col] = (bf16)f2bf(gr * v + gs * v2);
    } else if (MODE == MODE_X1) {
        const float x1 = a.x[(size_t)row * 1024 + col] + v;
        a.out[(size_t)row * 1024 + col] = x1; ((bf16*)(ws + WS_X1B))[(size_t)row * 1024 + col] = (bf16)f2bf(x1);
    } else if (MODE == MODE_PP) {
        ((bf16*)(ws + WS_PP))[(size_t)row * 1024 + col] = (bf16)f2bf(v);
    } else if (MODE == MODE_FINAL) {
        const float rstd2 = ((const float*)(ws + WS_RSTD2))[row], rstdp = ((const float*)(ws + WS_RSTDP))[row];
        const float ple = bf2f(((const bf16*)(ws + WS_PP))[(size_t)row * 1024 + col]) * rstdp * a.aux0[col];
        const float x2 = a.out[(size_t)row * 1024 + col];
        a.out[(size_t)row * 1024 + col] = x2 + sigmoidf_(rstd2 * v) * ple;
    }
}

template <int MODE> __global__ void __launch_bounds__(256) k_gemm_naive(NG_Args a) {
    __shared__ float As[16][68], Bs[16][68], As2[16][68], Bs2[16][68];
    const int tid = threadIdx.x, tx = tid & 15, ty = tid >> 4;
    const int m0 = blockIdx.y * 64, n0 = blockIdx.x * 64;
    float acc[4][4], acc2[4][4];
#pragma unroll
    for (int i = 0; i < 4; ++i)
#pragma unroll
        for (int j = 0; j < 4; ++j) { acc[i][j] = 0.f; acc2[i][j] = 0.f; }
    const int ar = tid >> 2, ak = (tid & 3) * 4;
    const int bk = tid >> 4, bn = (tid & 15) * 4;
    for (int k0 = 0; k0 < a.K; k0 += 16) {
        float av[4];
        if (a.a_is_f32) { const float4 t = *(const float4*)((const float*)a.A + (size_t)(m0 + ar) * a.lda + k0 + ak); av[0] = t.x; av[1] = t.y; av[2] = t.z; av[3] = t.w; }
        else { const uint2 t = *(const uint2*)((const bf16*)a.A + (size_t)(m0 + ar) * a.lda + k0 + ak); av[0] = bf2f(t.x & 0xffff); av[1] = bf2f(t.x >> 16); av[2] = bf2f(t.y & 0xffff); av[3] = bf2f(t.y >> 16); }
        float4 bv = *(const float4*)(a.B + (size_t)(k0 + bk) * a.ldb + n0 + bn);
        if (a.kscale) { const float s = a.kscale[k0 + bk]; bv.x *= s; bv.y *= s; bv.z *= s; bv.w *= s; }
#pragma unroll
        for (int i = 0; i < 4; ++i) As[ak + i][ar] = av[i];
        Bs[bk][bn] = bv.x; Bs[bk][bn + 1] = bv.y; Bs[bk][bn + 2] = bv.z; Bs[bk][bn + 3] = bv.w;
        if (MODE == MODE_MERGE) {
            const uint2 t = *(const uint2*)((const bf16*)a.A2 + (size_t)(m0 + ar) * a.lda + k0 + ak);
            As2[ak][ar] = bf2f(t.x & 0xffff); As2[ak + 1][ar] = bf2f(t.x >> 16); As2[ak + 2][ar] = bf2f(t.y & 0xffff); As2[ak + 3][ar] = bf2f(t.y >> 16);
            const float4 b2 = *(const float4*)(a.B2 + (size_t)(k0 + bk) * a.ldb + n0 + bn);
            Bs2[bk][bn] = b2.x; Bs2[bk][bn + 1] = b2.y; Bs2[bk][bn + 2] = b2.z; Bs2[bk][bn + 3] = b2.w;
        }
        __syncthreads();
#pragma unroll
        for (int kk = 0; kk < 16; ++kk) {
            float ra[4], rb[4];
#pragma unroll
            for (int i = 0; i < 4; ++i) { ra[i] = As[kk][ty * 4 + i]; rb[i] = Bs[kk][tx * 4 + i]; }
#pragma unroll
            for (int i = 0; i < 4; ++i)
#pragma unroll
                for (int j = 0; j < 4; ++j) acc[i][j] += ra[i] * rb[j];
            if (MODE == MODE_MERGE) {
#pragma unroll
                for (int i = 0; i < 4; ++i) { ra[i] = As2[kk][ty * 4 + i]; rb[i] = Bs2[kk][tx * 4 + i]; }
#pragma unroll
                for (int i = 0; i < 4; ++i)
#pragma unroll
                    for (int j = 0; j < 4; ++j) acc2[i][j] += ra[i] * rb[j];
            }
        }
        __syncthreads();
    }
#pragma unroll
    for (int i = 0; i < 4; ++i)
#pragma unroll
        for (int j = 0; j < 4; ++j) ng_store<MODE>(a, m0 + ty * 4 + i, n0 + tx * 4 + j, acc[i][j], acc2[i][j]);
}

__device__ __forceinline__ float ret_lg(int h) { return log1pf(-exp2f(-5.0f - (float)h)); }

__global__ void __launch_bounds__(256) k_ret_kv(unsigned char* ws) {
    const int bhn = blockIdx.x, n = bhn % NC, h = (bhn / NC) % RH, b = bhn / (NC * RH);
    const bf16* RK = (const bf16*)(ws + WS_RK); const bf16* RV = (const bf16*)(ws + WS_RV);
    float* KV = (float*)(ws + WS_KV) + (size_t)bhn * 128 * 128;
    const float lg = ret_lg(h);
    const size_t t0 = (size_t)b * SEQ + (size_t)n * RC;
    for (int o = threadIdx.x; o < 128 * 128; o += 256) {
        const int d = o >> 7, v = o & 127; float s = 0.f;
        for (int j = 0; j < 128; ++j) s += bf2f(RK[(t0 + j) * 512 + h * 128 + d]) * __expf((127.f - (float)j) * lg) * bf2f(RV[(t0 + j) * 512 + h * 128 + v]);
        KV[o] = s;
    }
}
__global__ void __launch_bounds__(256) k_ret_scan(unsigned char* ws) {
    const int gid = blockIdx.x * 256 + threadIdx.x;
    const int bh = gid >> 14, o = gid & 16383, d = o >> 7, v = o & 127, h = bh % RH;
    const float decay = __expf(128.f * ret_lg(h));
    const float* KV = (const float*)(ws + WS_KV); bf16* ST = (bf16*)(ws + WS_ST);
    float st = 0.f;
    for (int n = 0; n < NC; ++n) {
        const size_t bhn = (size_t)bh * NC + n;
        ST[bhn * 16384 + v * 128 + d] = (bf16)f2bf(st);
        st = decay * st + KV[bhn * 16384 + o];
    }
}
__global__ void __launch_bounds__(256) k_ret_out(unsigned char* ws, const float* gn_g, const float* gn_b) {
    extern __shared__ float sm[];
    float* sc = sm; float* yy = sm + 128 * 128;
    const int bhn = blockIdx.x, n = bhn % NC, h = (bhn / NC) % RH, b = bhn / (NC * RH);
    const bf16* RQ = (const bf16*)(ws + WS_RQ); const bf16* RK = (const bf16*)(ws + WS_RK); const bf16* RV = (const bf16*)(ws + WS_RV);
    const bf16* RG = (const bf16*)(ws + WS_RG); const bf16* ST = (const bf16*)(ws + WS_ST) + (size_t)bhn * 16384; bf16* AR = (bf16*)(ws + WS_AR);
    const float lg = ret_lg(h);
    const size_t t0 = (size_t)b * SEQ + (size_t)n * RC;
    for (int o = threadIdx.x; o < 128 * 128; o += 256) {
        const int i = o >> 7, j = o & 127; float s = 0.f;
        if (i >= j) { for (int d = 0; d < 128; ++d) s += bf2f(RQ[(t0 + i) * 512 + h * 128 + d]) * bf2f(RK[(t0 + j) * 512 + h * 128 + d]); s *= __expf((float)(i - j) * lg); }
        sc[o] = s;
    }
    __syncthreads();
    for (int o = threadIdx.x; o < 128 * 128; o += 256) {
        const int i = o >> 7, v = o & 127; float s = 0.f, c = 0.f;
        for (int j = 0; j <= i; ++j) s += sc[i * 128 + j] * bf2f(RV[(t0 + j) * 512 + h * 128 + v]);
        for (int d = 0; d < 128; ++d) c += bf2f(RQ[(t0 + i) * 512 + h * 128 + d]) * bf2f(ST[v * 128 + d]);
        yy[o] = s + c * __expf((float)(i + 1) * lg);
    }
    __syncthreads();
    if (threadIdx.x < 128) {
        const int i = threadIdx.x; float mu = 0.f;
        for (int v = 0; v < 128; ++v) mu += yy[i * 128 + ((v + i) & 127)];
        mu *= (1.f / 128.f); float var = 0.f;
        for (int v = 0; v < 128; ++v) { const float dd = yy[i * 128 + ((v + i) & 127)] - mu; var += dd * dd; }
        const float rstd = rsqrtf(var * (1.f / 128.f) + EPS);
        for (int v = 0; v < 128; ++v) { const int c = h * 128 + v; const float yn = (yy[i * 128 + v] - mu) * rstd * gn_g[c] + gn_b[c];
            AR[(t0 + i) * 512 + c] = (bf16)f2bf(bf2f(RG[(t0 + i) * 512 + c]) * yn); }
    }
}
__global__ void __launch_bounds__(256) k_swa(unsigned char* ws, const float* sinks) {
    const int gw = blockIdx.x * 4 + (threadIdx.x >> 6), lane = threadIdx.x & 63;
    const int t = gw >> 3, h = gw & 7, kvh = h >> 2, tpos = t & (SEQ - 1), tb = t - tpos;
    const bf16* SQ = (const bf16*)(ws + WS_SQ); const bf16* SK = (const bf16*)(ws + WS_SK); const bf16* SV = (const bf16*)(ws + WS_SV);
    const float q = bf2f(SQ[(size_t)t * 512 + h * 64 + lane]);
    const float slope2 = exp2f(-8.0f * (float)(h + 1) / 8.0f) * LOG2E;
    const float sink2 = sinks[h] * LOG2E;
    float m = sink2, l = 1.f, o = 0.f;
    const int lo = tpos - (WIN - 1) < 0 ? 0 : tpos - (WIN - 1);
    for (int kp = lo; kp <= tpos; ++kp) {
        const size_t tk = (size_t)(tb + kp);
        float s = wave_sum(q * bf2f(SK[tk * 128 + kvh * 64 + lane])) - slope2 * (float)(tpos - kp);
        const float mn = fmaxf(m, s), f = exp2f(m - mn), pp = exp2f(s - mn);
        l = l * f + pp; o = o * f + pp * bf2f(SV[tk * 128 + kvh * 64 + lane]); m = mn;
    }
    ((bf16*)(ws + WS_AS))[(size_t)t * 512 + h * 64 + lane] = (bf16)f2bf(o / l);
}
__global__ void __launch_bounds__(256) k_router(unsigned char* ws, const float* x1, const float* g, const float* wrg, const float* brg, const float* wre, const float* bre) {
    const int t = blockIdx.x * 4 + (threadIdx.x >> 6), lane = threadIdx.x & 63;
    float hv[16]; float ss = 0.f;
#pragma unroll
    for (int j = 0; j < 16; ++j) { hv[j] = x1[(size_t)t * D + j * 64 + lane]; ss += hv[j] * hv[j]; }
    const float rstd = rsqrtf(wave_sum(ss) * (1.f / D) + EPS);
#pragma unroll
    for (int j = 0; j < 16; ++j) hv[j] *= rstd * g[j * 64 + lane];
    float lgts[4], le[32];
#pragma unroll
    for (int o = 0; o < 4; ++o) { float s = 0.f;
#pragma unroll
        for (int j = 0; j < 16; ++j) s += hv[j] * wrg[(size_t)(j * 64 + lane) * 4 + o];
        lgts[o] = wave_sum(s) + brg[o]; }
#pragma unroll
    for (int o = 0; o < 32; ++o) { float s = 0.f;
#pragma unroll
        for (int j = 0; j < 16; ++j) s += hv[j] * wre[(size_t)(j * 64 + lane) * 32 + o];
        le[o] = wave_sum(s) + bre[o]; }
    float gm = lgts[0]; int gs = 0;
#pragma unroll
    for (int o = 1; o < 4; ++o) if (lgts[o] > gm) { gm = lgts[o]; gs = o; }
    float gden = 0.f;
#pragma unroll
    for (int o = 0; o < 4; ++o) gden += __expf(lgts[o] - gm);
    const float gw = 1.f / gden;
    float e8[8];
#pragma unroll
    for (int o = 0; o < 8; ++o) { e8[o] = gs == 0 ? le[o] : gs == 1 ? le[8 + o] : gs == 2 ? le[16 + o] : le[24 + o]; }
    float m1 = e8[0]; int i1 = 0;
#pragma unroll
    for (int o = 1; o < 8; ++o) if (e8[o] > m1) { m1 = e8[o]; i1 = o; }
    float m2 = -3.0e38f; int i2 = 0;
#pragma unroll
    for (int o = 0; o < 8; ++o) if (o != i1 && e8[o] > m2) { m2 = e8[o]; i2 = o; }
    const float p2 = __expf(m2 - m1), inv = 1.f / (1.f + p2);
    if (lane == 0) {
        ((float*)(ws + WS_RSTD1))[t] = rstd;
        ((int*)(ws + WS_SEL))[t * 2] = gs * 8 + i1; ((int*)(ws + WS_SEL))[t * 2 + 1] = gs * 8 + i2;
        ((float*)(ws + WS_CW))[t * 2] = gw * inv; ((float*)(ws + WS_CW))[t * 2 + 1] = gw * p2 * inv;
    }
}
__global__ void __launch_bounds__(256) k_moe_up(unsigned char* ws, const float* g, const float* wg, const float* wu) {
    const int tk = blockIdx.x, t = tk >> 1, f = threadIdx.x;
    const int e = ((const int*)(ws + WS_SEL))[tk]; const float cw = ((const float*)(ws + WS_CW))[tk], rstd = ((const float*)(ws + WS_RSTD1))[t];
    const bf16* xb = (const bf16*)(ws + WS_X1B) + (size_t)t * D;
    const float* Wg = wg + (size_t)e * D * FF; const float* Wu = wu + (size_t)e * D * FF;
    float a = 0.f, u = 0.f;
    for (int d = 0; d < D; ++d) { const float hv = bf2f(xb[d]) * g[d]; a += hv * Wg[(size_t)d * FF + f]; u += hv * Wu[(size_t)d * FF + f]; }
    a *= rstd; u *= rstd;
    ((bf16*)(ws + WS_HIDN))[(size_t)tk * FF + f] = (bf16)f2bf(a * sigmoidf_(a) * u * cw);
}
__global__ void __launch_bounds__(256) k_moe_down(unsigned char* ws, float* out, const float* wd) {
    const int t = blockIdx.x, c0 = threadIdx.x * 4;
    float4 acc = *(const float4*)(out + (size_t)t * D + c0);
    for (int k = 0; k < 2; ++k) {
        const int e = ((const int*)(ws + WS_SEL))[t * 2 + k]; const float* Wd = wd + (size_t)e * FF * D;
        const bf16* hid = (const bf16*)(ws + WS_HIDN) + (size_t)(t * 2 + k) * FF;
        for (int f = 0; f < FF; ++f) { const float hv = bf2f(hid[f]); const float4 w = *(const float4*)(Wd + (size_t)f * D + c0); acc.x += hv * w.x; acc.y += hv * w.y; acc.z += hv * w.z; acc.w += hv * w.w; }
    }
    *(float4*)(out + (size_t)t * D + c0) = acc;
}
__global__ void __launch_bounds__(256) k_x2_stats(unsigned char* ws, const float* x2) {
    const int row = blockIdx.x * 4 + (threadIdx.x >> 6), lane = threadIdx.x & 63;
    const float4* xr = (const float4*)(x2 + (size_t)row * D) + lane; float s = 0.f;
#pragma unroll
    for (int j = 0; j < 4; ++j) { const float4 v = xr[64 * j]; s += v.x * v.x + v.y * v.y + v.z * v.z + v.w * v.w;
        uint2 o; o.x = f2bf(v.x) | (f2bf(v.y) << 16); o.y = f2bf(v.z) | (f2bf(v.w) << 16); ((uint2*)((bf16*)(ws + WS_X2B) + (size_t)row * D))[lane + 64 * j] = o; }
    s = wave_sum(s);
    if (lane == 0) ((float*)(ws + WS_RSTD2))[row] = rsqrtf(s * (1.f / D) + EPS);
}
__global__ void __launch_bounds__(256) k_pp_stats(unsigned char* ws) {
    const int row = blockIdx.x * 4 + (threadIdx.x >> 6), lane = threadIdx.x & 63;
    const bf16* pr = (const bf16*)(ws + WS_PP) + (size_t)row * D; float s = 0.f;
#pragma unroll
    for (int j = 0; j < 16; ++j) { const float v = bf2f(pr[j * 64 + lane]); s += v * v; }
    s = wave_sum(s);
    if (lane == 0) ((float*)(ws + WS_RSTDP))[row] = rsqrtf(s * (1.f / D) + EPS);
}

extern "C" void kernel_launch(void* const* d_in, const int* in_sizes, int n_in, void* d_out, int out_size, void* d_ws, size_t ws_size, hipStream_t stream) {
    static int grid = 0;
    if (grid == 0) {
        if (n_in != 24 || in_sizes[0] != T * D || out_size != T * D || ws_size < WS_END) { fprintf(stderr, "kernel_launch: unexpected shapes (n_in %d, in0 %d, out %d, ws %zu); nothing launched\n", n_in, n_in > 0 ? in_sizes[0] : -1, out_size, ws_size); grid = -1; return; }
        int dev = 0, cus = 0, per_cu = 0;
        if (hipGetDevice(&dev) != hipSuccess || hipDeviceGetAttribute(&cus, hipDeviceAttributeMultiprocessorCount, dev) != hipSuccess) { grid = -1; return; }
        if (hipFuncSetAttribute((const void*)mk_fwd, hipFuncAttributeMaxDynamicSharedMemorySize, LDS_BYTES) != hipSuccess) { fprintf(stderr, "kernel_launch: hipFuncSetAttribute failed\n"); grid = -1; return; }
        if (hipOccupancyMaxActiveBlocksPerMultiprocessor(&per_cu, (const void*)mk_fwd, NWAVES * 64, LDS_BYTES) != hipSuccess || per_cu < 1) { fprintf(stderr, "kernel_launch: occupancy query says %d workgroups per CU\n", per_cu); }
        (void)hipGetLastError();
        grid = cus;
        (void)hipFuncSetAttribute((const void*)k_ret_out, hipFuncAttributeMaxDynamicSharedMemorySize, 131072);
    }
    if (grid < 0) return;
    const float* x = (const float*)d_in[0]; const float* p = (const float*)d_in[1];
    const float* gn_g = (const float*)d_in[4]; const float* gn_b = (const float*)d_in[5]; const float* w_ret_o = (const float*)d_in[6];
    const float* sinks = (const float*)d_in[9];
    const float* w_swa_o = (const float*)d_in[10]; const float* w_out = (const float*)d_in[11]; const float* ffn_g = (const float*)d_in[12];
    const float* wrg = (const float*)d_in[13]; const float* brg = (const float*)d_in[14]; const float* wre = (const float*)d_in[15]; const float* bre = (const float*)d_in[16];
    const float* weg = (const float*)d_in[17]; const float* weu = (const float*)d_in[18]; const float* wed = (const float*)d_in[19];
    const float* pg_g = (const float*)d_in[20]; const float* w_pg = (const float*)d_in[21]; const float* w_ple = (const float*)d_in[22]; const float* ple_g = (const float*)d_in[23];
    unsigned char* ws = (unsigned char*)d_ws; float* out = (float*)d_out;

    Args a{};
    for (int i = 0; i < 24; ++i) a.in[i] = (const float*)d_in[i];
    a.out = out; a.ws = ws;
#define MK(lo, hi) do { (void)hipMemsetAsync(ws + WS_CTL, 0, CTL_ZERO_BYTES, stream); a.ph_lo = (lo); a.ph_hi = (hi); hipLaunchKernelGGL(mk_fwd, dim3(grid), dim3(NWAVES * 64), LDS_BYTES, stream, a); } while (0)
    MK(0, 12);
}
```

```cpp
#include <hip/hip_runtime.h>
#include <cstdio>
#include <cstdint>

constexpr int BATCH = 4, SEQ = 4096, T = BATCH * SEQ, D = 1024;
constexpr int PLE = 256;
constexpr float EPS = 1e-6f;
constexpr int RH = 4, RDK = 128, RC = 128, NC = SEQ / RC;
constexpr int SH = 8, SKV = 2, SG = 4, HD = 64, WIN = 128;
constexpr int NE = 32, EPG = 8, NG = 4, FF = 256;
constexpr int INW = 4864;
constexpr float LOG2E = 1.4426950408889634f;
constexpr float QSCALE = 0.125f * LOG2E;
constexpr float KSCALE = 0.08838834764831845f;

typedef unsigned short bf16;
__device__ __forceinline__ unsigned f2bf(float f) { unsigned u = __builtin_bit_cast(unsigned, f); return (u + 0x7fffu + ((u >> 16) & 1u)) >> 16; }
__device__ __forceinline__ unsigned pk2(float lo, float hi) { return f2bf(lo) | (f2bf(hi) << 16); }
__device__ __forceinline__ float bf2f(bf16 h) { return __builtin_bit_cast(float, (unsigned)h << 16); }
__device__ __forceinline__ float wave_sum(float v) {
#pragma unroll
    for (int o = 1; o < 64; o <<= 1) v += __shfl_xor(v, o);
    return v;
}
__device__ __forceinline__ float sigmoidf_(float x) { return __builtin_amdgcn_rcpf(1.f + __expf(-x)); }

constexpr size_t MiB = 1u << 20;
constexpr size_t WS_CTL = 0, CTL_ZERO_BYTES = 1 * MiB;
constexpr size_t WS_WIN = 1 * MiB;
constexpr size_t WS_WRO = 11 * MiB;
constexpr size_t WS_WSO = 12 * MiB;
constexpr size_t WS_WOUT = 13 * MiB;
constexpr size_t WS_WPG = 15 * MiB;
constexpr size_t WS_WPLE = 17 * MiB;
constexpr size_t WS_WRT = 17 * MiB + 512 * 1024;
constexpr size_t WS_XN = 18 * MiB;
constexpr size_t WS_KV = 18 * MiB;
constexpr size_t WS_MG = 18 * MiB;
constexpr size_t WS_X2B = 18 * MiB;
constexpr size_t WS_RQ = 50 * MiB, WS_RK = 66 * MiB, WS_RV = 82 * MiB, WS_RG = 98 * MiB;
constexpr size_t WS_SQ = 114 * MiB;
constexpr size_t WS_SK = 130 * MiB, WS_SV = 134 * MiB;
constexpr size_t WS_GR = 138 * MiB, WS_GS = 170 * MiB;
constexpr size_t WS_ST = 202 * MiB;
constexpr size_t WS_AS = 218 * MiB, WS_AR = 234 * MiB;
constexpr size_t WS_MISC = 250 * MiB;
constexpr size_t WS_RSTD1 = WS_MISC, WS_RSTD2 = WS_MISC + 65536, WS_RSTDP = WS_MISC + 2 * 65536;
constexpr size_t WS_SEL = WS_MISC + 3 * 65536;
constexpr size_t WS_CW = WS_SEL + 131072;
constexpr size_t WS_SSP = 251 * MiB;
constexpr size_t WS_X1B = 50 * MiB;
constexpr size_t WS_HIDN = 130 * MiB;
constexpr size_t WS_PP = 216 * MiB;
constexpr size_t WS_PB = 152 * MiB;
constexpr size_t WS_WGU = 82 * MiB;
constexpr size_t WS_WD = 114 * MiB;
constexpr size_t WS_HID = 130 * MiB;
constexpr size_t WS_Y = 152 * MiB;
constexpr size_t WS_LIST = 252 * MiB;
constexpr size_t WS_END = 256 * MiB;
constexpr int CW_CNT = 8192;
constexpr int CW_BAR = 4096;

namespace pg8 {
#define PG8_LAS __attribute__((address_space(3)))
typedef unsigned short bf16_t;
typedef short bf16x8 __attribute__((ext_vector_type(8)));
typedef float f32x4 __attribute__((ext_vector_type(4)));
typedef unsigned u32x4 __attribute__((ext_vector_type(4)));
constexpr int BM = 256, BK = 64, HALF = 128, HTB = HALF * BK * 2  , STAGE_BYTES = 8 * HTB, NXCD = 8, WGM = 8;

__host__ __device__ __forceinline__ int lds_byte(int r, int c) { const int st = (r >> 4) * 2 + (c >> 5), rr = r & 15, cc = c & 31, ob = rr * 64 + cc * 2; return st * 1024 + (ob ^ (((ob >> 9) & 1) << 5)); }
__host__ __device__ __forceinline__ void stage_rc(int b, int& R, int& C) { const int st = b / 1024, sb = b % 1024, swz = sb ^ (((sb >> 9) & 1) << 5); R = (st >> 1) * 16 + swz / 64; C = (st & 1) * 32 + (swz % 64) / 2; }
__host__ __device__ __forceinline__ int perm32(int rho) { const int n = rho >> 4, i = rho & 15; return 8 * (i >> 2) + 4 * n + (i & 3); }
struct Unit { int pm, pn; const char* a; const char* b; int tag, aux; };

__device__ __forceinline__ void tile_of(int L, int nM, int nN, int& pm, int& pn) {
    const int nwg = nM * nN; int wgid = L; { const int q = nwg / NXCD, r = nwg % NXCD, xcd = wgid % NXCD, off = wgid / NXCD; wgid = (xcd < r ? xcd * (q + 1) : r * (q + 1) + (xcd - r) * q) + off; }
    const int nig = WGM * nN, gid = wgid / nig, fm = gid * WGM, gsz = (nM - fm) < WGM ? (nM - fm) : WGM;
    pm = fm + ((wgid % nig) % gsz); pn = (wgid % nig) / gsz;
}
struct TileOrder {
    int nM, nN, nwg, G, c; const char* A; const char* Bt; size_t tstep;
    __device__ void init(const void* A_, const void* Bt_, int M, int N, int K, int G_, int c_) { nM = M / BM; nN = N / BM; nwg = nM * nN; G = G_; c = c_; A = (const char*)A_; Bt = (const char*)Bt_; tstep = (size_t)BM * K * 2; }
    __device__ bool next(int i, Unit& u) const {
        const long L = (long)i * G + c; if (L >= nwg) return false;
        tile_of((int)L, nM, nN, u.pm, u.pn); u.a = A + (size_t)u.pm * tstep; u.b = Bt + (size_t)u.pn * tstep; u.tag = 0; u.aux = 0; return true;
    }
    static constexpr bool GATHER = false;
};
struct TwoPassOrder {
    int nM, nN, nwg, G, c; const char* A0; const char* A1; const char* B0; const char* B1; size_t tstep;
    __device__ void init(const void* A0_, const void* B0_, const void* A1_, const void* B1_, int M, int N, int K, int G_, int c_) { nM = M / BM; nN = N / BM; nwg = nM * nN; G = G_; c = c_;
        A0 = (const char*)A0_; A1 = (const char*)A1_; B0 = (const char*)B0_; B1 = (const char*)B1_; tstep = (size_t)BM * K * 2; }
    __device__ bool next(int i, Unit& u) const {
        const long L = (long)(i >> 1) * G + c; if (L >= nwg) return false;
        tile_of((int)L, nM, nN, u.pm, u.pn); u.aux = 0; u.tag = i & 1; u.a = (u.tag ? A1 : A0) + (size_t)u.pm * tstep; u.b = (u.tag ? B1 : B0) + (size_t)u.pn * tstep; return true;
    }
    static constexpr bool GATHER = false;
};

__device__ __forceinline__ unsigned cvt_pk_bf16(float lo, float hi) { unsigned r; asm volatile("v_cvt_pk_bf16_f32 %0, %1, %2" : "=v"(r) : "v"(lo), "v"(hi)); return r; }
__device__ __forceinline__ u32x4 pack8(const f32x4 v0, const f32x4 v1) { u32x4 w; w.x = cvt_pk_bf16(v0[0], v0[1]); w.y = cvt_pk_bf16(v0[2], v0[3]); w.z = cvt_pk_bf16(v1[0], v1[1]); w.w = cvt_pk_bf16(v1[2], v1[3]); return w; }
__device__ __forceinline__ float sigm(float x) { return __builtin_amdgcn_rcpf(1.f + __expf(-x)); }

struct EpiZ {
    static constexpr bool PERM = true, AFTER_DRAIN = false;
    unsigned char* ws; const float* qg; const float* kg;
    __device__ __forceinline__ void operator()(const f32x4 (&acc)[2][2][4][2], const Unit& u, int wr, int wc, int fr, int fq) const {
        const int pn = u.pn; const int row0 = u.pm * BM + wr * 64 + fr;
        if (pn < 8 || pn >= 11) {
            int kind, ld, colt; bf16_t* base;
            if (pn < 8) { kind = pn >> 1; base = (bf16_t*)(ws + WS_RQ + (size_t)kind * (16 * MiB)); ld = 512; colt = (pn & 1) * 256; }
            else { const int g = pn - 11; kind = 4; base = (bf16_t*)(ws + WS_GR + (size_t)(g >> 2) * (32 * MiB)); ld = 1024; colt = (g & 3) * 256; }
            const int col0 = colt + wc * 32 + 8 * fq;
#pragma unroll
            for (int ai = 0; ai < 2; ++ai)
#pragma unroll
                for (int m = 0; m < 4; ++m) { bf16_t* rowp = base + (size_t)(row0 + ai * HALF + m * 16) * ld + col0;
#pragma unroll
                    for (int bj = 0; bj < 2; ++bj) { f32x4 v0 = acc[ai][bj][m][0], v1 = acc[ai][bj][m][1];
                        if (kind == 1) { v0 = v0 * KSCALE; v1 = v1 * KSCALE; }
                        else if (kind == 3) {
#pragma unroll
                            for (int j = 0; j < 4; ++j) { v0[j] = v0[j] * sigm(v0[j]); v1[j] = v1[j] * sigm(v1[j]); } }
                        else if (kind == 4) {
#pragma unroll
                            for (int j = 0; j < 4; ++j) { v0[j] = sigm(v0[j]); v1[j] = sigm(v1[j]); } }
                        *(u32x4*)(rowp + bj * HALF) = pack8(v0, v1); } }
        } else {
            const bool isq = pn < 10, isk = (pn == 10) && (wc < 2);
            f32x4 gv[2][2];
#pragma unroll
            for (int bj = 0; bj < 2; ++bj)
#pragma unroll
                for (int n = 0; n < 2; ++n) { const int dd = 32 * bj + 8 * fq + 4 * n;
                    gv[bj][n] = isq ? *(const f32x4*)(qg + dd) * QSCALE : isk ? *(const f32x4*)(kg + dd) : (f32x4){1.f, 1.f, 1.f, 1.f}; }
            bf16_t* base; int ld;
            if (isq) { base = (bf16_t*)(ws + WS_SQ) + (pn - 8) * 256 + 64 * wc + 8 * fq; ld = 512; }
            else if (isk) { base = (bf16_t*)(ws + WS_SK) + 64 * wc + 8 * fq; ld = 128; }
            else { base = (bf16_t*)(ws + WS_SV) + 64 * (wc - 2) + 8 * fq; ld = 128; }
#pragma unroll
            for (int ai = 0; ai < 2; ++ai)
#pragma unroll
                for (int m = 0; m < 4; ++m) {
                    float ss = 0.f;
#pragma unroll
                    for (int bj = 0; bj < 2; ++bj)
#pragma unroll
                        for (int n = 0; n < 2; ++n) { const f32x4 x = acc[ai][bj][m][n]; ss += (x[0] * x[0] + x[1] * x[1]) + (x[2] * x[2] + x[3] * x[3]); }
                    ss += __shfl_xor(ss, 16); ss += __shfl_xor(ss, 32);
                    const float rstd = (isq || isk) ? rsqrtf(ss * (1.f / 64.f) + EPS) : 1.f;
                    bf16_t* rowp = base + (size_t)(row0 + ai * HALF + m * 16) * ld;
#pragma unroll
                    for (int bj = 0; bj < 2; ++bj) *(u32x4*)(rowp + 32 * bj) = pack8(acc[ai][bj][m][0] * rstd * gv[bj][0], acc[ai][bj][m][1] * rstd * gv[bj][1]); }
        }
    }
};


__device__ __forceinline__ void unpack8(const u32x4 w, f32x4& v0, f32x4& v1) {
    v0[0] = __builtin_bit_cast(float, w.x << 16); v0[1] = __builtin_bit_cast(float, w.x & 0xffff0000u); v0[2] = __builtin_bit_cast(float, w.y << 16); v0[3] = __builtin_bit_cast(float, w.y & 0xffff0000u);
    v1[0] = __builtin_bit_cast(float, w.z << 16); v1[1] = __builtin_bit_cast(float, w.z & 0xffff0000u); v1[2] = __builtin_bit_cast(float, w.w << 16); v1[3] = __builtin_bit_cast(float, w.w & 0xffff0000u);
}
typedef unsigned u32x2 __attribute__((ext_vector_type(2)));
__device__ __forceinline__ f32x4 unpack4(const u32x2 w) { f32x4 v; v[0] = __builtin_bit_cast(float, w.x << 16); v[1] = __builtin_bit_cast(float, w.x & 0xffff0000u); v[2] = __builtin_bit_cast(float, w.y << 16); v[3] = __builtin_bit_cast(float, w.y & 0xffff0000u); return v; }

struct EpiMerge {
    static constexpr bool PERM = true, AFTER_DRAIN = false;
    const bf16_t* GR; const bf16_t* GS; bf16_t* MG;
    __device__ __forceinline__ void operator()(const f32x4 (&acc)[2][2][4][2], const Unit& u, int wr, int wc, int fr, int fq) const {
        const int row0 = u.pm * BM + wr * 64 + fr, col0 = u.pn * BM + wc * 32 + 8 * fq; const bf16_t* G = u.tag ? GS : GR;
#pragma unroll
        for (int ai = 0; ai < 2; ++ai)
#pragma unroll
            for (int m = 0; m < 4; ++m) { const size_t off = (size_t)(row0 + ai * HALF + m * 16) * D + col0;
#pragma unroll
                for (int bj = 0; bj < 2; ++bj) { f32x4 g0, g1; unpack8(*(const u32x4*)(G + off + bj * HALF), g0, g1);
                    f32x4 v0 = acc[ai][bj][m][0] * g0, v1 = acc[ai][bj][m][1] * g1;
                    if (u.tag) { f32x4 p0, p1; unpack8(*(const u32x4*)(MG + off + bj * HALF), p0, p1); v0 = v0 + p0; v1 = v1 + p1; }
                    *(u32x4*)(MG + off + bj * HALF) = pack8(v0, v1); } }
    }
};
struct EpiX1 {
    static constexpr bool PERM = true, AFTER_DRAIN = false;
    const float* x; bf16_t* xb;
    __device__ __forceinline__ void operator()(const f32x4 (&acc)[2][2][4][2], const Unit& u, int wr, int wc, int fr, int fq) const {
        const int row0 = u.pm * BM + wr * 64 + fr, col0 = u.pn * BM + wc * 32 + 8 * fq;
#pragma unroll
        for (int ai = 0; ai < 2; ++ai)
#pragma unroll
            for (int m = 0; m < 4; ++m) { const size_t off = (size_t)(row0 + ai * HALF + m * 16) * D + col0;
#pragma unroll
                for (int bj = 0; bj < 2; ++bj) { const size_t o = off + bj * HALF;
                    *(u32x4*)(xb + o) = pack8(*(const f32x4*)(x + o) + acc[ai][bj][m][0], *(const f32x4*)(x + o + 4) + acc[ai][bj][m][1]); } }
    }
};
struct EpiPP {
    static constexpr bool PERM = true, AFTER_DRAIN = false;
    bf16_t* PP; float* SSP;
    __device__ __forceinline__ void operator()(const f32x4 (&acc)[2][2][4][2], const Unit& u, int wr, int wc, int fr, int fq) const {
        const int row0 = u.pm * BM + wr * 64 + fr, col0 = u.pn * BM + wc * 32 + 8 * fq;
#pragma unroll
        for (int ai = 0; ai < 2; ++ai)
#pragma unroll
            for (int m = 0; m < 4; ++m) { const int row = row0 + ai * HALF + m * 16; float ss = 0.f;
#pragma unroll
                for (int bj = 0; bj < 2; ++bj) { const f32x4 a = acc[ai][bj][m][0], b = acc[ai][bj][m][1];
                    ss += (a[0] * a[0] + a[1] * a[1]) + (a[2] * a[2] + a[3] * a[3]) + (b[0] * b[0] + b[1] * b[1]) + (b[2] * b[2] + b[3] * b[3]);
                    *(u32x4*)(PP + (size_t)row * D + col0 + bj * HALF) = pack8(a, b); }
                ss += __shfl_xor(ss, 16); ss += __shfl_xor(ss, 32);
                if (fq == 0) SSP[(size_t)row * 16 + u.pn * 4 + wc] = ss; }
    }
};
struct EpiFinal {
    static constexpr bool PERM = false, AFTER_DRAIN = false;
    float* out; const bf16_t* X2B; const bf16_t* PP; const float* rstd2; const float* rstdp; const float* pleg;
    __device__ __forceinline__ void operator()(const f32x4 (&acc)[2][2][4][2], const Unit& u, int wr, int wc, int fr, int fq) const {
        const int row0 = u.pm * BM + wr * 64 + fr, col0 = u.pn * BM + wc * 32 + 4 * fq;
        f32x4 gv[2][2];
#pragma unroll
        for (int bj = 0; bj < 2; ++bj)
#pragma unroll
            for (int n = 0; n < 2; ++n) gv[bj][n] = *(const f32x4*)(pleg + col0 + bj * HALF + n * 16);
#pragma unroll
        for (int ai = 0; ai < 2; ++ai)
#pragma unroll
            for (int m = 0; m < 4; ++m) { const int row = row0 + ai * HALF + m * 16; const size_t off = (size_t)row * D + col0; const float r2 = rstd2[row], rp = rstdp[row];
#pragma unroll
                for (int bj = 0; bj < 2; ++bj)
#pragma unroll
                    for (int n = 0; n < 2; ++n) { const size_t o = off + bj * HALF + n * 16; const f32x4 x2 = unpack4(*(const u32x2*)(X2B + o)); const f32x4 pp = unpack4(*(const u32x2*)(PP + o)); const f32x4 a = acc[ai][bj][m][n];
                        f32x4 r;
#pragma unroll
                        for (int j = 0; j < 4; ++j) r[j] = x2[j] + sigm(r2 * a[j]) * (pp[j] * rp * gv[bj][n][j]);
                        *(f32x4*)(out + o) = r; } }
    }
};


struct MoeTables { const PG8_LAS int* cnt; const PG8_LAS int* pre; };
struct MoeUpOrder {
    MoeTables tb; int G, c; const char* X1B; const char* WGU; const int* LIST;
    __device__ bool next(int i, Unit& u) const {
        const int L = i * G + c; if (L >= tb.pre[32] * 2) return false;
        const int rtg = L >> 1; int e = 0; while (tb.pre[e + 1] <= rtg) ++e;
        u.pm = rtg - tb.pre[e]; u.pn = L & 1; u.tag = e; u.aux = rtg * 256; u.a = X1B; u.b = WGU + (size_t)e * (512 * 1024 * 2) + (size_t)u.pn * (256 * 1024 * 2); return true;
    }
    static constexpr bool GATHER = true;
    __device__ __forceinline__ void a_off(const Unit& u, int tid, int K, PG8_LAS unsigned short* tab) const {
        const int cnt = tb.cnt[u.tag]; const int* lst = LIST + u.tag * 16384;
#pragma unroll
        for (int i = 0; i < 2; ++i) { int R, C; stage_rc(tid * 16 + i * 8192, R, C); const int s0 = u.pm * 256 + R, s1 = s0 + HALF;
            const int t0 = s0 < cnt ? lst[s0] >> 1 : 0, t1 = s1 < cnt ? lst[s1] >> 1 : 0;
            tab[(0 * 2 + i) * 512] = (unsigned short)t0; tab[(1 * 2 + i) * 512] = (unsigned short)t1; }
    }
};
struct MoeDownOrder {
    MoeTables tb; int G, c; const char* HID; const char* WD;
    __device__ bool next(int i, Unit& u) const {
        const int L = i * G + c; if (L >= tb.pre[32] * 4) return false;
        const int rtg = L >> 2; int e = 0; while (tb.pre[e + 1] <= rtg) ++e;
        u.pm = rtg; u.pn = L & 3; u.tag = e; u.aux = rtg - tb.pre[e]; u.a = HID + (size_t)rtg * (256 * 256 * 2); u.b = WD + (size_t)e * (1024 * 256 * 2) + (size_t)u.pn * (256 * 256 * 2); return true;
    }
    static constexpr bool GATHER = false;
};
struct EpiUp {
    static constexpr bool PERM = true, AFTER_DRAIN = false;
    MoeTables tb; const int* LIST; const float* RSTD1; const float* CW; bf16_t* HID;
    __device__ __forceinline__ void operator()(const f32x4 (&acc)[2][2][4][2], const Unit& u, int wr, int wc, int fr, int fq) const {
        const int cnt = tb.cnt[u.tag]; const int* lst = LIST + u.tag * 16384 + u.pm * 256;
#pragma unroll
        for (int ai = 0; ai < 2; ++ai)
#pragma unroll
            for (int m = 0; m < 4; ++m) { const int r = ai * HALF + wr * 64 + m * 16 + fr; const bool valid = u.pm * 256 + r < cnt;
                const int tk = valid ? lst[r] : 0; const float rs = RSTD1[tk >> 1], cw = valid ? CW[tk] : 0.f;
                f32x4 h0, h1;
#pragma unroll
                for (int j = 0; j < 4; ++j) { const float g0 = acc[ai][0][m][0][j] * rs, g1 = acc[ai][0][m][1][j] * rs;
                    h0[j] = g0 * sigm(g0) * (acc[ai][1][m][0][j] * rs) * cw; h1[j] = g1 * sigm(g1) * (acc[ai][1][m][1][j] * rs) * cw; }
                *(u32x4*)(HID + (size_t)(u.aux + r) * 256 + 128 * u.pn + 32 * wc + 8 * fq) = pack8(h0, h1); }
    }
};
struct EpiDown {
    static constexpr bool PERM = true, AFTER_DRAIN = false;
    MoeTables tb; const int* LIST; bf16_t* Y;
    __device__ __forceinline__ void operator()(const f32x4 (&acc)[2][2][4][2], const Unit& u, int wr, int wc, int fr, int fq) const {
        const int cnt = tb.cnt[u.tag]; const int* lst = LIST + u.tag * 16384 + u.aux * 256; const int col0 = u.pn * BM + wc * 32 + 8 * fq;
#pragma unroll
        for (int ai = 0; ai < 2; ++ai)
#pragma unroll
            for (int m = 0; m < 4; ++m) { const int r = ai * HALF + wr * 64 + m * 16 + fr; const bool valid = u.aux * 256 + r < cnt;
                if (valid) { bf16_t* rowp = Y + (size_t)lst[r] * D + col0;
#pragma unroll
                    for (int bj = 0; bj < 2; ++bj) *(u32x4*)(rowp + bj * HALF) = pack8(acc[ai][bj][m][0], acc[ai][bj][m][1]); } }
    }
};

template <class Epi, class Sched>
__device__ __forceinline__ void gemm_phase(PG8_LAS unsigned char* lds, const int K, const Sched& S, const Epi& E, PG8_LAS unsigned short* gtab = nullptr) {
    constexpr bool GATHER = Sched::GATHER;
    const int tid = threadIdx.x, wid = __builtin_amdgcn_readfirstlane(tid >> 6), lane = tid & 63, wr = wid >> 2, wc = wid & 3, fr = lane & 15, fq = lane >> 4;
    const int nt = K / BK;
    unsigned voffA[2], voffB[2], cA2[2];
#pragma unroll
    for (int i = 0; i < 2; ++i) { int R, C; stage_rc(tid * 16 + i * 8192, R, C); const int Rb = Epi::PERM ? ((R & ~31) + perm32(R & 31)) : R;
        voffA[i] = (unsigned)(R * K + C) * 2u; cA2[i] = (unsigned)C * 2u; voffB[i] = (unsigned)(Rb * K + C) * 2u; }
    const size_t kstep = (size_t)(BK * 2);
    const size_t hstep = (size_t)HALF * K * 2;
    const unsigned ldsw = (unsigned)wid * 1024u;
    const int aoff = lds_byte(wr * 64 + fr, fq * 8), boff = lds_byte(wc * 32 + fr, fq * 8);
#define PG8_SA(b, h) (((b) * 2 + (h)) * HTB)
#define PG8_SB(b, h) ((4 + (b) * 2 + (h)) * HTB)
#define PG8_STAGE(bufoff, gbase, voff) do { _Pragma("unroll") for (int _i = 0; _i < 2; ++_i) \
        __builtin_amdgcn_global_load_lds((const unsigned*)((const char*)(gbase) + (voff)[_i]), (PG8_LAS unsigned*)(lds + (bufoff) + ldsw + _i * 8192), 16, 0, 0); } while (0)
#define PG8_STAGE_A(bufoff, gbase, un, h) do { if constexpr (GATHER) { unsigned _o[2]; _o[0] = (unsigned)gtab[((((ui + (un)) & 1) * 2 + (h)) * 2 + 0) * 512 + tid] * (unsigned)(K * 2) + cA2[0]; _o[1] = (unsigned)gtab[((((ui + (un)) & 1) * 2 + (h)) * 2 + 1) * 512 + tid] * (unsigned)(K * 2) + cA2[1]; PG8_STAGE(bufoff, gbase, _o); } \
        else { PG8_STAGE(bufoff, (gbase) + (h) * hstep, voffA); } } while (0)
#define PG8_LDA(dst, b, h) do { _Pragma("unroll") for (int m = 0; m < 4; ++m) _Pragma("unroll") for (int k = 0; k < 2; ++k) dst[m][k] = *(const PG8_LAS bf16x8*)(lds + PG8_SA(b, h) + aoff + m * 2048 + k * 1024); } while (0)
#define PG8_LDB(dst, b, h) do { _Pragma("unroll") for (int n = 0; n < 2; ++n) _Pragma("unroll") for (int k = 0; k < 2; ++k) dst[n][k] = *(const PG8_LAS bf16x8*)(lds + PG8_SB(b, h) + boff + n * 2048 + k * 1024); } while (0)
#define PG8_MMA(ai, bj, At, Bt) do { __builtin_amdgcn_s_setprio(1); _Pragma("unroll") for (int m = 0; m < 4; ++m) _Pragma("unroll") for (int n = 0; n < 2; ++n) _Pragma("unroll") for (int k = 0; k < 2; ++k) \
        acc[ai][bj][m][n] = __builtin_amdgcn_mfma_f32_16x16x32_bf16(Bt[n][k], At[m][k], acc[ai][bj][m][n], 0, 0, 0); __builtin_amdgcn_s_setprio(0); } while (0)
#define PG8_WAIT_V(n) asm volatile("s_waitcnt vmcnt(" #n ")" ::: "memory")
#define PG8_WAIT_L(n) asm volatile("s_waitcnt lgkmcnt(" #n ")" ::: "memory")
#define PG8_BAR __builtin_amdgcn_s_barrier()
#define PG8_SCHED __builtin_amdgcn_sched_barrier(0)
    Unit cur, nxt; int ui = 0;
    if (!S.next(0, cur)) return;
    f32x4 acc[2][2][4][2];
#pragma unroll
    for (int a = 0; a < 2; ++a)
#pragma unroll
        for (int b = 0; b < 2; ++b)
#pragma unroll
            for (int m = 0; m < 4; ++m)
#pragma unroll
                for (int n = 0; n < 2; ++n) acc[a][b][m][n] = (f32x4){0.f, 0.f, 0.f, 0.f};
    bf16x8 At[4][2], B0[2][2], B1[2][2];
    const char* cA = cur.a; const char* cB = cur.b;
    if constexpr (GATHER) S.a_off(cur, tid, K, gtab + 0 * 2048 + tid);
    PG8_STAGE(PG8_SB(0, 0), cB, voffB); PG8_STAGE(PG8_SB(0, 1), cB + hstep, voffB); PG8_STAGE_A(PG8_SA(0, 0), cA, 0, 0); PG8_STAGE_A(PG8_SA(0, 1), cA, 0, 1);
    if (wr == 1) PG8_BAR;
    PG8_WAIT_V(2); PG8_BAR;
    PG8_STAGE(PG8_SB(1, 0), cB + kstep, voffB); PG8_STAGE_A(PG8_SA(1, 0), cA + kstep, 0, 0); PG8_STAGE(PG8_SB(1, 1), cB + hstep + kstep, voffB);
    PG8_WAIT_V(6); PG8_BAR;
    for (;;) {
        const bool has_next = S.next(ui + 1, nxt);
        if constexpr (GATHER) S.a_off(has_next ? nxt : cur, tid, K, gtab + ((ui + 1) & 1) * 2048 + tid);
        const char* nA = has_next ? nxt.a : cA; const char* nB = has_next ? nxt.b : cB;
        for (int t = 0; t < nt; t += 2) {
            const bool last = (t == nt - 2);
            const char* a1 = cA + (size_t)(t + 1) * kstep;
            const char* a2 = last ? nA : cA + (size_t)(t + 2) * kstep; const char* b2 = last ? nB : cB + (size_t)(t + 2) * kstep;
            const char* a3 = a2 + kstep; const char* b3 = b2 + kstep;
            const int un = last ? 1 : 0;
            PG8_LDB(B0, 0, 0); PG8_LDB(B1, 0, 1); PG8_SCHED; PG8_LDA(At, 0, 0); PG8_STAGE_A(PG8_SA(1, 1), a1, 0, 1);
            PG8_WAIT_V(8); PG8_WAIT_L(0); PG8_BAR; PG8_MMA(0, 0, At, B0); PG8_MMA(0, 1, At, B1); PG8_BAR; PG8_SCHED;
            PG8_LDA(At, 0, 1); PG8_STAGE(PG8_SB(0, 0), b2, voffB); PG8_STAGE(PG8_SB(0, 1), b2 + hstep, voffB); PG8_STAGE_A(PG8_SA(0, 0), a2, un, 0);
            PG8_WAIT_V(8); PG8_WAIT_L(0); PG8_BAR; PG8_MMA(1, 0, At, B0); PG8_MMA(1, 1, At, B1); PG8_BAR; PG8_SCHED;
            PG8_LDB(B0, 1, 0); PG8_LDB(B1, 1, 1); PG8_SCHED; PG8_LDA(At, 1, 0); PG8_STAGE_A(PG8_SA(0, 1), a2, un, 1);
            PG8_WAIT_V(8); PG8_WAIT_L(0); PG8_BAR; PG8_MMA(0, 0, At, B0); PG8_MMA(0, 1, At, B1); PG8_BAR; PG8_SCHED;
            PG8_LDA(At, 1, 1); PG8_STAGE(PG8_SB(1, 0), b3, voffB); PG8_STAGE(PG8_SB(1, 1), b3 + hstep, voffB); PG8_STAGE_A(PG8_SA(1, 0), a3, un, 0);
            PG8_WAIT_V(8); PG8_WAIT_L(0); PG8_BAR; PG8_MMA(1, 0, At, B0); PG8_MMA(1, 1, At, B1); PG8_BAR; PG8_SCHED;
        }
        if (wr == 0) PG8_BAR;
        E(acc, cur, wr, wc, fr, fq);
        if (!has_next) break;
#pragma unroll
        for (int a = 0; a < 2; ++a)
#pragma unroll
            for (int b = 0; b < 2; ++b)
#pragma unroll
                for (int m = 0; m < 4; ++m)
#pragma unroll
                    for (int n = 0; n < 2; ++n) acc[a][b][m][n] = (f32x4){0.f, 0.f, 0.f, 0.f};
        cur = nxt; cA = nA; cB = nB; ++ui;
        if (wr == 1) PG8_BAR;
    }
    PG8_WAIT_V(0);
    PG8_BAR;
#undef PG8_SA
#undef PG8_SB
#undef PG8_STAGE
#undef PG8_STAGE_A
#undef PG8_LDA
#undef PG8_LDB
#undef PG8_MMA
#undef PG8_WAIT_V
#undef PG8_WAIT_L
#undef PG8_BAR
#undef PG8_SCHED
}
}
#define GAS __attribute__((address_space(1)))
#define LAS __attribute__((address_space(3)))
typedef unsigned v4u __attribute__((ext_vector_type(4)));
typedef float f32x4 __attribute__((ext_vector_type(4)));
typedef short bf16x8 __attribute__((ext_vector_type(8)));
typedef GAS unsigned gu32;
typedef GAS unsigned long long gu64;
#define RLX_AGENT __ATOMIC_RELAXED, __HIP_MEMORY_SCOPE_AGENT
#define LDS_WAIT() asm volatile("s_waitcnt lgkmcnt(0)" ::: "memory")
#define VM_WAIT() asm volatile("s_waitcnt vmcnt(0)" ::: "memory")
__device__ __forceinline__ unsigned long long rt() { return __builtin_amdgcn_s_memrealtime(); }


#define XB_TMO      128
#define XB_XCNT(j)  (256  + 64 * (j))
#define XB_XSUB(j)  (1280 + 64 * (j))
#define XB_XGEN(j)  (2304 + 64 * (j))
#define XB_TOP      3328
#define XB_TOPGEN   3392
#define XCD_BAR_WORDS 3456
#define XB_SPIN_CAP (1u << 18)

__device__ __forceinline__ unsigned xb_ld(unsigned* p)              { return __hip_atomic_load(p, __ATOMIC_RELAXED, __HIP_MEMORY_SCOPE_AGENT); }
__device__ __forceinline__ unsigned xb_add(unsigned* p, unsigned v) { return __hip_atomic_fetch_add(p, v, __ATOMIC_RELAXED, __HIP_MEMORY_SCOPE_AGENT); }
__device__ __forceinline__ unsigned xb_xcc_id() { return (unsigned)__builtin_amdgcn_s_getreg((3 << 11) | 20) & 0xFu; }
#define XB_SPIN(cond, bar) do { unsigned _sp = 0; while (cond) { __builtin_amdgcn_s_sleep(1); \
    if ((++_sp & 255u) == 0u) { if (xb_ld(&(bar)[XB_TMO])) break; if (_sp > XB_SPIN_CAP) { atomicAdd(&(bar)[XB_TMO], 1u); break; } } } } while (0)

struct XcdBarrier {
    unsigned* bar; unsigned x;
    volatile LAS unsigned* st;
};

__device__ __forceinline__ XcdBarrier xcd_barrier_post(unsigned* bar, volatile LAS unsigned* st) {
    XcdBarrier b; b.bar = bar; b.x = xb_xcc_id(); b.st = st;
    if (threadIdx.x == 0) (void)xb_add(&bar[XB_XCNT(b.x)], 1u);
    return b;
}
__device__ __forceinline__ void xcd_barrier_complete(unsigned* bar, unsigned x, unsigned& nloc, unsigned& nx) {
    const unsigned G = gridDim.x * gridDim.y * gridDim.z;
    unsigned sum, cnt, mine, sp = 0u;
    for (;;) {
        sum = 0u; cnt = 0u; mine = 0u;
#pragma unroll
        for (unsigned j = 0; j < 16; ++j) { const unsigned c = xb_ld(&bar[XB_XCNT(j)]); sum += c; cnt += (c > 0u) ? 1u : 0u; mine = (j == x) ? c : mine; }
        if (sum == G) break;
        __builtin_amdgcn_s_sleep(1);
        if ((++sp & 255u) == 0u) { if (xb_ld(&bar[XB_TMO])) break; if (sp > XB_SPIN_CAP) { atomicAdd(&bar[XB_TMO], 1u); break; } }
    }
    nloc = mine > 0u ? mine : 1u; nx = cnt > 0u ? cnt : 1u;
}

__device__ __forceinline__ void xcd_barrier(const XcdBarrier& b) {
    asm volatile("s_waitcnt vmcnt(0)" ::: "memory");
    __syncthreads();
    if (threadIdx.x == 0) {
        unsigned* bar = b.bar;
        __builtin_amdgcn_s_waitcnt(0);
        unsigned nloc = b.st[0], nx = b.st[1];
        if (nloc == 0u) { xcd_barrier_complete(bar, b.x, nloc, nx); b.st[0] = nloc; b.st[1] = nx; }
        const unsigned old = xb_add(&bar[XB_XSUB(b.x)], 1u);
        const unsigned gen = old / nloc;
        if (old + 1u == (gen + 1u) * nloc) {
            __builtin_amdgcn_fence(__ATOMIC_RELEASE, "agent");
            asm volatile("s_waitcnt vmcnt(0)" ::: "memory");
            const unsigned og = xb_add(&bar[XB_TOP], 1u);
            const unsigned tg = og / nx;
            if (og + 1u == (tg + 1u) * nx) xb_add(&bar[XB_TOPGEN], 1u);
            else XB_SPIN(xb_ld(&bar[XB_TOPGEN]) == tg, bar);
            __builtin_amdgcn_fence(__ATOMIC_ACQUIRE, "agent");
            xb_add(&bar[XB_XGEN(b.x)], 1u);
            asm volatile("s_waitcnt vmcnt(0)" ::: "memory");
        } else {
            XB_SPIN(xb_ld(&bar[XB_XGEN(b.x)]) == gen, bar);
            __builtin_amdgcn_fence(__ATOMIC_ACQUIRE, "agent");
            asm volatile("s_waitcnt vmcnt(0)" ::: "memory");
        }
    }
    __syncthreads();
}
namespace mx {
typedef short bf16x8 __attribute__((ext_vector_type(8)));
typedef short s16x4 __attribute__((ext_vector_type(4)));
typedef float f32x16 __attribute__((ext_vector_type(16)));
typedef LAS const char* lcp;
__device__ __forceinline__ int crow(int r, int hi) { return (r & 3) + 8 * (r >> 2) + 4 * hi; }
__device__ __forceinline__ s16x4 trr(lcp p) { return __builtin_bit_cast(s16x4, __builtin_amdgcn_ds_read_tr16_b64_v4i16((LAS s16x4*)p)); }
__device__ __forceinline__ bf16x8 trfrag(lcp tb, int stride, int rA, int rB, int c0) {
    const s16x4 a = trr(tb + rA * stride + c0 * 2), b = trr(tb + rB * stride + c0 * 2);
    return (bf16x8){a[0], a[1], a[2], a[3], b[0], b[1], b[2], b[3]};
}
__device__ __forceinline__ lcp tr_base(lcp tile, int stride, int lane) { const int i16 = lane & 15, g16 = (lane >> 4) & 1; return tile + (i16 >> 2) * stride + (16 * g16 + 4 * (i16 & 3)) * 2; }
__device__ __forceinline__ unsigned cvtpk(float lo, float hi) { unsigned r; asm volatile("v_cvt_pk_bf16_f32 %0, %1, %2" : "=v"(r) : "v"(lo), "v"(hi)); return r; }
__device__ __forceinline__ bf16x8 accfrag(const f32x16& x, int s) {
    v4u w; w.x = cvtpk(x[8 * s + 0], x[8 * s + 1]); w.y = cvtpk(x[8 * s + 2], x[8 * s + 3]); w.z = cvtpk(x[8 * s + 4], x[8 * s + 5]); w.w = cvtpk(x[8 * s + 6], x[8 * s + 7]);
    return __builtin_bit_cast(bf16x8, w);
}
__device__ __forceinline__ float ret_lg2(int h) { return log1pf(-exp2f(-5.0f - (float)h)) * LOG2E; }
#define MFMA32(a, b, c) __builtin_amdgcn_mfma_f32_32x32x16_bf16((a), (b), (c), 0, 0, 0)

constexpr int TS = 320;
constexpr int KS = 272;

__device__ __forceinline__ void ret_kv_unit(unsigned char* ws, LAS unsigned char* lds, int bhn, int tid, int wave, int lane) {
    const int n = bhn % NC, h = (bhn / NC) % RH, b = bhn / (NC * RH);
    const size_t t0 = (size_t)b * SEQ + (size_t)n * RC;
    const bf16* RK = (const bf16*)(ws + WS_RK) + t0 * 512 + h * 128; const bf16* RV = (const bf16*)(ws + WS_RV) + t0 * 512 + h * 128;
    LAS unsigned char* Kt = lds; LAS unsigned char* Vt = lds + 128 * TS;
    const float lg2 = ret_lg2(h);
    for (int c = tid; c < 2048; c += 512) { const int row = c >> 4, ch = c & 15;
        const v4u kq = *(const GAS v4u*)(RK + (size_t)row * 512 + ch * 8), vq = *(const GAS v4u*)(RV + (size_t)row * 512 + ch * 8);
        const float z = __builtin_amdgcn_exp2f((127.f - (float)row) * lg2);
        v4u ko; ko.x = pk2(bf2f(kq.x & 0xffff) * z, bf2f(kq.x >> 16) * z); ko.y = pk2(bf2f(kq.y & 0xffff) * z, bf2f(kq.y >> 16) * z); ko.z = pk2(bf2f(kq.z & 0xffff) * z, bf2f(kq.z >> 16) * z); ko.w = pk2(bf2f(kq.w & 0xffff) * z, bf2f(kq.w >> 16) * z);
        *(LAS v4u*)(Kt + row * TS + ch * 16) = ko; *(LAS v4u*)(Vt + row * TS + ch * 16) = vq; }
    __syncthreads();
    const int hi = lane >> 5, dt = wave >> 1, vh = wave & 1;
    const lcp kb = tr_base((lcp)Kt, TS, lane), vb = tr_base((lcp)Vt, TS, lane);
    f32x16 a0 = {}, a1 = {};
#pragma unroll
    for (int ks = 0; ks < 8; ++ks) { const int rA = 16 * ks + 4 * hi, rB = rA + 8;
        const bf16x8 A = trfrag(kb, TS, rA, rB, 32 * dt), B0 = trfrag(vb, TS, rA, rB, 64 * vh), B1 = trfrag(vb, TS, rA, rB, 64 * vh + 32);
        a0 = MFMA32(A, B0, a0); a1 = MFMA32(A, B1, a1); }
    float* KV = (float*)(ws + WS_KV) + (size_t)bhn * 16384;
#pragma unroll
    for (int r = 0; r < 16; ++r) { const int d = 32 * dt + crow(r, hi); KV[d * 128 + 64 * vh + (lane & 31)] = a0[r]; KV[d * 128 + 64 * vh + 32 + (lane & 31)] = a1[r]; }
    __syncthreads();
}
__device__ __forceinline__ void ret_scan(unsigned char* ws, int gtid, int nthreads) {
    const float* KV = (const float*)(ws + WS_KV); bf16* ST = (bf16*)(ws + WS_ST);
    for (int c = gtid; c < BATCH * RH * 16384; c += nthreads) { const int bh = c >> 14, o = c & 16383, h = bh % RH;
        const float decay = __builtin_amdgcn_exp2f(128.f * ret_lg2(h));
        float kv[NC];
#pragma unroll
        for (int n = 0; n < NC; ++n) kv[n] = KV[((size_t)bh * NC + n) * 16384 + o];
        float st = 0.f;
#pragma unroll
        for (int n = 0; n < NC; ++n) { ST[((size_t)bh * NC + n) * 16384 + o] = (bf16)f2bf(st); st = decay * st + kv[n]; } }
}
constexpr int SKS = 144, SVS = 192;
__device__ __forceinline__ void swa_unit(unsigned char* ws, LAS unsigned char* lds, const float* sinks, int unit, int tid, int wave, int lane) {
    const int kvh = unit & 1, nb = (unit >> 1) & 31, b = unit >> 6;
    const size_t tb0 = (size_t)b * SEQ + (size_t)nb * WIN;
    LAS unsigned char* Kt = lds; LAS unsigned char* Vt = lds + 256 * SKS;
    { const bf16* SK = (const bf16*)(ws + WS_SK) + kvh * 64; const bf16* SV = (const bf16*)(ws + WS_SV) + kvh * 64;
      for (int c = tid; c < 2048; c += 512) { const int row = c >> 3, ch = c & 7; v4u kq = {0u, 0u, 0u, 0u}, vq = {0u, 0u, 0u, 0u};
          if (nb > 0 || row >= WIN) { const size_t tk = tb0 - WIN + row; kq = *(const GAS v4u*)(SK + tk * 128 + ch * 8); vq = *(const GAS v4u*)(SV + tk * 128 + ch * 8); }
          *(LAS v4u*)(Kt + row * SKS + ch * 16) = kq; *(LAS v4u*)(Vt + row * SVS + ch * 16) = vq; } }
    __syncthreads();
    const int hi = lane >> 5, r32 = lane & 31, g = wave >> 1, qh = wave & 1, head = kvh * 4 + g;
    const float slope2 = __builtin_amdgcn_exp2f(-(float)(head + 1)) * LOG2E, sink2 = sinks[head] * LOG2E;
    const lcp vb = tr_base((lcp)Vt, SVS, lane);
    const bf16* SQ = (const bf16*)(ws + WS_SQ); bf16* AS = (bf16*)(ws + WS_AS);
#pragma unroll 1
    for (int qt = 0; qt < 2; ++qt) {
        const int q0 = qh * 64 + qt * 32, q = q0 + r32, kt0 = q0 >> 5;
        bf16x8 qf[4];
#pragma unroll
        for (int ks = 0; ks < 4; ++ks) qf[ks] = *(const GAS bf16x8*)(SQ + (tb0 + q) * 512 + head * 64 + 16 * ks + 8 * hi);
        f32x16 p[5];
#pragma unroll
        for (int j = 0; j < 5; ++j) { p[j] = (f32x16){};
            const lcp kr = (lcp)Kt + (32 * (kt0 + j) + r32) * SKS + 16 * hi;
#pragma unroll
            for (int ks = 0; ks < 4; ++ks) p[j] = MFMA32(*(const LAS bf16x8*)(kr + 32 * ks), qf[ks], p[j]); }
        float m = sink2; const int lim = nb > 0 ? WIN - 1 : (q < WIN - 1 ? q : WIN - 1);
#pragma unroll
        for (int j = 0; j < 5; ++j) { const int relb = q + WIN - 32 * (kt0 + j) - 4 * hi;
#pragma unroll
            for (int r = 0; r < 16; ++r) { const int rel = relb - ((r & 3) + 8 * (r >> 2));
                const float v = (unsigned)rel <= (unsigned)lim ? p[j][r] - slope2 * (float)rel : -__builtin_inff(); p[j][r] = v; m = fmaxf(m, v); } }
        m = fmaxf(m, __shfl_xor(m, 32));
        float l = 0.f;
#pragma unroll
        for (int j = 0; j < 5; ++j)
#pragma unroll
            for (int r = 0; r < 16; ++r) { const float e = __builtin_amdgcn_exp2f(p[j][r] - m); p[j][r] = e; l += e; }
        l += __shfl_xor(l, 32); l += __builtin_amdgcn_exp2f(sink2 - m);
        const float rl = 1.f / l;
        f32x16 o0 = {}, o1 = {};
#pragma unroll
        for (int j = 0; j < 5; ++j)
#pragma unroll
            for (int s = 0; s < 2; ++s) { const int rA = 32 * (kt0 + j) + 16 * s + 4 * hi, rB = rA + 8; const bf16x8 P = accfrag(p[j], s);
                o0 = MFMA32(trfrag(vb, SVS, rA, rB, 0), P, o0); o1 = MFMA32(trfrag(vb, SVS, rA, rB, 32), P, o1); }
        bf16* orow = AS + (tb0 + q) * 512 + head * 64;
#pragma unroll
        for (int rg = 0; rg < 4; ++rg) { const int d = 8 * rg + 4 * hi;
            pg8::u32x2 w0, w1; w0.x = cvtpk(o0[4 * rg] * rl, o0[4 * rg + 1] * rl); w0.y = cvtpk(o0[4 * rg + 2] * rl, o0[4 * rg + 3] * rl); w1.x = cvtpk(o1[4 * rg] * rl, o1[4 * rg + 1] * rl); w1.y = cvtpk(o1[4 * rg + 2] * rl, o1[4 * rg + 3] * rl);
            *(GAS pg8::u32x2*)(orow + d) = w0; *(GAS pg8::u32x2*)(orow + 32 + d) = w1; }
    }
    __syncthreads();
}
__device__ __forceinline__ void ret_out_unit(unsigned char* ws, LAS unsigned char* lds, const float* gn_g, const float* gn_b, int bhn, int tid, int wave, int lane) {
    const int n = bhn % NC, h = (bhn / NC) % RH, b = bhn / (NC * RH);
    const size_t t0 = (size_t)b * SEQ + (size_t)n * RC;
    const bf16* RQ = (const bf16*)(ws + WS_RQ) + t0 * 512 + h * 128; const bf16* RK = (const bf16*)(ws + WS_RK) + t0 * 512 + h * 128; const bf16* RV = (const bf16*)(ws + WS_RV) + t0 * 512 + h * 128;
    const bf16* ST = (const bf16*)(ws + WS_ST) + (size_t)bhn * 16384;
    LAS unsigned char* Kt = lds; LAS unsigned char* Vt = lds + 128 * KS; LAS unsigned char* St = Vt + 128 * TS; LAS float* xs = (LAS float*)(St + 128 * TS);
    for (int c = tid; c < 2048; c += 512) { const int row = c >> 4, ch = c & 15;
        *(LAS v4u*)(Kt + row * KS + ch * 16) = *(const GAS v4u*)(RK + (size_t)row * 512 + ch * 8);
        *(LAS v4u*)(Vt + row * TS + ch * 16) = *(const GAS v4u*)(RV + (size_t)row * 512 + ch * 8);
        *(LAS v4u*)(St + row * TS + ch * 16) = *(const GAS v4u*)(ST + (size_t)row * 128 + ch * 8); }
    __syncthreads();
    const int hi = lane >> 5, r32 = lane & 31, it = wave >> 1, vh = wave & 1, i = 32 * it + r32;
    const float lg2 = ret_lg2(h);
    bf16x8 qf[8];
#pragma unroll
    for (int ks = 0; ks < 8; ++ks) qf[ks] = *(const GAS bf16x8*)(RQ + (size_t)i * 512 + 16 * ks + 8 * hi);
    const lcp vb = tr_base((lcp)Vt, TS, lane), sb = tr_base((lcp)St, TS, lane);
    f32x16 y0 = {}, y1 = {};
#pragma unroll
    for (int ks = 0; ks < 8; ++ks) { const int rA = 16 * ks + 8 * hi, rB = rA + 4;
        y0 = MFMA32(trfrag(sb, TS, rA, rB, 64 * vh), qf[ks], y0); y1 = MFMA32(trfrag(sb, TS, rA, rB, 64 * vh + 32), qf[ks], y1); }
    { const float xi = __builtin_amdgcn_exp2f((float)(i + 1) * lg2);
#pragma unroll
      for (int r = 0; r < 16; ++r) { y0[r] *= xi; y1[r] *= xi; } }
#pragma unroll 1
    for (int jt = 0; jt <= it; ++jt) {
        f32x16 p = {};
        const lcp kr = (lcp)Kt + (32 * jt + r32) * KS + 16 * hi;
#pragma unroll
        for (int ks = 0; ks < 8; ++ks) p = MFMA32(*(const LAS bf16x8*)(kr + 32 * ks), qf[ks], p);
#pragma unroll
        for (int r = 0; r < 16; ++r) { const int dj = i - (32 * jt + crow(r, hi)); p[r] = dj >= 0 ? p[r] * __builtin_amdgcn_exp2f((float)dj * lg2) : 0.f; }
#pragma unroll
        for (int s = 0; s < 2; ++s) { const int rA = 32 * jt + 16 * s + 4 * hi, rB = rA + 8; const bf16x8 P = accfrag(p, s);
            y0 = MFMA32(trfrag(vb, TS, rA, rB, 64 * vh), P, y0); y1 = MFMA32(trfrag(vb, TS, rA, rB, 64 * vh + 32), P, y1); }
    }
    float s1 = 0.f, s2 = 0.f;
#pragma unroll
    for (int r = 0; r < 16; ++r) { s1 += y0[r] + y1[r]; s2 += y0[r] * y0[r] + y1[r] * y1[r]; }
    s1 += __shfl_xor(s1, 32); s2 += __shfl_xor(s2, 32);
    if (hi == 0) { xs[(i * 2 + vh) * 2] = s1; xs[(i * 2 + vh) * 2 + 1] = s2; }
    __syncthreads();
    { const float o1 = xs[(i * 2 + (vh ^ 1)) * 2], o2 = xs[(i * 2 + (vh ^ 1)) * 2 + 1]; s1 += o1; s2 += o2; }
    const float mu = s1 * (1.f / 128.f), var = fmaxf(s2 * (1.f / 128.f) - mu * mu, 0.f), rstd = rsqrtf(var + EPS);
    const bf16* RG = (const bf16*)(ws + WS_RG) + (t0 + i) * 512 + h * 128; bf16* AR = (bf16*)(ws + WS_AR) + (t0 + i) * 512 + h * 128;
#pragma unroll
    for (int rg = 0; rg < 4; ++rg)
#pragma unroll
        for (int half = 0; half < 2; ++half) { const int v = 64 * vh + 32 * half + 8 * rg + 4 * hi;
            const f32x4 gg = *(const GAS f32x4*)(gn_g + h * 128 + v), bb = *(const GAS f32x4*)(gn_b + h * 128 + v); const f32x4 sg = pg8::unpack4(*(const GAS pg8::u32x2*)(RG + v));
            float o[4];
#pragma unroll
            for (int e = 0; e < 4; ++e) { const float yv = half ? y1[4 * rg + e] : y0[4 * rg + e]; o[e] = sg[e] * ((yv - mu) * rstd * gg[e] + bb[e]); }
            pg8::u32x2 w; w.x = cvtpk(o[0], o[1]); w.y = cvtpk(o[2], o[3]); *(GAS pg8::u32x2*)(AR + v) = w; }
    __syncthreads();
}
#undef MFMA32
}

constexpr int NWAVES = 8;
constexpr int RING_OFF = 0, RING_BYTES = 131072;
constexpr int LDSCTL_OFF = RING_BYTES, MISC_OFF = LDSCTL_OFF + 320;
constexpr int GTAB_OFF = LDSCTL_OFF + 2048;
constexpr int LDS_BYTES = 147456;

__device__ __forceinline__ void p0_transpose_item(const float* W, int ldw, int k0, int ns0, bf16* WT, int ldt, int nd0, const float* ks, LAS float* scr, int lane) {
    float ld[32];
#pragma unroll
    for (int i = 0; i < 32; ++i) ld[i] = W[(size_t)(k0 + 2 * i + (lane >> 5)) * ldw + ns0 + (lane & 31)];
#pragma unroll
    for (int i = 0; i < 32; ++i) scr[(2 * i + (lane >> 5)) * 33 + (lane & 31)] = ld[i];
    LDS_WAIT(); asm volatile("" ::: "memory");
    const int c = lane & 7;
    float sc[8];
#pragma unroll
    for (int i = 0; i < 8; ++i) sc[i] = ks ? ks[k0 + 8 * c + i] : 1.f;
#pragma unroll
    for (int j = 0; j < 4; ++j) { const int n = (lane >> 3) + 8 * j; const LAS float* s = scr + (8 * c) * 33 + n;
        v4u o; o.x = pk2(s[0 * 33] * sc[0], s[1 * 33] * sc[1]); o.y = pk2(s[2 * 33] * sc[2], s[3 * 33] * sc[3]); o.z = pk2(s[4 * 33] * sc[4], s[5 * 33] * sc[5]); o.w = pk2(s[6 * 33] * sc[6], s[7 * 33] * sc[7]);
        *(GAS v4u*)(WT + (size_t)(nd0 + n) * ldt + k0 + 8 * c) = o; }
    LDS_WAIT(); asm volatile("" ::: "memory");
}
__device__ __forceinline__ void rms_rows2_to_bf16(const float* x, const float* g, bf16* o, int r0, int r1, int lane) {
    const GAS f32x4* x0 = (const GAS f32x4*)(x + (size_t)r0 * D) + lane; const GAS f32x4* x1 = (const GAS f32x4*)(x + (size_t)r1 * D) + lane;
    f32x4 v0[4], v1[4]; float s0 = 0.f, s1 = 0.f;
#pragma unroll
    for (int j = 0; j < 4; ++j) { v0[j] = x0[64 * j]; v1[j] = x1[64 * j]; }
#pragma unroll
    for (int j = 0; j < 4; ++j) { s0 += (v0[j].x * v0[j].x + v0[j].y * v0[j].y) + (v0[j].z * v0[j].z + v0[j].w * v0[j].w); s1 += (v1[j].x * v1[j].x + v1[j].y * v1[j].y) + (v1[j].z * v1[j].z + v1[j].w * v1[j].w); }
    const float q0 = rsqrtf(wave_sum(s0) * (1.f / D) + EPS), q1 = rsqrtf(wave_sum(s1) * (1.f / D) + EPS);
    GAS unsigned long long* o0 = (GAS unsigned long long*)(o + (size_t)r0 * D) + lane; GAS unsigned long long* o1 = (GAS unsigned long long*)(o + (size_t)r1 * D) + lane;
#pragma unroll
    for (int j = 0; j < 4; ++j) { const f32x4 gg = ((const GAS f32x4*)g)[lane + 64 * j];
        o0[64 * j] = (unsigned long long)pk2(v0[j].x * q0 * gg.x, v0[j].y * q0 * gg.y) | ((unsigned long long)pk2(v0[j].z * q0 * gg.z, v0[j].w * q0 * gg.w) << 32);
        o1[64 * j] = (unsigned long long)pk2(v1[j].x * q1 * gg.x, v1[j].y * q1 * gg.y) | ((unsigned long long)pk2(v1[j].z * q1 * gg.z, v1[j].w * q1 * gg.w) << 32); }
}

struct Args { const float* in[24]; float* out; unsigned char* ws; int ph_lo, ph_hi; };
template <int I> __device__ __forceinline__ const float* karg() {
    unsigned long long v; asm volatile("s_load_dwordx2 %0, %1, %2\n\ts_waitcnt lgkmcnt(0)" : "=s"(v) : "s"(__builtin_amdgcn_kernarg_segment_ptr()), "i"(I * 8)); return (const float*)v; }
enum { I_X = 0, I_P, I_MIXG, I_WIN, I_GNG, I_GNB, I_WRO, I_QG, I_KG, I_SINK, I_WSO, I_WOUT, I_FFNG, I_WRG, I_BRG, I_WRE, I_BRE, I_WEG, I_WEU, I_WED, I_PGG, I_WPG, I_WPLE, I_PLEG };

__device__ __forceinline__ void p0_prologue(unsigned char* ws, LAS unsigned char* lds, int vcu, int G, int wave, int lane) {
    LAS float* scr = (LAS float*)(lds + RING_OFF + wave * 16384);
    const int gw = vcu * NWAVES + wave, NGW = G * NWAVES;
    const float* a_win = karg<I_WIN>(); const float* a_wro = karg<I_WRO>(); const float* a_wso = karg<I_WSO>(); const float* a_wout = karg<I_WOUT>(); const float* a_wpg = karg<I_WPG>(); const float* a_pgg = karg<I_PGG>(); const float* a_wple = karg<I_WPLE>();
    constexpr int I_IN = 16 * 152, I_RO = 8 * 32, I_SO = 8 * 32, I_OUT = 16 * 32, I_PG = 16 * 32, I_PL = 4 * 32;
    constexpr int NITEMS = I_IN + I_RO + I_SO + I_OUT + I_PG + I_PL;
    for (int it = gw; it < NITEMS; it += NGW) {
        int r = it;
        if (r < I_IN) { const int kb = r / 152, nb = r % 152, pn = nb >> 3, q = nb & 7; int ns0 = 32 * nb;
            if (pn >= 8 && pn <= 10) ns0 = 256 * pn + 32 * (((q & 3) << 1) | (q >> 2));
            p0_transpose_item(a_win, INW, 64 * kb, ns0, (bf16*)(ws + WS_WIN), D, 32 * nb, nullptr, scr, lane); continue; } r -= I_IN;
        if (r < I_RO) { p0_transpose_item(a_wro, D, 64 * (r / 32), 32 * (r % 32), (bf16*)(ws + WS_WRO), 512, 32 * (r % 32), nullptr, scr, lane); continue; } r -= I_RO;
        if (r < I_SO) { p0_transpose_item(a_wso, D, 64 * (r / 32), 32 * (r % 32), (bf16*)(ws + WS_WSO), 512, 32 * (r % 32), nullptr, scr, lane); continue; } r -= I_SO;
        if (r < I_OUT) { p0_transpose_item(a_wout, D, 64 * (r / 32), 32 * (r % 32), (bf16*)(ws + WS_WOUT), D, 32 * (r % 32), nullptr, scr, lane); continue; } r -= I_OUT;
        if (r < I_PG) { p0_transpose_item(a_wpg, D, 64 * (r / 32), 32 * (r % 32), (bf16*)(ws + WS_WPG), D, 32 * (r % 32), a_pgg, scr, lane); continue; } r -= I_PG;
        p0_transpose_item(a_wple, D, 64 * (r / 32), 32 * (r % 32), (bf16*)(ws + WS_WPLE), PLE, 32 * (r % 32), nullptr, scr, lane);
    }
    { const float* g = karg<I_FFNG>(); const float* wrg = karg<I_WRG>(); const float* wre = karg<I_WRE>(); float* wrt = (float*)(ws + WS_WRT);
      for (int idx = gw * 64 + lane; idx < 36 * D; idx += NGW * 64) { const int o = idx >> 10, k = idx & 1023; wrt[idx] = g[k] * (o < 4 ? wrg[k * 4 + o] : wre[k * 32 + (o - 4)]); } }
    { const float* xx = karg<I_X>(); const float* mg = karg<I_MIXG>();
      for (int m = gw; m < T; m += 2 * NGW) rms_rows2_to_bf16(xx, mg, (bf16*)(ws + WS_XN), m, m + NGW < T ? m + NGW : m, lane); }
}


__device__ __forceinline__ void router_block(unsigned char* ws, const float* brg, const float* bre, LAS unsigned char* sc, int rb, int tid, int wave, int lane) {
    LAS float* wl = (LAS float*)sc; LAS float* dots = (LAS float*)(sc + 73728); LAS float* rsl = dots + 64 * 36; LAS unsigned* lcnt = (LAS unsigned*)(rsl + 64); LAS unsigned* lbase = lcnt + 32;
    const float* wrt = (const float*)(ws + WS_WRT);
    if (tid < 32) lcnt[tid] = 0u;
    const int row0 = rb * 64 + wave * 8;
    f32x4 xv[8][4];
    { pg8::u32x2 xr[8][4];
#pragma unroll
      for (int r = 0; r < 8; ++r)
#pragma unroll
          for (int j = 0; j < 4; ++j) xr[r][j] = ((const GAS pg8::u32x2*)((const bf16*)(ws + WS_X1B) + (size_t)(row0 + r) * D))[64 * j + lane];
#pragma unroll
      for (int r = 0; r < 8; ++r) { float ss = 0.f;
#pragma unroll
          for (int j = 0; j < 4; ++j) { xv[r][j] = pg8::unpack4(xr[r][j]); ss += (xv[r][j].x * xv[r][j].x + xv[r][j].y * xv[r][j].y) + (xv[r][j].z * xv[r][j].z + xv[r][j].w * xv[r][j].w); }
          ss = wave_sum(ss); if (lane == 0) rsl[wave * 8 + r] = rsqrtf(ss * (1.f / D) + EPS); } }
    const int myr = ((lane >> 5) & 1) * 4 + ((lane >> 4) & 1) * 2 + ((lane >> 3) & 1);
#pragma unroll 1
    for (int half = 0; half < 2; ++half) {
        __syncthreads();
        { f32x4 t[9];
#pragma unroll
          for (int i = 0; i < 9; ++i) t[i] = ((const GAS f32x4*)(wrt + half * 18 * D))[i * 512 + tid];
#pragma unroll
          for (int i = 0; i < 9; ++i) ((LAS f32x4*)wl)[i * 512 + tid] = t[i]; }
        __syncthreads();
#pragma unroll 2
        for (int o = 0; o < 18; ++o) {
            f32x4 w[4]; float acc[8];
#pragma unroll
            for (int j = 0; j < 4; ++j) w[j] = ((const LAS f32x4*)(wl + o * D))[64 * j + lane];
#pragma unroll
            for (int r = 0; r < 8; ++r) { float s = 0.f;
#pragma unroll
                for (int j = 0; j < 4; ++j) s += (xv[r][j].x * w[j].x + xv[r][j].y * w[j].y) + (xv[r][j].z * w[j].z + xv[r][j].w * w[j].w);
                acc[r] = s; }
            { const bool up = (lane & 32) != 0;
#pragma unroll
              for (int i = 0; i < 4; ++i) { const float keep = up ? acc[i + 4] : acc[i], send = up ? acc[i] : acc[i + 4]; acc[i] = keep + __shfl_xor(send, 32); } }
            { const bool up = (lane & 16) != 0;
#pragma unroll
              for (int i = 0; i < 2; ++i) { const float keep = up ? acc[i + 2] : acc[i], send = up ? acc[i] : acc[i + 2]; acc[i] = keep + __shfl_xor(send, 16); } }
            { const bool up = (lane & 8) != 0; const float keep = up ? acc[1] : acc[0], send = up ? acc[0] : acc[1]; acc[0] = keep + __shfl_xor(send, 8); }
            float v = acc[0]; v += __shfl_xor(v, 4); v += __shfl_xor(v, 2); v += __shfl_xor(v, 1);
            if ((lane & 7) == 0) dots[(wave * 8 + myr) * 36 + half * 18 + o] = v;
        }
    }
    __syncthreads();
    int e1 = 0, e2 = 0; unsigned lp1 = 0, lp2 = 0; const int row = row0 + lane;
    if (lane < 8) {
        const float rstd = rsl[wave * 8 + lane]; const LAS float* dr = dots + (wave * 8 + lane) * 36;
        float lg[4], le[32];
#pragma unroll
        for (int o = 0; o < 4; ++o) lg[o] = dr[o] * rstd + brg[o];
#pragma unroll
        for (int o = 0; o < 32; ++o) le[o] = dr[4 + o] * rstd + bre[o];
        float gm = lg[0]; int gs = 0;
#pragma unroll
        for (int o = 1; o < 4; ++o) if (lg[o] > gm) { gm = lg[o]; gs = o; }
        float gden = 0.f;
#pragma unroll
        for (int o = 0; o < 4; ++o) gden += __expf(lg[o] - gm);
        const float gw = 1.f / gden;
        float e8[8];
#pragma unroll
        for (int o = 0; o < 8; ++o) e8[o] = gs == 0 ? le[o] : gs == 1 ? le[8 + o] : gs == 2 ? le[16 + o] : le[24 + o];
        float m1 = e8[0]; int i1 = 0;
#pragma unroll
        for (int o = 1; o < 8; ++o) if (e8[o] > m1) { m1 = e8[o]; i1 = o; }
        float m2 = -3.0e38f; int i2 = 0;
#pragma unroll
        for (int o = 0; o < 8; ++o) if (o != i1 && e8[o] > m2) { m2 = e8[o]; i2 = o; }
        const float p2 = __expf(m2 - m1), inv = 1.f / (1.f + p2);
        e1 = gs * 8 + i1; e2 = gs * 8 + i2;
        ((float*)(ws + WS_RSTD1))[row] = rstd;
        ((float*)(ws + WS_CW))[row * 2] = gw * inv; ((float*)(ws + WS_CW))[row * 2 + 1] = gw * p2 * inv;
        lp1 = __hip_atomic_fetch_add(lcnt + e1, 1u, __ATOMIC_RELAXED, __HIP_MEMORY_SCOPE_WORKGROUP);
        lp2 = __hip_atomic_fetch_add(lcnt + e2, 1u, __ATOMIC_RELAXED, __HIP_MEMORY_SCOPE_WORKGROUP);
    }
    __syncthreads();
    if (tid < 32) { const unsigned n = lcnt[tid]; lbase[tid] = n ? __hip_atomic_fetch_add((unsigned*)(ws + WS_CTL) + CW_CNT + 64 * tid, n, __ATOMIC_RELAXED, __HIP_MEMORY_SCOPE_AGENT) : 0u; }
    __syncthreads();
    if (lane < 8) { int* LIST = (int*)(ws + WS_LIST);
        LIST[e1 * 16384 + (int)(lbase[e1] + lp1)] = row * 2; LIST[e2 * 16384 + (int)(lbase[e2] + lp2)] = row * 2 + 1; }
    __syncthreads();
}
__device__ __forceinline__ void p7_expert_weights(unsigned char* ws, LAS unsigned char* lds, int vcu, int G, int wave, int lane) {
    LAS float* scr = (LAS float*)(lds + RING_OFF + wave * 16384);
    const float* weg = karg<I_WEG>(); const float* weu = karg<I_WEU>(); const float* wed = karg<I_WED>(); const float* ffg = karg<I_FFNG>();
    const int gw = vcu * NWAVES + wave, NGW = G * NWAVES;
    constexpr int I_GU = NE * 16 * 16, I_DN = NE * 4 * 32;
    for (int it = gw; it < I_GU + I_DN; it += NGW) {
        if (it < I_GU) { const int e = it >> 8, r = it & 255, kb = r >> 4, nbd = r & 15, pn = nbd >> 3, bj = (nbd >> 2) & 1, jb = nbd & 3;
            const float* W = (bj ? weu : weg) + (size_t)e * D * FF;
            p0_transpose_item(W, FF, 64 * kb, 128 * pn + 32 * jb, (bf16*)(ws + WS_WGU) + (size_t)e * 512 * D, D, 32 * nbd, ffg, scr, lane); }
        else { const int r2 = it - I_GU, e = r2 >> 7, r = r2 & 127, kb = r >> 5, nb = r & 31;
            p0_transpose_item(wed + (size_t)e * FF * D, D, 64 * kb, 32 * nb, (bf16*)(ws + WS_WD) + (size_t)e * D * FF, FF, 32 * nb, nullptr, scr, lane); }
    }
}
__device__ __forceinline__ pg8::MoeTables moe_tables(unsigned char* ws, LAS unsigned char* tb, int tid) {
    LAS int* cnt = (LAS int*)tb; LAS int* pre = cnt + 32;
    if (tid < 32) cnt[tid] = (int)__hip_atomic_load((unsigned*)(ws + WS_CTL) + CW_CNT + 64 * tid, __ATOMIC_RELAXED, __HIP_MEMORY_SCOPE_AGENT);
    __syncthreads();
    if (tid == 0) { int s = 0; for (int e = 0; e < 32; ++e) { pre[e] = s; s += (cnt[e] + 255) >> 8; } pre[32] = s; }
    __syncthreads();
    return pg8::MoeTables{cnt, pre};
}
__device__ __forceinline__ void combine_rows2(unsigned char* ws, int t0, int t1, int lane) {
    const int tt[2] = {t0, t1}; pg8::u32x2 xr[2][4], ya[2][4], yb[2][4];
#pragma unroll
    for (int q = 0; q < 2; ++q) { const GAS pg8::u32x2* x1 = (const GAS pg8::u32x2*)((const bf16*)(ws + WS_X1B) + (size_t)tt[q] * D) + lane;
        const GAS pg8::u32x2* y0 = (const GAS pg8::u32x2*)((const bf16*)(ws + WS_Y) + (size_t)(2 * tt[q]) * D) + lane;
#pragma unroll
        for (int j = 0; j < 4; ++j) { xr[q][j] = x1[64 * j]; ya[q][j] = y0[64 * j]; yb[q][j] = y0[D / 4 + 64 * j]; } }
#pragma unroll
    for (int q = 0; q < 2; ++q) { GAS pg8::u32x2* xb = (GAS pg8::u32x2*)((bf16*)(ws + WS_X2B) + (size_t)tt[q] * D) + lane; float s = 0.f;
#pragma unroll
        for (int j = 0; j < 4; ++j) { const f32x4 v = pg8::unpack4(xr[q][j]) + pg8::unpack4(ya[q][j]) + pg8::unpack4(yb[q][j]);
            pg8::u32x2 w; w.x = pk2(v.x, v.y); w.y = pk2(v.z, v.w); xb[64 * j] = w;
            const f32x4 vr = pg8::unpack4(w); s += (vr.x * vr.x + vr.y * vr.y) + (vr.z * vr.z + vr.w * vr.w); }
        s = wave_sum(s);
        float sp = lane < 16 ? ((const float*)(ws + WS_SSP))[(size_t)tt[q] * 16 + lane] : 0.f; sp = wave_sum(sp);
        if (lane == 0) { ((float*)(ws + WS_RSTD2))[tt[q]] = rsqrtf(s * (1.f / D) + EPS); ((float*)(ws + WS_RSTDP))[tt[q]] = rsqrtf(sp * (1.f / D) + EPS); } }
}

#define PH_IDS int tid = threadIdx.x; asm volatile("" : "+v"(tid)); const int lane = tid & 63, wave = __builtin_amdgcn_readfirstlane(tid >> 6); (void)lane; (void)wave
struct Ctx { unsigned char* ws; float* out; LAS unsigned char* lds; int G, bx, vcu; };

__device__ __forceinline__ void phase0(const Ctx& c) { PH_IDS; p0_prologue(c.ws, c.lds, c.vcu, c.G, wave, lane); }
__device__ __forceinline__ void phase1(const Ctx& c) { unsigned char* ws = c.ws;
    pg8::TileOrder S; S.init(ws + WS_XN, ws + WS_WIN, T, INW, D, c.G, c.bx);
    pg8::EpiZ E{ws, karg<I_QG>(), karg<I_KG>()};
    pg8::gemm_phase<pg8::EpiZ, pg8::TileOrder>(c.lds + RING_OFF, D, S, E); }
__device__ __forceinline__ void phase2(const Ctx& c) { PH_IDS;
    for (int u = c.bx; u < BATCH * RH * NC; u += c.G) mx::ret_kv_unit(c.ws, c.lds + RING_OFF, u, tid, wave, lane); }
__device__ __forceinline__ void phase3(const Ctx& c) { PH_IDS;
    mx::ret_scan(c.ws, c.bx * (NWAVES * 64) + tid, c.G * NWAVES * 64);
    const float* sinks = karg<I_SINK>();
    for (int u = c.bx; u < BATCH * (SEQ / WIN) * SKV; u += c.G) mx::swa_unit(c.ws, c.lds + RING_OFF, sinks, u, tid, wave, lane); }
__device__ __forceinline__ void phase4(const Ctx& c) { PH_IDS;
    const float* gng = karg<I_GNG>(); const float* gnb = karg<I_GNB>();
    for (int u = c.bx; u < BATCH * RH * NC; u += c.G) mx::ret_out_unit(c.ws, c.lds + RING_OFF, gng, gnb, u, tid, wave, lane); }
__device__ __forceinline__ void phase5(const Ctx& c) { unsigned char* ws = c.ws;
    pg8::TwoPassOrder S; S.init(ws + WS_AR, ws + WS_WRO, ws + WS_AS, ws + WS_WSO, T, D, 512, c.G, c.bx);
    pg8::EpiMerge E{(const bf16*)(ws + WS_GR), (const bf16*)(ws + WS_GS), (bf16*)(ws + WS_MG)};
    pg8::gemm_phase<pg8::EpiMerge, pg8::TwoPassOrder>(c.lds + RING_OFF, 512, S, E); }
__device__ __forceinline__ void phase6(const Ctx& c) { unsigned char* ws = c.ws;
    { PH_IDS; const int gw = c.vcu * NWAVES + wave, NGW = c.G * NWAVES;
      const float* pp_ = karg<I_P>();
      for (int m = gw; m < T; m += 8 * NGW) { f32x4 v[8];
#pragma unroll
          for (int i = 0; i < 8; ++i) v[i] = ((const GAS f32x4*)(pp_ + (size_t)(m + i * NGW) * PLE))[lane];
#pragma unroll
          for (int i = 0; i < 8; ++i) ((GAS unsigned long long*)((bf16*)(ws + WS_PB) + (size_t)(m + i * NGW) * PLE))[lane] = (unsigned long long)pk2(v[i].x, v[i].y) | ((unsigned long long)pk2(v[i].z, v[i].w) << 32); } }
    pg8::TileOrder S; S.init(ws + WS_MG, ws + WS_WOUT, T, D, D, c.G, c.bx);
    pg8::EpiX1 E{karg<I_X>(), (bf16*)(ws + WS_X1B)};
    pg8::gemm_phase<pg8::EpiX1, pg8::TileOrder>(c.lds + RING_OFF, D, S, E); }
__device__ __forceinline__ void phase7(const Ctx& c) { unsigned char* ws = c.ws;
    { PH_IDS; const float* brg = karg<I_BRG>(); const float* bre = karg<I_BRE>();
      for (int rb = c.bx; rb < T / 64; rb += c.G) router_block(ws, brg, bre, c.lds + RING_OFF, rb, tid, wave, lane);
      p7_expert_weights(ws, c.lds, c.vcu, c.G, wave, lane);
      __syncthreads(); }
    pg8::TileOrder S; S.init(ws + WS_PB, ws + WS_WPLE, T, D, PLE, c.G, c.bx);
    pg8::EpiPP E{(bf16*)(ws + WS_PP), (float*)(ws + WS_SSP)};
    pg8::gemm_phase<pg8::EpiPP, pg8::TileOrder>(c.lds + RING_OFF, PLE, S, E); }
__device__ __forceinline__ void phase8(const Ctx& c) { unsigned char* ws = c.ws;
    const pg8::MoeTables tb = moe_tables(ws, c.lds + LDSCTL_OFF + 1024, threadIdx.x);
    pg8::MoeUpOrder S{tb, c.G, c.bx, (const char*)(ws + WS_X1B), (const char*)(ws + WS_WGU), (const int*)(ws + WS_LIST)};
    pg8::EpiUp E{tb, (const int*)(ws + WS_LIST), (const float*)(ws + WS_RSTD1), (const float*)(ws + WS_CW), (bf16*)(ws + WS_HID)};
    pg8::gemm_phase<pg8::EpiUp, pg8::MoeUpOrder>(c.lds + RING_OFF, D, S, E, (LAS unsigned short*)(c.lds + GTAB_OFF)); }
__device__ __forceinline__ void phase9(const Ctx& c) { unsigned char* ws = c.ws;
    const pg8::MoeTables tb = moe_tables(ws, c.lds + LDSCTL_OFF + 1024, threadIdx.x);
    pg8::MoeDownOrder S{tb, c.G, c.bx, (const char*)(ws + WS_HID), (const char*)(ws + WS_WD)};
    pg8::EpiDown E{tb, (const int*)(ws + WS_LIST), (bf16*)(ws + WS_Y)};
    pg8::gemm_phase<pg8::EpiDown, pg8::MoeDownOrder>(c.lds + RING_OFF, FF, S, E); }
__device__ __forceinline__ void phase10(const Ctx& c) { PH_IDS;
    const int gw = c.vcu * NWAVES + wave, NGW = c.G * NWAVES;
    for (int t = gw; t < T; t += 2 * NGW) combine_rows2(c.ws, t, t + NGW < T ? t + NGW : t, lane); }
__device__ __forceinline__ void phase11(const Ctx& c) { unsigned char* ws = c.ws;
    pg8::TileOrder S; S.init(ws + WS_X2B, ws + WS_WPG, T, D, D, c.G, c.bx);
    pg8::EpiFinal E{c.out, (const bf16*)(ws + WS_X2B), (const bf16*)(ws + WS_PP), (const float*)(ws + WS_RSTD2), (const float*)(ws + WS_RSTDP), karg<I_PLEG>()};
    pg8::gemm_phase<pg8::EpiFinal, pg8::TileOrder>(c.lds + RING_OFF, D, S, E); }

constexpr int N_PHASES = 12;
#ifndef PROBE_MASK
#define PROBE_MASK 0
#endif
__global__ void __launch_bounds__(NWAVES * 64, 2) mk_fwd(Args args) {
    extern __shared__ __attribute__((aligned(16))) unsigned char lds_raw[];
    LAS unsigned char* lds = (LAS unsigned char*)lds_raw;
    volatile LAS unsigned* MISC = (volatile LAS unsigned*)(lds + MISC_OFF);
    const int G = gridDim.x; const int bx = blockIdx.x; const int vcu = (G % 8 == 0) ? (bx % 8) * (G / 8) + bx / 8 : bx;
    unsigned char* ws = args.ws;
    gu32* ctl = (gu32*)(ws + WS_CTL);
    for (int u = threadIdx.x; u < (LDS_BYTES - LDSCTL_OFF) / 4; u += NWAVES * 64) ((LAS unsigned*)(lds + LDSCTL_OFF))[u] = 0u;
    __syncthreads();
    XcdBarrier bar = xcd_barrier_post((unsigned*)(ctl + CW_BAR), MISC + 8);
    const int lo = args.ph_lo, hi = args.ph_hi;
    const Ctx c{ws, args.out, lds, G, bx, vcu};
#define RUN(k, f) do { if (lo <= (k) && (k) < hi) { if ((PROBE_MASK >> (k)) & 1) { f(c); xcd_barrier(bar); } f(c); if ((k) + 1 < hi) xcd_barrier(bar); } } while (0)
    RUN(0, phase0); RUN(1, phase1); RUN(2, phase2); RUN(3, phase3); RUN(4, phase4); RUN(5, phase5);
    RUN(6, phase6); RUN(7, phase7); RUN(8, phase8); RUN(9, phase9); RUN(10, phase10); RUN(11, phase11);
#undef RUN
}

__global__ void __launch_bounds__(256) k_rmsnorm_bf16(const float* x, const float* g, bf16* out) {
    const int row = blockIdx.x * 4 + (threadIdx.x >> 6), lane = threadIdx.x & 63;
    const float4* xr = (const float4*)(x + (size_t)row * D) + lane;
    float4 v[4]; float s = 0.f;
#pragma unroll
    for (int j = 0; j < 4; ++j) { v[j] = xr[64 * j]; s += v[j].x * v[j].x + v[j].y * v[j].y + v[j].z * v[j].z + v[j].w * v[j].w; }
    const float rstd = rsqrtf(wave_sum(s) * (1.f / D) + EPS);
#pragma unroll
    for (int j = 0; j < 4; ++j) { const float4 gg = ((const float4*)g)[lane + 64 * j];
        uint2 o; o.x = f2bf(v[j].x * rstd * gg.x) | (f2bf(v[j].y * rstd * gg.y) << 16); o.y = f2bf(v[j].z * rstd * gg.z) | (f2bf(v[j].w * rstd * gg.w) << 16);
        ((uint2*)(out + (size_t)row * D))[lane + 64 * j] = o; }
}

struct NG_Args {
    const void* A; int lda; int a_is_f32; const float* B; int ldb; const float* kscale; int M, N, K;
    const void* A2; const float* B2;
    unsigned char* ws; const float* x; float* out; const float* aux0;
};
enum { MODE_Z = 1, MODE_MERGE = 2, MODE_X1 = 3, MODE_PP = 4, MODE_FINAL = 5 };

template <int MODE> __device__ __forceinline__ void ng_store(const NG_Args& a, int row, int col, float v, float v2) {
    unsigned char* ws = a.ws;
    if (MODE == MODE_Z) {
        if (col < 512) ((bf16*)(ws + WS_RQ))[(size_t)row * 512 + col] = (bf16)f2bf(v);
        else if (col < 1024) ((bf16*)(ws + WS_RK))[(size_t)row * 512 + col - 512] = (bf16)f2bf(v * 0.08838834764831845f);
        else if (col < 1536) ((bf16*)(ws + WS_RV))[(size_t)row * 512 + col - 1024] = (bf16)f2bf(v);
        else if (col < 2048) ((bf16*)(ws + WS_RG))[(size_t)row * 512 + col - 1536] = (bf16)f2bf(v * sigmoidf_(v));
        else if (col < 2816) ((bf16*)(ws + WS_SV))[(size_t)row * 128 + col - 2688] = (bf16)f2bf(v);
        else if (col < 3840) ((bf16*)(ws + WS_GR))[(size_t)row * 1024 + col - 2816] = (bf16)f2bf(sigmoidf_(v));
        else ((bf16*)(ws + WS_GS))[(size_t)row * 1024 + col - 3840] = (bf16)f2bf(sigmoidf_(v));
    } else if (MODE == MODE_MERGE) {
        const float gr = bf2f(((const bf16*)(ws + WS_GR))[(size_t)row * 1024 + col]), gs = bf2f(((const bf16*)(ws + WS_GS))[(size_t)row * 1024 + col]);
        ((bf16*)(ws + WS_MG))[(size_t)row * 1024 + col] = (bf16)f2bf(gr * v + gs * v2);
    } else if (MODE == MODE_X1) {
        const float x1 = a.x[(size_t)row * 1024 + col] + v;
        a.out[(size_t)row * 1024 + col] = x1; ((bf16*)(ws + WS_X1B))[(size_t)row * 1024 + col] = (bf16)f2bf(x1);
    } else if (MODE == MODE_PP) {
        ((bf16*)(ws + WS_PP))[(size_t)row * 1024 + col] = (bf16)f2bf(v);
    } else if (MODE == MODE_FINAL) {
        const float rstd2 = ((const float*)(ws + WS_RSTD2))[row], rstdp = ((const float*)(ws + WS_RSTDP))[row];
        const float ple = bf2f(((const bf16*)(ws + WS_PP))[(size_t)row * 1024 + col]) * rstdp * a.aux0[col];
        const float x2 = a.out[(size_t)row * 1024 + col];
        a.out[(size_t)row * 1024 + col] = x2 + sigmoidf_(rstd2 * v) * ple;
    }
}

template <int MODE> __global__ void __launch_bounds__(256) k_gemm_naive(NG_Args a) {
    __shared__ float As[16][68], Bs[16][68], As2[16][68], Bs2[16][68];
    const int tid = threadIdx.x, tx = tid & 15, ty = tid >> 4;
    const int m0 = blockIdx.y * 64, n0 = blockIdx.x * 64;
    float acc[4][4], acc2[4][4];
#pragma unroll
    for (int i = 0; i < 4; ++i)
#pragma unroll
        for (int j = 0; j < 4; ++j) { acc[i][j] = 0.f; acc2[i][j] = 0.f; }
    const int ar = tid >> 2, ak = (tid & 3) * 4;
    const int bk = tid >> 4, bn = (tid & 15) * 4;
    for (int k0 = 0; k0 < a.K; k0 += 16) {
        float av[4];
        if (a.a_is_f32) { const float4 t = *(const float4*)((const float*)a.A + (size_t)(m0 + ar) * a.lda + k0 + ak); av[0] = t.x; av[1] = t.y; av[2] = t.z; av[3] = t.w; }
        else { const uint2 t = *(const uint2*)((const bf16*)a.A + (size_t)(m0 + ar) * a.lda + k0 + ak); av[0] = bf2f(t.x & 0xffff); av[1] = bf2f(t.x >> 16); av[2] = bf2f(t.y & 0xffff); av[3] = bf2f(t.y >> 16); }
        float4 bv = *(const float4*)(a.B + (size_t)(k0 + bk) * a.ldb + n0 + bn);
        if (a.kscale) { const float s = a.kscale[k0 + bk]; bv.x *= s; bv.y *= s; bv.z *= s; bv.w *= s; }
#pragma unroll
        for (int i = 0; i < 4; ++i) As[ak + i][ar] = av[i];
        Bs[bk][bn] = bv.x; Bs[bk][bn + 1] = bv.y; Bs[bk][bn + 2] = bv.z; Bs[bk][bn + 3] = bv.w;
        if (MODE == MODE_MERGE) {
            const uint2 t = *(const uint2*)((const bf16*)a.A2 + (size_t)(m0 + ar) * a.lda + k0 + ak);
            As2[ak][ar] = bf2f(t.x & 0xffff); As2[ak + 1][ar] = bf2f(t.x >> 16); As2[ak + 2][ar] = bf2f(t.y & 0xffff); As2[ak + 3][ar] = bf2f(t.y >> 16);
            const float4 b2 = *(const float4*)(a.B2 + (size_t)(k0 + bk) * a.ldb + n0 + bn);
            Bs2[bk][bn] = b2.x; Bs2[bk][bn + 1] = b2.y; Bs2[bk][bn + 2] = b2.z; Bs2[bk][bn + 3] = b2.w;
        }
        __syncthreads();
#pragma unroll
        for (int kk = 0; kk < 16; ++kk) {
            float ra[4], rb[4];
#pragma unroll
            for (int i = 0; i < 4; ++i) { ra[i] = As[kk][ty * 4 + i]; rb[i] = Bs[kk][tx * 4 + i]; }
#pragma unroll
            for (int i = 0; i < 4; ++i)
#pragma unroll
                for (int j = 0; j < 4; ++j) acc[i][j] += ra[i] * rb[j];
            if (MODE == MODE_MERGE) {
#pragma unroll
                for (int i = 0; i < 4; ++i) { ra[i] = As2[kk][ty * 4 + i]; rb[i] = Bs2[kk][tx * 4 + i]; }
#pragma unroll
                for (int i = 0; i < 4; ++i)
#pragma unroll
                    for (int j = 0; j < 4; ++j) acc2[i][j] += ra[i] * rb[j];
            }
        }
        __syncthreads();
    }
#pragma unroll
    for (int i = 0; i < 4; ++i)
#pragma unroll
        for (int j = 0; j < 4; ++j) ng_store<MODE>(a, m0 + ty * 4 + i, n0 + tx * 4 + j, acc[i][j], acc2[i][j]);
}

__device__ __forceinline__ float ret_lg(int h) { return log1pf(-exp2f(-5.0f - (float)h)); }

__global__ void __launch_bounds__(256) k_ret_kv(unsigned char* ws) {
    const int bhn = blockIdx.x, n = bhn % NC, h = (bhn / NC) % RH, b = bhn / (NC * RH);
    const bf16* RK = (const bf16*)(ws + WS_RK); const bf16* RV = (const bf16*)(ws + WS_RV);
    float* KV = (float*)(ws + WS_KV) + (size_t)bhn * 128 * 128;
    const float lg = ret_lg(h);
    const size_t t0 = (size_t)b * SEQ + (size_t)n * RC;
    for (int o = threadIdx.x; o < 128 * 128; o += 256) {
        const int d = o >> 7, v = o & 127; float s = 0.f;
        for (int j = 0; j < 128; ++j) s += bf2f(RK[(t0 + j) * 512 + h * 128 + d]) * __expf((127.f - (float)j) * lg) * bf2f(RV[(t0 + j) * 512 + h * 128 + v]);
        KV[o] = s;
    }
}
__global__ void __launch_bounds__(256) k_ret_scan(unsigned char* ws) {
    const int gid = blockIdx.x * 256 + threadIdx.x;
    const int bh = gid >> 14, o = gid & 16383, d = o >> 7, v = o & 127, h = bh % RH;
    const float decay = __expf(128.f * ret_lg(h));
    const float* KV = (const float*)(ws + WS_KV); bf16* ST = (bf16*)(ws + WS_ST);
    float st = 0.f;
    for (int n = 0; n < NC; ++n) {
        const size_t bhn = (size_t)bh * NC + n;
        ST[bhn * 16384 + v * 128 + d] = (bf16)f2bf(st);
        st = decay * st + KV[bhn * 16384 + o];
    }
}
__global__ void __launch_bounds__(256) k_ret_out(unsigned char* ws, const float* gn_g, const float* gn_b) {
    extern __shared__ float sm[];
    float* sc = sm; float* yy = sm + 128 * 128;
    const int bhn = blockIdx.x, n = bhn % NC, h = (bhn / NC) % RH, b = bhn / (NC * RH);
    const bf16* RQ = (const bf16*)(ws + WS_RQ); const bf16* RK = (const bf16*)(ws + WS_RK); const bf16* RV = (const bf16*)(ws + WS_RV);
    const bf16* RG = (const bf16*)(ws + WS_RG); const bf16* ST = (const bf16*)(ws + WS_ST) + (size_t)bhn * 16384; bf16* AR = (bf16*)(ws + WS_AR);
    const float lg = ret_lg(h);
    const size_t t0 = (size_t)b * SEQ + (size_t)n * RC;
    for (int o = threadIdx.x; o < 128 * 128; o += 256) {
        const int i = o >> 7, j = o & 127; float s = 0.f;
        if (i >= j) { for (int d = 0; d < 128; ++d) s += bf2f(RQ[(t0 + i) * 512 + h * 128 + d]) * bf2f(RK[(t0 + j) * 512 + h * 128 + d]); s *= __expf((float)(i - j) * lg); }
        sc[o] = s;
    }
    __syncthreads();
    for (int o = threadIdx.x; o < 128 * 128; o += 256) {
        const int i = o >> 7, v = o & 127; float s = 0.f, c = 0.f;
        for (int j = 0; j <= i; ++j) s += sc[i * 128 + j] * bf2f(RV[(t0 + j) * 512 + h * 128 + v]);
        for (int d = 0; d < 128; ++d) c += bf2f(RQ[(t0 + i) * 512 + h * 128 + d]) * bf2f(ST[v * 128 + d]);
        yy[o] = s + c * __expf((float)(i + 1) * lg);
    }
    __syncthreads();
    if (threadIdx.x < 128) {
        const int i = threadIdx.x; float mu = 0.f;
        for (int v = 0; v < 128; ++v) mu += yy[i * 128 + ((v + i) & 127)];
        mu *= (1.f / 128.f); float var = 0.f;
        for (int v = 0; v < 128; ++v) { const float dd = yy[i * 128 + ((v + i) & 127)] - mu; var += dd * dd; }
        const float rstd = rsqrtf(var * (1.f / 128.f) + EPS);
        for (int v = 0; v < 128; ++v) { const int c = h * 128 + v; const float yn = (yy[i * 128 + v] - mu) * rstd * gn_g[c] + gn_b[c];
            AR[(t0 + i) * 512 + c] = (bf16)f2bf(bf2f(RG[(t0 + i) * 512 + c]) * yn); }
    }
}
__global__ void __launch_bounds__(256) k_swa(unsigned char* ws, const float* sinks) {
    const int gw = blockIdx.x * 4 + (threadIdx.x >> 6), lane = threadIdx.x & 63;
    const int t = gw >> 3, h = gw & 7, kvh = h >> 2, tpos = t & (SEQ - 1), tb = t - tpos;
    const bf16* SQ = (const bf16*)(ws + WS_SQ); const bf16* SK = (const bf16*)(ws + WS_SK); const bf16* SV = (const bf16*)(ws + WS_SV);
    const float q = bf2f(SQ[(size_t)t * 512 + h * 64 + lane]);
    const float slope2 = exp2f(-8.0f * (float)(h + 1) / 8.0f) * LOG2E;
    const float sink2 = sinks[h] * LOG2E;
    float m = sink2, l = 1.f, o = 0.f;
    const int lo = tpos - (WIN - 1) < 0 ? 0 : tpos - (WIN - 1);
    for (int kp = lo; kp <= tpos; ++kp) {
        const size_t tk = (size_t)(tb + kp);
        float s = wave_sum(q * bf2f(SK[tk * 128 + kvh * 64 + lane])) - slope2 * (float)(tpos - kp);
        const float mn = fmaxf(m, s), f = exp2f(m - mn), pp = exp2f(s - mn);
        l = l * f + pp; o = o * f + pp * bf2f(SV[tk * 128 + kvh * 64 + lane]); m = mn;
    }
    ((bf16*)(ws + WS_AS))[(size_t)t * 512 + h * 64 + lane] = (bf16)f2bf(o / l);
}
__global__ void __launch_bounds__(256) k_router(unsigned char* ws, const float* x1, const float* g, const float* wrg, const float* brg, const float* wre, const float* bre) {
    const int t = blockIdx.x * 4 + (threadIdx.x >> 6), lane = threadIdx.x & 63;
    float hv[16]; float ss = 0.f;
#pragma unroll
    for (int j = 0; j < 16; ++j) { hv[j] = x1[(size_t)t * D + j * 64 + lane]; ss += hv[j] * hv[j]; }
    const float rstd = rsqrtf(wave_sum(ss) * (1.f / D) + EPS);
#pragma unroll
    for (int j = 0; j < 16; ++j) hv[j] *= rstd * g[j * 64 + lane];
    float lgts[4], le[32];
#pragma unroll
    for (int o = 0; o < 4; ++o) { float s = 0.f;
#pragma unroll
        for (int j = 0; j < 16; ++j) s += hv[j] * wrg[(size_t)(j * 64 + lane) * 4 + o];
        lgts[o] = wave_sum(s) + brg[o]; }
#pragma unroll
    for (int o = 0; o < 32; ++o) { float s = 0.f;
#pragma unroll
        for (int j = 0; j < 16; ++j) s += hv[j] * wre[(size_t)(j * 64 + lane) * 32 + o];
        le[o] = wave_sum(s) + bre[o]; }
    float gm = lgts[0]; int gs = 0;
#pragma unroll
    for (int o = 1; o < 4; ++o) if (lgts[o] > gm) { gm = lgts[o]; gs = o; }
    float gden = 0.f;
#pragma unroll
    for (int o = 0; o < 4; ++o) gden += __expf(lgts[o] - gm);
    const float gw = 1.f / gden;
    float e8[8];
#pragma unroll
    for (int o = 0; o < 8; ++o) { e8[o] = gs == 0 ? le[o] : gs == 1 ? le[8 + o] : gs == 2 ? le[16 + o] : le[24 + o]; }
    float m1 = e8[0]; int i1 = 0;
#pragma unroll
    for (int o = 1; o < 8; ++o) if (e8[o] > m1) { m1 = e8[o]; i1 = o; }
    float m2 = -3.0e38f; int i2 = 0;
#pragma unroll
    for (int o = 0; o < 8; ++o) if (o != i1 && e8[o] > m2) { m2 = e8[o]; i2 = o; }
    const float p2 = __expf(m2 - m1), inv = 1.f / (1.f + p2);
    if (lane == 0) {
        ((float*)(ws + WS_RSTD1))[t] = rstd;
        ((int*)(ws + WS_SEL))[t * 2] = gs * 8 + i1; ((int*)(ws + WS_SEL))[t * 2 + 1] = gs * 8 + i2;
        ((float*)(ws + WS_CW))[t * 2] = gw * inv; ((float*)(ws + WS_CW))[t * 2 + 1] = gw * p2 * inv;
    }
}
__global__ void __launch_bounds__(256) k_moe_up(unsigned char* ws, const float* g, const float* wg, const float* wu) {
    const int tk = blockIdx.x, t = tk >> 1, f = threadIdx.x;
    const int e = ((const int*)(ws + WS_SEL))[tk]; const float cw = ((const float*)(ws + WS_CW))[tk], rstd = ((const float*)(ws + WS_RSTD1))[t];
    const bf16* xb = (const bf16*)(ws + WS_X1B) + (size_t)t * D;
    const float* Wg = wg + (size_t)e * D * FF; const float* Wu = wu + (size_t)e * D * FF;
    float a = 0.f, u = 0.f;
    for (int d = 0; d < D; ++d) { const float hv = bf2f(xb[d]) * g[d]; a += hv * Wg[(size_t)d * FF + f]; u += hv * Wu[(size_t)d * FF + f]; }
    a *= rstd; u *= rstd;
    ((bf16*)(ws + WS_HIDN))[(size_t)tk * FF + f] = (bf16)f2bf(a * sigmoidf_(a) * u * cw);
}
__global__ void __launch_bounds__(256) k_moe_down(unsigned char* ws, float* out, const float* wd) {
    const int t = blockIdx.x, c0 = threadIdx.x * 4;
    float4 acc = *(const float4*)(out + (size_t)t * D + c0);
    for (int k = 0; k < 2; ++k) {
        const int e = ((const int*)(ws + WS_SEL))[t * 2 + k]; const float* Wd = wd + (size_t)e * FF * D;
        const bf16* hid = (const bf16*)(ws + WS_HIDN) + (size_t)(t * 2 + k) * FF;
        for (int f = 0; f < FF; ++f) { const float hv = bf2f(hid[f]); const float4 w = *(const float4*)(Wd + (size_t)f * D + c0); acc.x += hv * w.x; acc.y += hv * w.y; acc.z += hv * w.z; acc.w += hv * w.w; }
    }
    *(float4*)(out + (size_t)t * D + c0) = acc;
}
__global__ void __launch_bounds__(256) k_x2_stats(unsigned char* ws, const float* x2) {
    const int row = blockIdx.x * 4 + (threadIdx.x >> 6), lane = threadIdx.x & 63;
    const float4* xr = (const float4*)(x2 + (size_t)row * D) + lane; float s = 0.f;
#pragma unroll
    for (int j = 0; j < 4; ++j) { const float4 v = xr[64 * j]; s += v.x * v.x + v.y * v.y + v.z * v.z + v.w * v.w;
        uint2 o; o.x = f2bf(v.x) | (f2bf(v.y) << 16); o.y = f2bf(v.z) | (f2bf(v.w) << 16); ((uint2*)((bf16*)(ws + WS_X2B) + (size_t)row * D))[lane + 64 * j] = o; }
    s = wave_sum(s);
    if (lane == 0) ((float*)(ws + WS_RSTD2))[row] = rsqrtf(s * (1.f / D) + EPS);
}
__global__ void __launch_bounds__(256) k_pp_stats(unsigned char* ws) {
    const int row = blockIdx.x * 4 + (threadIdx.x >> 6), lane = threadIdx.x & 63;
    const bf16* pr = (const bf16*)(ws + WS_PP) + (size_t)row * D; float s = 0.f;
#pragma unroll
    for (int j = 0; j < 16; ++j) { const float v = bf2f(pr[j * 64 + lane]); s += v * v; }
    s = wave_sum(s);
    if (lane == 0) ((float*)(ws + WS_RSTDP))[row] = rsqrtf(s * (1.f / D) + EPS);
}

extern "C" void kernel_launch(void* const* d_in, const int* in_sizes, int n_in, void* d_out, int out_size, void* d_ws, size_t ws_size, hipStream_t stream) {
    static int grid = 0;
    if (grid == 0) {
        if (n_in != 24 || in_sizes[0] != T * D || out_size != T * D || ws_size < WS_END) { fprintf(stderr, "kernel_launch: unexpected shapes (n_in %d, in0 %d, out %d, ws %zu); nothing launched\n", n_in, n_in > 0 ? in_sizes[0] : -1, out_size, ws_size); grid = -1; return; }
        int dev = 0, cus = 0, per_cu = 0;
        if (hipGetDevice(&dev) != hipSuccess || hipDeviceGetAttribute(&cus, hipDeviceAttributeMultiprocessorCount, dev) != hipSuccess) { grid = -1; return; }
        if (hipFuncSetAttribute((const void*)mk_fwd, hipFuncAttributeMaxDynamicSharedMemorySize, LDS_BYTES) != hipSuccess) { fprintf(stderr, "kernel_launch: hipFuncSetAttribute failed\n"); grid = -1; return; }
        if (hipOccupancyMaxActiveBlocksPerMultiprocessor(&per_cu, (const void*)mk_fwd, NWAVES * 64, LDS_BYTES) != hipSuccess || per_cu < 1) { fprintf(stderr, "kernel_launch: occupancy query says %d workgroups per CU\n", per_cu); }
        (void)hipGetLastError();
        grid = cus;
        (void)hipFuncSetAttribute((const void*)k_ret_out, hipFuncAttributeMaxDynamicSharedMemorySize, 131072);
    }
    if (grid < 0) return;
    const float* x = (const float*)d_in[0]; const float* p = (const float*)d_in[1];
    const float* gn_g = (const float*)d_in[4]; const float* gn_b = (const float*)d_in[5]; const float* w_ret_o = (const float*)d_in[6];
    const float* sinks = (const float*)d_in[9];
    const float* w_swa_o = (const float*)d_in[10]; const float* w_out = (const float*)d_in[11]; const float* ffn_g = (const float*)d_in[12];
    const float* wrg = (const float*)d_in[13]; const float* brg = (const float*)d_in[14]; const float* wre = (const float*)d_in[15]; const float* bre = (const float*)d_in[16];
    const float* weg = (const float*)d_in[17]; const float* weu = (const float*)d_in[18]; const float* wed = (const float*)d_in[19];
    const float* pg_g = (const float*)d_in[20]; const float* w_pg = (const float*)d_in[21]; const float* w_ple = (const float*)d_in[22]; const float* ple_g = (const float*)d_in[23];
    unsigned char* ws = (unsigned char*)d_ws; float* out = (float*)d_out;

    Args a{};
    for (int i = 0; i < 24; ++i) a.in[i] = (const float*)d_in[i];
    a.out = out; a.ws = ws;
#define MK(lo, hi) do { (void)hipMemsetAsync(ws + WS_CTL, 0, CTL_ZERO_BYTES, stream); a.ph_lo = (lo); a.ph_hi = (hi); hipLaunchKernelGGL(mk_fwd, dim3(grid), dim3(NWAVES * 64), LDS_BYTES, stream, a); } while (0)
    MK(0, 12);
}
```

```cpp
#include <hip/hip_runtime.h>
#include <cstdio>
#include <cstdint>

constexpr int BATCH = 4, SEQ = 4096, T = BATCH * SEQ, D = 1024;
constexpr int PLE = 256;
constexpr float EPS = 1e-6f;
constexpr int RH = 4, RDK = 128, RC = 128, NC = SEQ / RC;
constexpr int SH = 8, SKV = 2, SG = 4, HD = 64, WIN = 128;
constexpr int NE = 32, EPG = 8, NG = 4, FF = 256;
constexpr int INW = 4864;
constexpr float LOG2E = 1.4426950408889634f;
constexpr float QSCALE = 0.125f * LOG2E;
constexpr float KSCALE = 0.08838834764831845f;

typedef unsigned short bf16;
__device__ __forceinline__ unsigned f2bf(float f) { unsigned u = __builtin_bit_cast(unsigned, f); return (u + 0x7fffu + ((u >> 16) & 1u)) >> 16; }
__device__ __forceinline__ unsigned pk2(float lo, float hi) { return f2bf(lo) | (f2bf(hi) << 16); }
__device__ __forceinline__ float bf2f(bf16 h) { return __builtin_bit_cast(float, (unsigned)h << 16); }
__device__ __forceinline__ float wave_sum(float v) {
#pragma unroll
    for (int o = 1; o < 64; o <<= 1) v += __shfl_xor(v, o);
    return v;
}
__device__ __forceinline__ float sigmoidf_(float x) { return __builtin_amdgcn_rcpf(1.f + __expf(-x)); }

constexpr size_t MiB = 1u << 20;
constexpr size_t WS_CTL = 0, CTL_ZERO_BYTES = 1 * MiB;
constexpr size_t WS_WIN = 1 * MiB;
constexpr size_t WS_WRO = 11 * MiB;
constexpr size_t WS_WSO = 12 * MiB;
constexpr size_t WS_WOUT = 13 * MiB;
constexpr size_t WS_WPG = 15 * MiB;
constexpr size_t WS_WPLE = 17 * MiB;
constexpr size_t WS_WRT = 17 * MiB + 512 * 1024;
constexpr size_t WS_XN = 18 * MiB;
constexpr size_t WS_KV = 18 * MiB;
constexpr size_t WS_MG = 18 * MiB;
constexpr size_t WS_X2B = 18 * MiB;
constexpr size_t WS_RQ = 50 * MiB, WS_RK = 66 * MiB, WS_RV = 82 * MiB, WS_RG = 98 * MiB;
constexpr size_t WS_SQ = 114 * MiB;
constexpr size_t WS_SK = 130 * MiB, WS_SV = 134 * MiB;
constexpr size_t WS_GR = 138 * MiB, WS_GS = 170 * MiB;
constexpr size_t WS_ST = 202 * MiB;
constexpr size_t WS_AS = 218 * MiB, WS_AR = 234 * MiB;
constexpr size_t WS_MISC = 250 * MiB;
constexpr size_t WS_RSTD1 = WS_MISC, WS_RSTD2 = WS_MISC + 65536, WS_RSTDP = WS_MISC + 2 * 65536;
constexpr size_t WS_SEL = WS_MISC + 3 * 65536;
constexpr size_t WS_CW = WS_SEL + 131072;
constexpr size_t WS_SSP = 251 * MiB;
constexpr size_t WS_X1B = 50 * MiB;
constexpr size_t WS_HIDN = 130 * MiB;
constexpr size_t WS_PP = 216 * MiB;
constexpr size_t WS_PB = 152 * MiB;
constexpr size_t WS_WGU = 82 * MiB;
constexpr size_t WS_WD = 114 * MiB;
constexpr size_t WS_HID = 130 * MiB;
constexpr size_t WS_Y = 152 * MiB;
constexpr size_t WS_LIST = 252 * MiB;
constexpr size_t WS_END = 256 * MiB;
constexpr int CW_CNT = 8192;
constexpr int CW_BAR = 4096;

namespace pg8 {
#define PG8_LAS __attribute__((address_space(3)))
typedef unsigned short bf16_t;
typedef short bf16x8 __attribute__((ext_vector_type(8)));
typedef float f32x4 __attribute__((ext_vector_type(4)));
typedef unsigned u32x4 __attribute__((ext_vector_type(4)));
constexpr int BM = 256, BK = 64, HALF = 128, HTB = HALF * BK * 2  , STAGE_BYTES = 8 * HTB, NXCD = 8, WGM = 8;

__host__ __device__ __forceinline__ int lds_byte(int r, int c) { const int st = (r >> 4) * 2 + (c >> 5), rr = r & 15, cc = c & 31, ob = rr * 64 + cc * 2; return st * 1024 + (ob ^ (((ob >> 9) & 1) << 5)); }
__host__ __device__ __forceinline__ void stage_rc(int b, int& R, int& C) { const int st = b / 1024, sb = b % 1024, swz = sb ^ (((sb >> 9) & 1) << 5); R = (st >> 1) * 16 + swz / 64; C = (st & 1) * 32 + (swz % 64) / 2; }
__host__ __device__ __forceinline__ int perm32(int rho) { const int n = rho >> 4, i = rho & 15; return 8 * (i >> 2) + 4 * n + (i & 3); }
struct Unit { int pm, pn; const char* a; const char* b; int tag, aux; };

__device__ __forceinline__ void tile_of(int L, int nM, int nN, int& pm, int& pn) {
    const int nwg = nM * nN; int wgid = L; { const int q = nwg / NXCD, r = nwg % NXCD, xcd = wgid % NXCD, off = wgid / NXCD; wgid = (xcd < r ? xcd * (q + 1) : r * (q + 1) + (xcd - r) * q) + off; }
    const int nig = WGM * nN, gid = wgid / nig, fm = gid * WGM, gsz = (nM - fm) < WGM ? (nM - fm) : WGM;
    pm = fm + ((wgid % nig) % gsz); pn = (wgid % nig) / gsz;
}
struct TileOrder {
    int nM, nN, nwg, G, c; const char* A; const char* Bt; size_t tstep;
    __device__ void init(const void* A_, const void* Bt_, int M, int N, int K, int G_, int c_) { nM = M / BM; nN = N / BM; nwg = nM * nN; G = G_; c = c_; A = (const char*)A_; Bt = (const char*)Bt_; tstep = (size_t)BM * K * 2; }
    __device__ bool next(int i, Unit& u) const {
        const long L = (long)i * G + c; if (L >= nwg) return false;
        tile_of((int)L, nM, nN, u.pm, u.pn); u.a = A + (size_t)u.pm * tstep; u.b = Bt + (size_t)u.pn * tstep; u.tag = 0; u.aux = 0; return true;
    }
    static constexpr bool GATHER = false;
};
struct TwoPassOrder {
    int nM, nN, nwg, G, c; const char* A0; const char* A1; const char* B0; const char* B1; size_t tstep;
    __device__ void init(const void* A0_, const void* B0_, const void* A1_, const void* B1_, int M, int N, int K, int G_, int c_) { nM = M / BM; nN = N / BM; nwg = nM * nN; G = G_; c = c_;
        A0 = (const char*)A0_; A1 = (const char*)A1_; B0 = (const char*)B0_; B1 = (const char*)B1_; tstep = (size_t)BM * K * 2; }
    __device__ bool next(int i, Unit& u) const {
        const long L = (long)(i >> 1) * G + c; if (L >= nwg) return false;
        tile_of((int)L, nM, nN, u.pm, u.pn); u.aux = 0; u.tag = i & 1; u.a = (u.tag ? A1 : A0) + (size_t)u.pm * tstep; u.b = (u.tag ? B1 : B0) + (size_t)u.pn * tstep; return true;
    }
    static constexpr bool GATHER = false;
};

__device__ __forceinline__ unsigned cvt_pk_bf16(float lo, float hi) { unsigned r; asm volatile("v_cvt_pk_bf16_f32 %0, %1, %2" : "=v"(r) : "v"(lo), "v"(hi)); return r; }
__device__ __forceinline__ u32x4 pack8(const f32x4 v0, const f32x4 v1) { u32x4 w; w.x = cvt_pk_bf16(v0[0], v0[1]); w.y = cvt_pk_bf16(v0[2], v0[3]); w.z = cvt_pk_bf16(v1[0], v1[1]); w.w = cvt_pk_bf16(v1[2], v1[3]); return w; }
__device__ __forceinline__ float sigm(float x) { return __builtin_amdgcn_rcpf(1.f + __expf(-x)); }

struct EpiZ {
    static constexpr bool PERM = true, AFTER_DRAIN = false;
    unsigned char* ws; const float* qg; const float* kg;
    __device__ __forceinline__ void operator()(const f32x4 (&acc)[2][2][4][2], const Unit& u, int wr, int wc, int fr, int fq) const {
        const int pn = u.pn; const int row0 = u.pm * BM + wr * 64 + fr;
        if (pn < 8 || pn >= 11) {
            int kind, ld, colt; bf16_t* base;
            if (pn < 8) { kind = pn >> 1; base = (bf16_t*)(ws + WS_RQ + (size_t)kind * (16 * MiB)); ld = 512; colt = (pn & 1) * 256; }
            else { const int g = pn - 11; kind = 4; base = (bf16_t*)(ws + WS_GR + (size_t)(g >> 2) * (32 * MiB)); ld = 1024; colt = (g & 3) * 256; }
            const int col0 = colt + wc * 32 + 8 * fq;
#pragma unroll
            for (int ai = 0; ai < 2; ++ai)
#pragma unroll
                for (int m = 0; m < 4; ++m) { bf16_t* rowp = base + (size_t)(row0 + ai * HALF + m * 16) * ld + col0;
#pragma unroll
                    for (int bj = 0; bj < 2; ++bj) { f32x4 v0 = acc[ai][bj][m][0], v1 = acc[ai][bj][m][1];
                        if (kind == 1) { v0 = v0 * KSCALE; v1 = v1 * KSCALE; }
                        else if (kind == 3) {
#pragma unroll
                            for (int j = 0; j < 4; ++j) { v0[j] = v0[j] * sigm(v0[j]); v1[j] = v1[j] * sigm(v1[j]); } }
                        else if (kind == 4) {
#pragma unroll
                            for (int j = 0; j < 4; ++j) { v0[j] = sigm(v0[j]); v1[j] = sigm(v1[j]); } }
                        *(u32x4*)(rowp + bj * HALF) = pack8(v0, v1); } }
        } else {
            const bool isq = pn < 10, isk = (pn == 10) && (wc < 2);
            f32x4 gv[2][2];
#pragma unroll
            for (int bj = 0; bj < 2; ++bj)
#pragma unroll
                for (int n = 0; n < 2; ++n) { const int dd = 32 * bj + 8 * fq + 4 * n;
                    gv[bj][n] = isq ? *(const f32x4*)(qg + dd) * QSCALE : isk ? *(const f32x4*)(kg + dd) : (f32x4){1.f, 1.f, 1.f, 1.f}; }
            bf16_t* base; int ld;
            if (isq) { base = (bf16_t*)(ws + WS_SQ) + (pn - 8) * 256 + 64 * wc + 8 * fq; ld = 512; }
            else if (isk) { base = (bf16_t*)(ws + WS_SK) + 64 * wc + 8 * fq; ld = 128; }
            else { base = (bf16_t*)(ws + WS_SV) + 64 * (wc - 2) + 8 * fq; ld = 128; }
#pragma unroll
            for (int ai = 0; ai < 2; ++ai)
#pragma unroll
                for (int m = 0; m < 4; ++m) {
                    float ss = 0.f;
#pragma unroll
                    for (int bj = 0; bj < 2; ++bj)
#pragma unroll
                        for (int n = 0; n < 2; ++n) { const f32x4 x = acc[ai][bj][m][n]; ss += (x[0] * x[0] + x[1] * x[1]) + (x[2] * x[2] + x[3] * x[3]); }
                    ss += __shfl_xor(ss, 16); ss += __shfl_xor(ss, 32);
                    const float rstd = (isq || isk) ? rsqrtf(ss * (1.f / 64.f) + EPS) : 1.f;
                    bf16_t* rowp = base + (size_t)(row0 + ai * HALF + m * 16) * ld;
#pragma unroll
                    for (int bj = 0; bj < 2; ++bj) *(u32x4*)(rowp + 32 * bj) = pack8(acc[ai][bj][m][0] * rstd * gv[bj][0], acc[ai][bj][m][1] * rstd * gv[bj][1]); }
        }
    }
};


__device__ __forceinline__ void unpack8(const u32x4 w, f32x4& v0, f32x4& v1) {
    v0[0] = __builtin_bit_cast(float, w.x << 16); v0[1] = __builtin_bit_cast(float, w.x & 0xffff0000u); v0[2] = __builtin_bit_cast(float, w.y << 16); v0[3] = __builtin_bit_cast(float, w.y & 0xffff0000u);
    v1[0] = __builtin_bit_cast(float, w.z << 16); v1[1] = __builtin_bit_cast(float, w.z & 0xffff0000u); v1[2] = __builtin_bit_cast(float, w.w << 16); v1[3] = __builtin_bit_cast(float, w.w & 0xffff0000u);
}
typedef unsigned u32x2 __attribute__((ext_vector_type(2)));
__device__ __forceinline__ f32x4 unpack4(const u32x2 w) { f32x4 v; v[0] = __builtin_bit_cast(float, w.x << 16); v[1] = __builtin_bit_cast(float, w.x & 0xffff0000u); v[2] = __builtin_bit_cast(float, w.y << 16); v[3] = __builtin_bit_cast(float, w.y & 0xffff0000u); return v; }

struct EpiMerge {
    static constexpr bool PERM = true, AFTER_DRAIN = false;
    const bf16_t* GR; const bf16_t* GS; bf16_t* MG;
    __device__ __forceinline__ void operator()(const f32x4 (&acc)[2][2][4][2], const Unit& u, int wr, int wc, int fr, int fq) const {
        const int row0 = u.pm * BM + wr * 64 + fr, col0 = u.pn * BM + wc * 32 + 8 * fq; const bf16_t* G = u.tag ? GS : GR;
#pragma unroll
        for (int ai = 0; ai < 2; ++ai)
#pragma unroll
            for (int m = 0; m < 4; ++m) { const size_t off = (size_t)(row0 + ai * HALF + m * 16) * D + col0;
#pragma unroll
                for (int bj = 0; bj < 2; ++bj) { f32x4 g0, g1; unpack8(*(const u32x4*)(G + off + bj * HALF), g0, g1);
                    f32x4 v0 = acc[ai][bj][m][0] * g0, v1 = acc[ai][bj][m][1] * g1;
                    if (u.tag) { f32x4 p0, p1; unpack8(*(const u32x4*)(MG + off + bj * HALF), p0, p1); v0 = v0 + p0; v1 = v1 + p1; }
                    *(u32x4*)(MG + off + bj * HALF) = pack8(v0, v1); } }
    }
};
struct EpiX1 {
    static constexpr bool PERM = true, AFTER_DRAIN = false;
    const float* x; bf16_t* xb;
    __device__ __forceinline__ void operator()(const f32x4 (&acc)[2][2][4][2], const Unit& u, int wr, int wc, int fr, int fq) const {
        const int row0 = u.pm * BM + wr * 64 + fr, col0 = u.pn * BM + wc * 32 + 8 * fq;
#pragma unroll
        for (int ai = 0; ai < 2; ++ai)
#pragma unroll
            for (int m = 0; m < 4; ++m) { const size_t off = (size_t)(row0 + ai * HALF + m * 16) * D + col0;
#pragma unroll
                for (int bj = 0; bj < 2; ++bj) { const size_t o = off + bj * HALF;
                    *(u32x4*)(xb + o) = pack8(*(const f32x4*)(x + o) + acc[ai][bj][m][0], *(const f32x4*)(x + o + 4) + acc[ai][bj][m][1]); } }
    }
};
struct EpiPP {
    static constexpr bool PERM = true, AFTER_DRAIN = false;
    bf16_t* PP; float* SSP;
    __device__ __forceinline__ void operator()(const f32x4 (&acc)[2][2][4][2], const Unit& u, int wr, int wc, int fr, int fq) const {
        const int row0 = u.pm * BM + wr * 64 + fr, col0 = u.pn * BM + wc * 32 + 8 * fq;
#pragma unroll
        for (int ai = 0; ai < 2; ++ai)
#pragma unroll
            for (int m = 0; m < 4; ++m) { const int row = row0 + ai * HALF + m * 16; float ss = 0.f;
#pragma unroll
                for (int bj = 0; bj < 2; ++bj) { const f32x4 a = acc[ai][bj][m][0], b = acc[ai][bj][m][1];
                    ss += (a[0] * a[0] + a[1] * a[1]) + (a[2] * a[2] + a[3] * a[3]) + (b[0] * b[0] + b[1] * b[1]) + (b[2] * b[2] + b[3] * b[3]);
                    *(u32x4*)(PP + (size_t)row * D + col0 + bj * HALF) = pack8(a, b); }
                ss += __shfl_xor(ss, 16); ss += __shfl_xor(ss, 32);
                if (fq == 0) SSP[(size_t)row * 16 + u.pn * 4 + wc] = ss; }
    }
};
struct EpiFinal {
    static constexpr bool PERM = false, AFTER_DRAIN = false;
    float* out; const bf16_t* X2B; const bf16_t* PP; const float* rstd2; const float* rstdp; const float* pleg;
    __device__ __forceinline__ void operator()(const f32x4 (&acc)[2][2][4][2], const Unit& u, int wr, int wc, int fr, int fq) const {
        const int row0 = u.pm * BM + wr * 64 + fr, col0 = u.pn * BM + wc * 32 + 4 * fq;
        f32x4 gv[2][2];
#pragma unroll
        for (int bj = 0; bj < 2; ++bj)
#pragma unroll
            for (int n = 0; n < 2; ++n) gv[bj][n] = *(const f32x4*)(pleg + col0 + bj * HALF + n * 16);
#pragma unroll
        for (int ai = 0; ai < 2; ++ai)
#pragma unroll
            for (int m = 0; m < 4; ++m) { const int row = row0 + ai * HALF + m * 16; const size_t off = (size_t)row * D + col0; const float r2 = rstd2[row], rp = rstdp[row];
#pragma unroll
                for (int bj = 0; bj < 2; ++bj)
#pragma unroll
                    for (int n = 0; n < 2; ++n) { const size_t o = off + bj * HALF + n * 16; const f32x4 x2 = unpack4(*(const u32x2*)(X2B + o)); const f32x4 pp = unpack4(*(const u32x2*)(PP + o)); const f32x4 a = acc[ai][bj][m][n];
                        f32x4 r;
#pragma unroll
                        for (int j = 0; j < 4; ++j) r[j] = x2[j] + sigm(r2 * a[j]) * (pp[j] * rp * gv[bj][n][j]);
                        *(f32x4*)(out + o) = r; } }
    }
};


struct MoeTables { const PG8_LAS int* cnt; const PG8_LAS int* pre; };
struct MoeUpOrder {
    MoeTables tb; int G, c; const char* X1B; const char* WGU; const int* LIST;
    __device__ bool next(int i, Unit& u) const {
        const int L = i * G + c; if (L >= tb.pre[32] * 2) return false;
        const int rtg = L >> 1; int e = 0; while (tb.pre[e + 1] <= rtg) ++e;
        u.pm = rtg - tb.pre[e]; u.pn = L & 1; u.tag = e; u.aux = rtg * 256; u.a = X1B; u.b = WGU + (size_t)e * (512 * 1024 * 2) + (size_t)u.pn * (256 * 1024 * 2); return true;
    }
    static constexpr bool GATHER = true;
    __device__ __forceinline__ void a_off(const Unit& u, int tid, int K, PG8_LAS unsigned short* tab) const {
        const int cnt = tb.cnt[u.tag]; const int* lst = LIST + u.tag * 16384;
#pragma unroll
        for (int i = 0; i < 2; ++i) { int R, C; stage_rc(tid * 16 + i * 8192, R, C); const int s0 = u.pm * 256 + R, s1 = s0 + HALF;
            const int t0 = s0 < cnt ? lst[s0] >> 1 : 0, t1 = s1 < cnt ? lst[s1] >> 1 : 0;
            tab[(0 * 2 + i) * 512] = (unsigned short)t0; tab[(1 * 2 + i) * 512] = (unsigned short)t1; }
    }
};
struct MoeDownOrder {
    MoeTables tb; int G, c; const char* HID; const char* WD;
    __device__ bool next(int i, Unit& u) const {
        const int L = i * G + c; if (L >= tb.pre[32] * 4) return false;
        const int rtg = L >> 2; int e = 0; while (tb.pre[e + 1] <= rtg) ++e;
        u.pm = rtg; u.pn = L & 3; u.tag = e; u.aux = rtg - tb.pre[e]; u.a = HID + (size_t)rtg * (256 * 256 * 2); u.b = WD + (size_t)e * (1024 * 256 * 2) + (size_t)u.pn * (256 * 256 * 2); return true;
    }
    static constexpr bool GATHER = false;
};
struct EpiUp {
    static constexpr bool PERM = true, AFTER_DRAIN = false;
    MoeTables tb; const int* LIST; const float* RSTD1; const float* CW; bf16_t* HID;
    __device__ __forceinline__ void operator()(const f32x4 (&acc)[2][2][4][2], const Unit& u, int wr, int wc, int fr, int fq) const {
        const int cnt = tb.cnt[u.tag]; const int* lst = LIST + u.tag * 16384 + u.pm * 256;
#pragma unroll
        for (int ai = 0; ai < 2; ++ai)
#pragma unroll
            for (int m = 0; m < 4; ++m) { const int r = ai * HALF + wr * 64 + m * 16 + fr; const bool valid = u.pm * 256 + r < cnt;
                const int tk = valid ? lst[r] : 0; const float rs = RSTD1[tk >> 1], cw = valid ? CW[tk] : 0.f;
                f32x4 h0, h1;
#pragma unroll
                for (int j = 0; j < 4; ++j) { const float g0 = acc[ai][0][m][0][j] * rs, g1 = acc[ai][0][m][1][j] * rs;
                    h0[j] = g0 * sigm(g0) * (acc[ai][1][m][0][j] * rs) * cw; h1[j] = g1 * sigm(g1) * (acc[ai][1][m][1][j] * rs) * cw; }
                *(u32x4*)(HID + (size_t)(u.aux + r) * 256 + 128 * u.pn + 32 * wc + 8 * fq) = pack8(h0, h1); }
    }
};
struct EpiDown {
    static constexpr bool PERM = true, AFTER_DRAIN = false;
    MoeTables tb; const int* LIST; bf16_t* Y;
    __device__ __forceinline__ void operator()(const f32x4 (&acc)[2][2][4][2], const Unit& u, int wr, int wc, int fr, int fq) const {
        const int cnt = tb.cnt[u.tag]; const int* lst = LIST + u.tag * 16384 + u.aux * 256; const int col0 = u.pn * BM + wc * 32 + 8 * fq;
#pragma unroll
        for (int ai = 0; ai < 2; ++ai)
#pragma unroll
            for (int m = 0; m < 4; ++m) { const int r = ai * HALF + wr * 64 + m * 16 + fr; const bool valid = u.aux * 256 + r < cnt;
                if (valid) { bf16_t* rowp = Y + (size_t)lst[r] * D + col0;
#pragma unroll
                    for (int bj = 0; bj < 2; ++bj) *(u32x4*)(rowp + bj * HALF) = pack8(acc[ai][bj][m][0], acc[ai][bj][m][1]); } }
    }
};

template <class Epi, class Sched>
__device__ __forceinline__ void gemm_phase(PG8_LAS unsigned char* lds, const int K, const Sched& S, const Epi& E, PG8_LAS unsigned short* gtab = nullptr) {
    constexpr bool GATHER = Sched::GATHER;
    const int tid = threadIdx.x, wid = __builtin_amdgcn_readfirstlane(tid >> 6), lane = tid & 63, wr = wid >> 2, wc = wid & 3, fr = lane & 15, fq = lane >> 4;
    const int nt = K / BK;
    unsigned voffA[2], voffB[2], cA2[2];
#pragma unroll
    for (int i = 0; i < 2; ++i) { int R, C; stage_rc(tid * 16 + i * 8192, R, C); const int Rb = Epi::PERM ? ((R & ~31) + perm32(R & 31)) : R;
        voffA[i] = (unsigned)(R * K + C) * 2u; cA2[i] = (unsigned)C * 2u; voffB[i] = (unsigned)(Rb * K + C) * 2u; }
    const size_t kstep = (size_t)(BK * 2);
    const size_t hstep = (size_t)HALF * K * 2;
    const unsigned ldsw = (unsigned)wid * 1024u;
    const int aoff = lds_byte(wr * 64 + fr, fq * 8), boff = lds_byte(wc * 32 + fr, fq * 8);
#define PG8_SA(b, h) (((b) * 2 + (h)) * HTB)
#define PG8_SB(b, h) ((4 + (b) * 2 + (h)) * HTB)
#define PG8_STAGE(bufoff, gbase, voff) do { _Pragma("unroll") for (int _i = 0; _i < 2; ++_i) \
        __builtin_amdgcn_global_load_lds((const unsigned*)((const char*)(gbase) + (voff)[_i]), (PG8_LAS unsigned*)(lds + (bufoff) + ldsw + _i * 8192), 16, 0, 0); } while (0)
#define PG8_STAGE_A(bufoff, gbase, un, h) do { if constexpr (GATHER) { unsigned _o[2]; _o[0] = (unsigned)gtab[((((ui + (un)) & 1) * 2 + (h)) * 2 + 0) * 512 + tid] * (unsigned)(K * 2) + cA2[0]; _o[1] = (unsigned)gtab[((((ui + (un)) & 1) * 2 + (h)) * 2 + 1) * 512 + tid] * (unsigned)(K * 2) + cA2[1]; PG8_STAGE(bufoff, gbase, _o); } \
        else { PG8_STAGE(bufoff, (gbase) + (h) * hstep, voffA); } } while (0)
#define PG8_LDA(dst, b, h) do { _Pragma("unroll") for (int m = 0; m < 4; ++m) _Pragma("unroll") for (int k = 0; k < 2; ++k) dst[m][k] = *(const PG8_LAS bf16x8*)(lds + PG8_SA(b, h) + aoff + m * 2048 + k * 1024); } while (0)
#define PG8_LDB(dst, b, h) do { _Pragma("unroll") for (int n = 0; n < 2; ++n) _Pragma("unroll") for (int k = 0; k < 2; ++k) dst[n][k] = *(const PG8_LAS bf16x8*)(lds + PG8_SB(b, h) + boff + n * 2048 + k * 1024); } while (0)
#define PG8_MMA(ai, bj, At, Bt) do { __builtin_amdgcn_s_setprio(1); _Pragma("unroll") for (int m = 0; m < 4; ++m) _Pragma("unroll") for (int n = 0; n < 2; ++n) _Pragma("unroll") for (int k = 0; k < 2; ++k) \
        acc[ai][bj][m][n] = __builtin_amdgcn_mfma_f32_16x16x32_bf16(Bt[n][k], At[m][k], acc[ai][bj][m][n], 0, 0, 0); __builtin_amdgcn_s_setprio(0); } while (0)
#define PG8_WAIT_V(n) asm volatile("s_waitcnt vmcnt(" #n ")" ::: "memory")
#define PG8_WAIT_L(n) asm volatile("s_waitcnt lgkmcnt(" #n ")" ::: "memory")
#define PG8_BAR __builtin_amdgcn_s_barrier()
#define PG8_SCHED __builtin_amdgcn_sched_barrier(0)
    Unit cur, nxt; int ui = 0;
    if (!S.next(0, cur)) return;
    f32x4 acc[2][2][4][2];
#pragma unroll
    for (int a = 0; a < 2; ++a)
#pragma unroll
        for (int b = 0; b < 2; ++b)
#pragma unroll
            for (int m = 0; m < 4; ++m)
#pragma unroll
                for (int n = 0; n < 2; ++n) acc[a][b][m][n] = (f32x4){0.f, 0.f, 0.f, 0.f};
    bf16x8 At[4][2], B0[2][2], B1[2][2];
    const char* cA = cur.a; const char* cB = cur.b;
    if constexpr (GATHER) S.a_off(cur, tid, K, gtab + 0 * 2048 + tid);
    PG8_STAGE(PG8_SB(0, 0), cB, voffB); PG8_STAGE(PG8_SB(0, 1), cB + hstep, voffB); PG8_STAGE_A(PG8_SA(0, 0), cA, 0, 0); PG8_STAGE_A(PG8_SA(0, 1), cA, 0, 1);
    if (wr == 1) PG8_BAR;
    PG8_WAIT_V(2); PG8_BAR;
    PG8_STAGE(PG8_SB(1, 0), cB + kstep, voffB); PG8_STAGE_A(PG8_SA(1, 0), cA + kstep, 0, 0); PG8_STAGE(PG8_SB(1, 1), cB + hstep + kstep, voffB);
    PG8_WAIT_V(6); PG8_BAR;
    for (;;) {
        const bool has_next = S.next(ui + 1, nxt);
        if constexpr (GATHER) S.a_off(has_next ? nxt : cur, tid, K, gtab + ((ui + 1) & 1) * 2048 + tid);
        const char* nA = has_next ? nxt.a : cA; const char* nB = has_next ? nxt.b : cB;
        for (int t = 0; t < nt; t += 2) {
            const bool last = (t == nt - 2);
            const char* a1 = cA + (size_t)(t + 1) * kstep;
            const char* a2 = last ? nA : cA + (size_t)(t + 2) * kstep; const char* b2 = last ? nB : cB + (size_t)(t + 2) * kstep;
            const char* a3 = a2 + kstep; const char* b3 = b2 + kstep;
            const int un = last ? 1 : 0;
            PG8_LDB(B0, 0, 0); PG8_LDB(B1, 0, 1); PG8_SCHED; PG8_LDA(At, 0, 0); PG8_STAGE_A(PG8_SA(1, 1), a1, 0, 1);
            PG8_WAIT_V(8); PG8_WAIT_L(0); PG8_BAR; PG8_MMA(0, 0, At, B0); PG8_MMA(0, 1, At, B1); PG8_BAR; PG8_SCHED;
            PG8_LDA(At, 0, 1); PG8_STAGE(PG8_SB(0, 0), b2, voffB); PG8_STAGE(PG8_SB(0, 1), b2 + hstep, voffB); PG8_STAGE_A(PG8_SA(0, 0), a2, un, 0);
            PG8_WAIT_V(8); PG8_WAIT_L(0); PG8_BAR; PG8_MMA(1, 0, At, B0); PG8_MMA(1, 1, At, B1); PG8_BAR; PG8_SCHED;
            PG8_LDB(B0, 1, 0); PG8_LDB(B1, 1, 1); PG8_SCHED; PG8_LDA(At, 1, 0); PG8_STAGE_A(PG8_SA(0, 1), a2, un, 1);
            PG8_WAIT_V(8); PG8_WAIT_L(0); PG8_BAR; PG8_MMA(0, 0, At, B0); PG8_MMA(0, 1, At, B1); PG8_BAR; PG8_SCHED;
            PG8_LDA(At, 1, 1); PG8_STAGE(PG8_SB(1, 0), b3, voffB); PG8_STAGE(PG8_SB(1, 1), b3 + hstep, voffB); PG8_STAGE_A(PG8_SA(1, 0), a3, un, 0);
            PG8_WAIT_V(8); PG8_WAIT_L(0); PG8_BAR; PG8_MMA(1, 0, At, B0); PG8_MMA(1, 1, At, B1); PG8_BAR; PG8_SCHED;
        }
        if (wr == 0) PG8_BAR;
        E(acc, cur, wr, wc, fr, fq);
        if (!has_next) break;
#pragma unroll
        for (int a = 0; a < 2; ++a)
#pragma unroll
            for (int b = 0; b < 2; ++b)
#pragma unroll
                for (int m = 0; m < 4; ++m)
#pragma unroll
                    for (int n = 0; n < 2; ++n) acc[a][b][m][n] = (f32x4){0.f, 0.f, 0.f, 0.f};
        cur = nxt; cA = nA; cB = nB; ++ui;
        if (wr == 1) PG8_BAR;
    }
    PG8_WAIT_V(0);
    PG8_BAR;
#undef PG8_SA
#undef PG8_SB
#undef PG8_STAGE
#undef PG8_STAGE_A
#undef PG8_LDA
#undef PG8_LDB
#undef PG8_MMA
#undef PG8_WAIT_V
#undef PG8_WAIT_L
#undef PG8_BAR
#undef PG8_SCHED
}
}
#define GAS __attribute__((address_space(1)))
#define LAS __attribute__((address_space(3)))
typedef unsigned v4u __attribute__((ext_vector_type(4)));
typedef float f32x4 __attribute__((ext_vector_type(4)));
typedef short bf16x8 __attribute__((ext_vector_type(8)));
typedef GAS unsigned gu32;
typedef GAS unsigned long long gu64;
#define RLX_AGENT __ATOMIC_RELAXED, __HIP_MEMORY_SCOPE_AGENT
#define LDS_WAIT() asm volatile("s_waitcnt lgkmcnt(0)" ::: "memory")
#define VM_WAIT() asm volatile("s_waitcnt vmcnt(0)" ::: "memory")
__device__ __forceinline__ unsigned long long rt() { return __builtin_amdgcn_s_memrealtime(); }


#define XB_TMO      128
#define XB_XCNT(j)  (256  + 64 * (j))
#define XB_XSUB(j)  (1280 + 64 * (j))
#define XB_XGEN(j)  (2304 + 64 * (j))
#define XB_TOP      3328
#define XB_TOPGEN   3392
#define XCD_BAR_WORDS 3456
#define XB_SPIN_CAP (1u << 18)

__device__ __forceinline__ unsigned xb_ld(unsigned* p)              { return __hip_atomic_load(p, __ATOMIC_RELAXED, __HIP_MEMORY_SCOPE_AGENT); }
__device__ __forceinline__ unsigned xb_add(unsigned* p, unsigned v) { return __hip_atomic_fetch_add(p, v, __ATOMIC_RELAXED, __HIP_MEMORY_SCOPE_AGENT); }
__device__ __forceinline__ unsigned xb_xcc_id() { return (unsigned)__builtin_amdgcn_s_getreg((3 << 11) | 20) & 0xFu; }
#define XB_SPIN(cond, bar) do { unsigned _sp = 0; while (cond) { __builtin_amdgcn_s_sleep(1); \
    if ((++_sp & 255u) == 0u) { if (xb_ld(&(bar)[XB_TMO])) break; if (_sp > XB_SPIN_CAP) { atomicAdd(&(bar)[XB_TMO], 1u); break; } } } } while (0)

struct XcdBarrier {
    unsigned* bar; unsigned x;
    volatile LAS unsigned* st;
};

__device__ __forceinline__ XcdBarrier xcd_barrier_post(unsigned* bar, volatile LAS unsigned* st) {
    XcdBarrier b; b.bar = bar; b.x = xb_xcc_id(); b.st = st;
    if (threadIdx.x == 0) (void)xb_add(&bar[XB_XCNT(b.x)], 1u);
    return b;
}
__device__ __forceinline__ void xcd_barrier_complete(unsigned* bar, unsigned x, unsigned& nloc, unsigned& nx) {
    const unsigned G = gridDim.x * gridDim.y * gridDim.z;
    unsigned sum, cnt, mine, sp = 0u;
    for (;;) {
        sum = 0u; cnt = 0u; mine = 0u;
#pragma unroll
        for (unsigned j = 0; j < 16; ++j) { const unsigned c = xb_ld(&bar[XB_XCNT(j)]); sum += c; cnt += (c > 0u) ? 1u : 0u; mine = (j == x) ? c : mine; }
        if (sum == G) break;
        __builtin_amdgcn_s_sleep(1);
        if ((++sp & 255u) == 0u) { if (xb_ld(&bar[XB_TMO])) break; if (sp > XB_SPIN_CAP) { atomicAdd(&bar[XB_TMO], 1u); break; } }
    }
    nloc = mine > 0u ? mine : 1u; nx = cnt > 0u ? cnt : 1u;
}

__device__ __forceinline__ void xcd_barrier(const XcdBarrier& b) {
    asm volatile("s_waitcnt vmcnt(0)" ::: "memory");
    __syncthreads();
    if (threadIdx.x == 0) {
        unsigned* bar = b.bar;
        __builtin_amdgcn_s_waitcnt(0);
        unsigned nloc = b.st[0], nx = b.st[1];
        if (nloc == 0u) { xcd_barrier_complete(bar, b.x, nloc, nx); b.st[0] = nloc; b.st[1] = nx; }
        const unsigned old = xb_add(&bar[XB_XSUB(b.x)], 1u);
        const unsigned gen = old / nloc;
        if (old + 1u == (gen + 1u) * nloc) {
            __builtin_amdgcn_fence(__ATOMIC_RELEASE, "agent");
            asm volatile("s_waitcnt vmcnt(0)" ::: "memory");
            const unsigned og = xb_add(&bar[XB_TOP], 1u);
            const unsigned tg = og / nx;
            if (og + 1u == (tg + 1u) * nx) xb_add(&bar[XB_TOPGEN], 1u);
            else XB_SPIN(xb_ld(&bar[XB_TOPGEN]) == tg, bar);
            __builtin_amdgcn_fence(__ATOMIC_ACQUIRE, "agent");
            xb_add(&bar[XB_XGEN(b.x)], 1u);
            asm volatile("s_waitcnt vmcnt(0)" ::: "memory");
        } else {
            XB_SPIN(xb_ld(&bar[XB_XGEN(b.x)]) == gen, bar);
            __builtin_amdgcn_fence(__ATOMIC_ACQUIRE, "agent");
            asm volatile("s_waitcnt vmcnt(0)" ::: "memory");
        }
    }
    __syncthreads();
}
namespace mx {
typedef short bf16x8 __attribute__((ext_vector_type(8)));
typedef short s16x4 __attribute__((ext_vector_type(4)));
typedef float f32x16 __attribute__((ext_vector_type(16)));
typedef LAS const char* lcp;
__device__ __forceinline__ int crow(int r, int hi) { return (r & 3) + 8 * (r >> 2) + 4 * hi; }
__device__ __forceinline__ s16x4 trr(lcp p) { return __builtin_bit_cast(s16x4, __builtin_amdgcn_ds_read_tr16_b64_v4i16((LAS s16x4*)p)); }
__device__ __forceinline__ bf16x8 trfrag(lcp tb, int stride, int rA, int rB, int c0) {
    const s16x4 a = trr(tb + rA * stride + c0 * 2), b = trr(tb + rB * stride + c0 * 2);
    return (bf16x8){a[0], a[1], a[2], a[3], b[0], b[1], b[2], b[3]};
}
__device__ __forceinline__ lcp tr_base(lcp tile, int stride, int lane) { const int i16 = lane & 15, g16 = (lane >> 4) & 1; return tile + (i16 >> 2) * stride + (16 * g16 + 4 * (i16 & 3)) * 2; }
__device__ __forceinline__ unsigned cvtpk(float lo, float hi) { unsigned r; asm volatile("v_cvt_pk_bf16_f32 %0, %1, %2" : "=v"(r) : "v"(lo), "v"(hi)); return r; }
__device__ __forceinline__ bf16x8 accfrag(const f32x16& x, int s) {
    v4u w; w.x = cvtpk(x[8 * s + 0], x[8 * s + 1]); w.y = cvtpk(x[8 * s + 2], x[8 * s + 3]); w.z = cvtpk(x[8 * s + 4], x[8 * s + 5]); w.w = cvtpk(x[8 * s + 6], x[8 * s + 7]);
    return __builtin_bit_cast(bf16x8, w);
}
__device__ __forceinline__ float ret_lg2(int h) { return log1pf(-exp2f(-5.0f - (float)h)) * LOG2E; }
#define MFMA32(a, b, c) __builtin_amdgcn_mfma_f32_32x32x16_bf16((a), (b), (c), 0, 0, 0)

constexpr int TS = 320;
constexpr int KS = 272;

struct KvRegs { v4u kq[4], vq[4]; };
__device__ __forceinline__ void ret_kv_load(unsigned char* ws, int bhn, int tid, KvRegs& R) {
    const int n = bhn % NC, h = (bhn / NC) % RH, b = bhn / (NC * RH);
    const size_t t0 = (size_t)b * SEQ + (size_t)n * RC;
    const bf16* RK = (const bf16*)(ws + WS_RK) + t0 * 512 + h * 128; const bf16* RV = (const bf16*)(ws + WS_RV) + t0 * 512 + h * 128;
#pragma unroll
    for (int i = 0; i < 4; ++i) { const int c = tid + 512 * i, row = c >> 4, ch = c & 15; R.kq[i] = *(const GAS v4u*)(RK + (size_t)row * 512 + ch * 8); R.vq[i] = *(const GAS v4u*)(RV + (size_t)row * 512 + ch * 8); }
}
__device__ __forceinline__ void ret_kv_commit(LAS unsigned char* lds, int bhn, int tid, const KvRegs& R) {
    const int h = (bhn / NC) % RH; const float lg2 = ret_lg2(h);
    LAS unsigned char* Kt = lds; LAS unsigned char* Vt = lds + 128 * TS;
#pragma unroll
    for (int i = 0; i < 4; ++i) { const int c = tid + 512 * i, row = c >> 4, ch = c & 15;
        const float z = __builtin_amdgcn_exp2f((127.f - (float)row) * lg2); const v4u kq = R.kq[i];
        v4u ko; ko.x = pk2(bf2f(kq.x & 0xffff) * z, bf2f(kq.x >> 16) * z); ko.y = pk2(bf2f(kq.y & 0xffff) * z, bf2f(kq.y >> 16) * z); ko.z = pk2(bf2f(kq.z & 0xffff) * z, bf2f(kq.z >> 16) * z); ko.w = pk2(bf2f(kq.w & 0xffff) * z, bf2f(kq.w >> 16) * z);
        *(LAS v4u*)(Kt + row * TS + ch * 16) = ko; *(LAS v4u*)(Vt + row * TS + ch * 16) = R.vq[i]; }
}
__device__ __forceinline__ void ret_kv_compute(unsigned char* ws, LAS unsigned char* lds, int bhn, int wave, int lane) {
    LAS unsigned char* Kt = lds; LAS unsigned char* Vt = lds + 128 * TS;
    const int hi = lane >> 5, dt = wave >> 1, vh = wave & 1;
    const lcp kb = tr_base((lcp)Kt, TS, lane), vb = tr_base((lcp)Vt, TS, lane);
    f32x16 a0 = {}, a1 = {};
#pragma unroll
    for (int ks = 0; ks < 8; ++ks) { const int rA = 16 * ks + 4 * hi, rB = rA + 8;
        const bf16x8 A = trfrag(kb, TS, rA, rB, 32 * dt), B0 = trfrag(vb, TS, rA, rB, 64 * vh), B1 = trfrag(vb, TS, rA, rB, 64 * vh + 32);
        a0 = MFMA32(A, B0, a0); a1 = MFMA32(A, B1, a1); }
    float* KV = (float*)(ws + WS_KV) + (size_t)bhn * 16384;
#pragma unroll
    for (int r = 0; r < 16; ++r) { const int d = 32 * dt + crow(r, hi); KV[d * 128 + 64 * vh + (lane & 31)] = a0[r]; KV[d * 128 + 64 * vh + 32 + (lane & 31)] = a1[r]; }
}
__device__ __forceinline__ void ret_kv_phase(unsigned char* ws, LAS unsigned char* lds, int bx, int G, int tid, int wave, int lane) {
    constexpr int NU = BATCH * RH * NC; if (bx >= NU) return;
    KvRegs R; ret_kv_load(ws, bx, tid, R);
    for (int u = bx; u < NU; u += G) {
        ret_kv_commit(lds, u, tid, R);
        __syncthreads();
        if (u + G < NU) ret_kv_load(ws, u + G, tid, R);
        ret_kv_compute(ws, lds, u, wave, lane);
        __syncthreads();
    }
}
__device__ __forceinline__ void ret_scan(unsigned char* ws, int gtid, int nthreads) {
    const float* KV = (const float*)(ws + WS_KV); bf16* ST = (bf16*)(ws + WS_ST);
    for (int c = gtid; c < BATCH * RH * 16384; c += nthreads) { const int bh = c >> 14, o = c & 16383, h = bh % RH;
        const float decay = __builtin_amdgcn_exp2f(128.f * ret_lg2(h));
        float kv[NC];
#pragma unroll
        for (int n = 0; n < NC; ++n) kv[n] = KV[((size_t)bh * NC + n) * 16384 + o];
        float st = 0.f;
#pragma unroll
        for (int n = 0; n < NC; ++n) { ST[((size_t)bh * NC + n) * 16384 + o] = (bf16)f2bf(st); st = decay * st + kv[n]; } }
}
constexpr int SKS = 144, SVS = 192;
__device__ __forceinline__ void swa_unit(unsigned char* ws, LAS unsigned char* lds, const float* sinks, int unit, int tid, int wave, int lane) {
    const int kvh = unit & 1, nb = (unit >> 1) & 31, b = unit >> 6;
    const size_t tb0 = (size_t)b * SEQ + (size_t)nb * WIN;
    LAS unsigned char* Kt = lds; LAS unsigned char* Vt = lds + 256 * SKS;
    { const bf16* SK = (const bf16*)(ws + WS_SK) + kvh * 64; const bf16* SV = (const bf16*)(ws + WS_SV) + kvh * 64;
      v4u kq[4], vq[4];
#pragma unroll
      for (int i = 0; i < 4; ++i) { const int c = tid + 512 * i, row = c >> 3, ch = c & 7; kq[i] = (v4u){0u, 0u, 0u, 0u}; vq[i] = (v4u){0u, 0u, 0u, 0u};
          if (nb > 0 || row >= WIN) { const size_t tk = tb0 - WIN + row; kq[i] = *(const GAS v4u*)(SK + tk * 128 + ch * 8); vq[i] = *(const GAS v4u*)(SV + tk * 128 + ch * 8); } }
#pragma unroll
      for (int i = 0; i < 4; ++i) { const int c = tid + 512 * i, row = c >> 3, ch = c & 7; *(LAS v4u*)(Kt + row * SKS + ch * 16) = kq[i]; *(LAS v4u*)(Vt + row * SVS + ch * 16) = vq[i]; } }
    __syncthreads();
    const int hi = lane >> 5, r32 = lane & 31, g = wave >> 1, qh = wave & 1, head = kvh * 4 + g;
    const float slope2 = __builtin_amdgcn_exp2f(-(float)(head + 1)) * LOG2E, sink2 = sinks[head] * LOG2E;
    const lcp vb = tr_base((lcp)Vt, SVS, lane);
    const bf16* SQ = (const bf16*)(ws + WS_SQ); bf16* AS = (bf16*)(ws + WS_AS);
#pragma unroll 1
    for (int qt = 0; qt < 2; ++qt) {
        const int q0 = qh * 64 + qt * 32, q = q0 + r32, kt0 = q0 >> 5;
        bf16x8 qf[4];
#pragma unroll
        for (int ks = 0; ks < 4; ++ks) qf[ks] = *(const GAS bf16x8*)(SQ + (tb0 + q) * 512 + head * 64 + 16 * ks + 8 * hi);
        f32x16 p[5];
#pragma unroll
        for (int j = 0; j < 5; ++j) { p[j] = (f32x16){};
            const lcp kr = (lcp)Kt + (32 * (kt0 + j) + r32) * SKS + 16 * hi;
#pragma unroll
            for (int ks = 0; ks < 4; ++ks) p[j] = MFMA32(*(const LAS bf16x8*)(kr + 32 * ks), qf[ks], p[j]); }
        float m = sink2; const int lim = nb > 0 ? WIN - 1 : (q < WIN - 1 ? q : WIN - 1);
#pragma unroll
        for (int j = 0; j < 5; ++j) { const int relb = q + WIN - 32 * (kt0 + j) - 4 * hi;
#pragma unroll
            for (int r = 0; r < 16; ++r) { const int rel = relb - ((r & 3) + 8 * (r >> 2));
                const float v = (unsigned)rel <= (unsigned)lim ? p[j][r] - slope2 * (float)rel : -__builtin_inff(); p[j][r] = v; m = fmaxf(m, v); } }
        m = fmaxf(m, __shfl_xor(m, 32));
        float l = 0.f;
#pragma unroll
        for (int j = 0; j < 5; ++j)
#pragma unroll
            for (int r = 0; r < 16; ++r) { const float e = __builtin_amdgcn_exp2f(p[j][r] - m); p[j][r] = e; l += e; }
        l += __shfl_xor(l, 32); l += __builtin_amdgcn_exp2f(sink2 - m);
        const float rl = 1.f / l;
        f32x16 o0 = {}, o1 = {};
#pragma unroll
        for (int j = 0; j < 5; ++j)
#pragma unroll
            for (int s = 0; s < 2; ++s) { const int rA = 32 * (kt0 + j) + 16 * s + 4 * hi, rB = rA + 8; const bf16x8 P = accfrag(p[j], s);
                o0 = MFMA32(trfrag(vb, SVS, rA, rB, 0), P, o0); o1 = MFMA32(trfrag(vb, SVS, rA, rB, 32), P, o1); }
        bf16* orow = AS + (tb0 + q) * 512 + head * 64;
#pragma unroll
        for (int rg = 0; rg < 4; ++rg) { const int d = 8 * rg + 4 * hi;
            pg8::u32x2 w0, w1; w0.x = cvtpk(o0[4 * rg] * rl, o0[4 * rg + 1] * rl); w0.y = cvtpk(o0[4 * rg + 2] * rl, o0[4 * rg + 3] * rl); w1.x = cvtpk(o1[4 * rg] * rl, o1[4 * rg + 1] * rl); w1.y = cvtpk(o1[4 * rg + 2] * rl, o1[4 * rg + 3] * rl);
            *(GAS pg8::u32x2*)(orow + d) = w0; *(GAS pg8::u32x2*)(orow + 32 + d) = w1; }
    }
    __syncthreads();
}
struct OutRegs { v4u kq[4], vq[4], sq[4]; };
__device__ __forceinline__ void ret_out_load(unsigned char* ws, int bhn, int tid, OutRegs& R) {
    const int n = bhn % NC, h = (bhn / NC) % RH, b = bhn / (NC * RH);
    const size_t t0 = (size_t)b * SEQ + (size_t)n * RC;
    const bf16* RK = (const bf16*)(ws + WS_RK) + t0 * 512 + h * 128; const bf16* RV = (const bf16*)(ws + WS_RV) + t0 * 512 + h * 128; const bf16* ST = (const bf16*)(ws + WS_ST) + (size_t)bhn * 16384;
#pragma unroll
    for (int i = 0; i < 4; ++i) { const int c = tid + 512 * i, row = c >> 4, ch = c & 15; R.kq[i] = *(const GAS v4u*)(RK + (size_t)row * 512 + ch * 8); R.vq[i] = *(const GAS v4u*)(RV + (size_t)row * 512 + ch * 8); R.sq[i] = *(const GAS v4u*)(ST + (size_t)row * 128 + ch * 8); }
}
__device__ __forceinline__ void ret_out_commit(LAS unsigned char* lds, int tid, const OutRegs& R) {
    LAS unsigned char* Kt = lds; LAS unsigned char* Vt = lds + 128 * KS; LAS unsigned char* St = Vt + 128 * TS;
#pragma unroll
    for (int i = 0; i < 4; ++i) { const int c = tid + 512 * i, row = c >> 4, ch = c & 15; *(LAS v4u*)(Kt + row * KS + ch * 16) = R.kq[i]; *(LAS v4u*)(Vt + row * TS + ch * 16) = R.vq[i]; *(LAS v4u*)(St + row * TS + ch * 16) = R.sq[i]; }
}
__device__ __forceinline__ void ret_out_compute(unsigned char* ws, LAS unsigned char* lds, const float* gn_g, const float* gn_b, int bhn, int wave, int lane, const bf16x8 (&qf)[8]) {
    const int n = bhn % NC, h = (bhn / NC) % RH, b = bhn / (NC * RH);
    const size_t t0 = (size_t)b * SEQ + (size_t)n * RC;
    LAS unsigned char* Kt = lds; LAS unsigned char* Vt = lds + 128 * KS; LAS unsigned char* St = Vt + 128 * TS; LAS float* xs = (LAS float*)(St + 128 * TS);
    const int hi = lane >> 5, r32 = lane & 31, it = wave >> 1, vh = wave & 1, i = 32 * it + r32;
    const float lg2 = ret_lg2(h);
    const lcp vb = tr_base((lcp)Vt, TS, lane), sb = tr_base((lcp)St, TS, lane);
    f32x16 y0 = {}, y1 = {};
#pragma unroll
    for (int ks = 0; ks < 8; ++ks) { const int rA = 16 * ks + 8 * hi, rB = rA + 4;
        y0 = MFMA32(trfrag(sb, TS, rA, rB, 64 * vh), qf[ks], y0); y1 = MFMA32(trfrag(sb, TS, rA, rB, 64 * vh + 32), qf[ks], y1); }
    { const float xi = __builtin_amdgcn_exp2f((float)(i + 1) * lg2);
#pragma unroll
      for (int r = 0; r < 16; ++r) { y0[r] *= xi; y1[r] *= xi; } }
#pragma unroll 1
    for (int jt = 0; jt <= it; ++jt) {
        f32x16 p = {};
        const lcp kr = (lcp)Kt + (32 * jt + r32) * KS + 16 * hi;
#pragma unroll
        for (int ks = 0; ks < 8; ++ks) p = MFMA32(*(const LAS bf16x8*)(kr + 32 * ks), qf[ks], p);
#pragma unroll
        for (int r = 0; r < 16; ++r) { const int dj = i - (32 * jt + crow(r, hi)); p[r] = dj >= 0 ? p[r] * __builtin_amdgcn_exp2f((float)dj * lg2) : 0.f; }
#pragma unroll
        for (int s = 0; s < 2; ++s) { const int rA = 32 * jt + 16 * s + 4 * hi, rB = rA + 8; const bf16x8 P = accfrag(p, s);
            y0 = MFMA32(trfrag(vb, TS, rA, rB, 64 * vh), P, y0); y1 = MFMA32(trfrag(vb, TS, rA, rB, 64 * vh + 32), P, y1); }
    }
    float s1 = 0.f, s2 = 0.f;
#pragma unroll
    for (int r = 0; r < 16; ++r) { s1 += y0[r] + y1[r]; s2 += y0[r] * y0[r] + y1[r] * y1[r]; }
    s1 += __shfl_xor(s1, 32); s2 += __shfl_xor(s2, 32);
    if (hi == 0) { xs[(i * 2 + vh) * 2] = s1; xs[(i * 2 + vh) * 2 + 1] = s2; }
    __syncthreads();
    { const float o1 = xs[(i * 2 + (vh ^ 1)) * 2], o2 = xs[(i * 2 + (vh ^ 1)) * 2 + 1]; s1 += o1; s2 += o2; }
    const float mu = s1 * (1.f / 128.f), var = fmaxf(s2 * (1.f / 128.f) - mu * mu, 0.f), rstd = rsqrtf(var + EPS);
    const bf16* RG = (const bf16*)(ws + WS_RG) + (t0 + i) * 512 + h * 128; bf16* AR = (bf16*)(ws + WS_AR) + (t0 + i) * 512 + h * 128;
#pragma unroll
    for (int rg = 0; rg < 4; ++rg)
#pragma unroll
        for (int half = 0; half < 2; ++half) { const int v = 64 * vh + 32 * half + 8 * rg + 4 * hi;
            const f32x4 gg = *(const GAS f32x4*)(gn_g + h * 128 + v), bb = *(const GAS f32x4*)(gn_b + h * 128 + v); const f32x4 sg = pg8::unpack4(*(const GAS pg8::u32x2*)(RG + v));
            float o[4];
#pragma unroll
            for (int e = 0; e < 4; ++e) { const float yv = half ? y1[4 * rg + e] : y0[4 * rg + e]; o[e] = sg[e] * ((yv - mu) * rstd * gg[e] + bb[e]); }
            pg8::u32x2 w; w.x = cvtpk(o[0], o[1]); w.y = cvtpk(o[2], o[3]); *(GAS pg8::u32x2*)(AR + v) = w; }
}
__device__ __forceinline__ void ret_out_phase(unsigned char* ws, LAS unsigned char* lds, const float* gn_g, const float* gn_b, int bx, int G, int tid, int wave, int lane) {
    constexpr int NU = BATCH * RH * NC; if (bx >= NU) return;
    OutRegs R; ret_out_load(ws, bx, tid, R);
    for (int u = bx; u < NU; u += G) {
        ret_out_commit(lds, tid, R);
        __syncthreads();
        bf16x8 qf[8];
        { const int n = u % NC, h = (u / NC) % RH, b = u / (NC * RH); const bf16* RQ = (const bf16*)(ws + WS_RQ) + ((size_t)b * SEQ + (size_t)n * RC) * 512 + h * 128;
          const int i = 32 * (wave >> 1) + (lane & 31), hi = lane >> 5;
#pragma unroll
          for (int ks = 0; ks < 8; ++ks) qf[ks] = *(const GAS bf16x8*)(RQ + (size_t)i * 512 + 16 * ks + 8 * hi); }
        if (u + G < NU) ret_out_load(ws, u + G, tid, R);
        ret_out_compute(ws, lds, gn_g, gn_b, u, wave, lane, qf);
        __syncthreads();
    }
}
#undef MFMA32
}

constexpr int NWAVES = 8;
constexpr int RING_OFF = 0, RING_BYTES = 131072;
constexpr int LDSCTL_OFF = RING_BYTES, MISC_OFF = LDSCTL_OFF + 320;
constexpr int GTAB_OFF = LDSCTL_OFF + 2048;
constexpr int LDS_BYTES = 147456;

__device__ __forceinline__ void p0_transpose_item(const float* W, int ldw, int k0, int ns0, bf16* WT, int ldt, int nd0, const float* ks, LAS float* scr, int lane) {
    float ld[32];
#pragma unroll
    for (int i = 0; i < 32; ++i) ld[i] = W[(size_t)(k0 + 2 * i + (lane >> 5)) * ldw + ns0 + (lane & 31)];
#pragma unroll
    for (int i = 0; i < 32; ++i) scr[(2 * i + (lane >> 5)) * 33 + (lane & 31)] = ld[i];
    LDS_WAIT(); asm volatile("" ::: "memory");
    const int c = lane & 7;
    float sc[8];
#pragma unroll
    for (int i = 0; i < 8; ++i) sc[i] = ks ? ks[k0 + 8 * c + i] : 1.f;
#pragma unroll
    for (int j = 0; j < 4; ++j) { const int n = (lane >> 3) + 8 * j; const LAS float* s = scr + (8 * c) * 33 + n;
        v4u o; o.x = pk2(s[0 * 33] * sc[0], s[1 * 33] * sc[1]); o.y = pk2(s[2 * 33] * sc[2], s[3 * 33] * sc[3]); o.z = pk2(s[4 * 33] * sc[4], s[5 * 33] * sc[5]); o.w = pk2(s[6 * 33] * sc[6], s[7 * 33] * sc[7]);
        *(GAS v4u*)(WT + (size_t)(nd0 + n) * ldt + k0 + 8 * c) = o; }
    LDS_WAIT(); asm volatile("" ::: "memory");
}
__device__ __forceinline__ void rms_rows2_to_bf16(const float* x, const float* g, bf16* o, int r0, int r1, int lane) {
    const GAS f32x4* x0 = (const GAS f32x4*)(x + (size_t)r0 * D) + lane; const GAS f32x4* x1 = (const GAS f32x4*)(x + (size_t)r1 * D) + lane;
    f32x4 v0[4], v1[4]; float s0 = 0.f, s1 = 0.f;
#pragma unroll
    for (int j = 0; j < 4; ++j) { v0[j] = x0[64 * j]; v1[j] = x1[64 * j]; }
#pragma unroll
    for (int j = 0; j < 4; ++j) { s0 += (v0[j].x * v0[j].x + v0[j].y * v0[j].y) + (v0[j].z * v0[j].z + v0[j].w * v0[j].w); s1 += (v1[j].x * v1[j].x + v1[j].y * v1[j].y) + (v1[j].z * v1[j].z + v1[j].w * v1[j].w); }
    const float q0 = rsqrtf(wave_sum(s0) * (1.f / D) + EPS), q1 = rsqrtf(wave_sum(s1) * (1.f / D) + EPS);
    GAS unsigned long long* o0 = (GAS unsigned long long*)(o + (size_t)r0 * D) + lane; GAS unsigned long long* o1 = (GAS unsigned long long*)(o + (size_t)r1 * D) + lane;
#pragma unroll
    for (int j = 0; j < 4; ++j) { const f32x4 gg = ((const GAS f32x4*)g)[lane + 64 * j];
        o0[64 * j] = (unsigned long long)pk2(v0[j].x * q0 * gg.x, v0[j].y * q0 * gg.y) | ((unsigned long long)pk2(v0[j].z * q0 * gg.z, v0[j].w * q0 * gg.w) << 32);
        o1[64 * j] = (unsigned long long)pk2(v1[j].x * q1 * gg.x, v1[j].y * q1 * gg.y) | ((unsigned long long)pk2(v1[j].z * q1 * gg.z, v1[j].w * q1 * gg.w) << 32); }
}

struct Args { const float* in[24]; float* out; unsigned char* ws; int ph_lo, ph_hi; };
template <int I> __device__ __forceinline__ const float* karg() {
    unsigned long long v; asm volatile("s_load_dwordx2 %0, %1, %2\n\ts_waitcnt lgkmcnt(0)" : "=s"(v) : "s"(__builtin_amdgcn_kernarg_segment_ptr()), "i"(I * 8)); return (const float*)v; }
enum { I_X = 0, I_P, I_MIXG, I_WIN, I_GNG, I_GNB, I_WRO, I_QG, I_KG, I_SINK, I_WSO, I_WOUT, I_FFNG, I_WRG, I_BRG, I_WRE, I_BRE, I_WEG, I_WEU, I_WED, I_PGG, I_WPG, I_WPLE, I_PLEG };

__device__ __forceinline__ void p0_prologue(unsigned char* ws, LAS unsigned char* lds, int vcu, int G, int wave, int lane) {
    LAS float* scr = (LAS float*)(lds + RING_OFF + wave * 16384);
    const int gw = vcu * NWAVES + wave, NGW = G * NWAVES;
    const float* a_win = karg<I_WIN>(); const float* a_wro = karg<I_WRO>(); const float* a_wso = karg<I_WSO>(); const float* a_wout = karg<I_WOUT>(); const float* a_wpg = karg<I_WPG>(); const float* a_pgg = karg<I_PGG>(); const float* a_wple = karg<I_WPLE>();
    constexpr int I_IN = 16 * 152, I_RO = 8 * 32, I_SO = 8 * 32, I_OUT = 16 * 32, I_PG = 16 * 32, I_PL = 4 * 32;
    constexpr int NITEMS = I_IN + I_RO + I_SO + I_OUT + I_PG + I_PL;
    for (int it = gw; it < NITEMS; it += NGW) {
        int r = it;
        if (r < I_IN) { const int kb = r / 152, nb = r % 152, pn = nb >> 3, q = nb & 7; int ns0 = 32 * nb;
            if (pn >= 8 && pn <= 10) ns0 = 256 * pn + 32 * (((q & 3) << 1) | (q >> 2));
            p0_transpose_item(a_win, INW, 64 * kb, ns0, (bf16*)(ws + WS_WIN), D, 32 * nb, nullptr, scr, lane); continue; } r -= I_IN;
        if (r < I_RO) { p0_transpose_item(a_wro, D, 64 * (r / 32), 32 * (r % 32), (bf16*)(ws + WS_WRO), 512, 32 * (r % 32), nullptr, scr, lane); continue; } r -= I_RO;
        if (r < I_SO) { p0_transpose_item(a_wso, D, 64 * (r / 32), 32 * (r % 32), (bf16*)(ws + WS_WSO), 512, 32 * (r % 32), nullptr, scr, lane); continue; } r -= I_SO;
        if (r < I_OUT) { p0_transpose_item(a_wout, D, 64 * (r / 32), 32 * (r % 32), (bf16*)(ws + WS_WOUT), D, 32 * (r % 32), nullptr, scr, lane); continue; } r -= I_OUT;
        if (r < I_PG) { p0_transpose_item(a_wpg, D, 64 * (r / 32), 32 * (r % 32), (bf16*)(ws + WS_WPG), D, 32 * (r % 32), a_pgg, scr, lane); continue; } r -= I_PG;
        p0_transpose_item(a_wple, D, 64 * (r / 32), 32 * (r % 32), (bf16*)(ws + WS_WPLE), PLE, 32 * (r % 32), nullptr, scr, lane);
    }
    { const float* g = karg<I_FFNG>(); const float* wrg = karg<I_WRG>(); const float* wre = karg<I_WRE>(); float* wrt = (float*)(ws + WS_WRT);
      for (int idx = gw * 64 + lane; idx < 36 * D; idx += NGW * 64) { const int o = idx >> 10, k = idx & 1023; wrt[idx] = g[k] * (o < 4 ? wrg[k * 4 + o] : wre[k * 32 + (o - 4)]); } }
    { const float* xx = karg<I_X>(); const float* mg = karg<I_MIXG>();
      for (int m = gw; m < T; m += 2 * NGW) rms_rows2_to_bf16(xx, mg, (bf16*)(ws + WS_XN), m, m + NGW < T ? m + NGW : m, lane); }
}


__device__ __forceinline__ void router_block(unsigned char* ws, const float* brg, const float* bre, LAS unsigned char* sc, int rb, int tid, int wave, int lane, int dummy = 0) {
    LAS float* wl = (LAS float*)sc; LAS float* dots = (LAS float*)(sc + 73728); LAS float* rsl = dots + 64 * 36; LAS unsigned* lcnt = (LAS unsigned*)(rsl + 64); LAS unsigned* lbase = lcnt + 32;
    const float* wrt = (const float*)(ws + WS_WRT);
    if (tid < 32) lcnt[tid] = 0u;
    const int row0 = rb * 64 + wave * 8;
    f32x4 xv[8][4];
    { pg8::u32x2 xr[8][4];
#pragma unroll
      for (int r = 0; r < 8; ++r)
#pragma unroll
          for (int j = 0; j < 4; ++j) xr[r][j] = ((const GAS pg8::u32x2*)((const bf16*)(ws + WS_X1B) + (size_t)(row0 + r) * D))[64 * j + lane];
#pragma unroll
      for (int r = 0; r < 8; ++r) { float ss = 0.f;
#pragma unroll
          for (int j = 0; j < 4; ++j) { xv[r][j] = pg8::unpack4(xr[r][j]); ss += (xv[r][j].x * xv[r][j].x + xv[r][j].y * xv[r][j].y) + (xv[r][j].z * xv[r][j].z + xv[r][j].w * xv[r][j].w); }
          ss = wave_sum(ss); if (lane == 0) rsl[wave * 8 + r] = rsqrtf(ss * (1.f / D) + EPS); } }
    const int myr = ((lane >> 5) & 1) * 4 + ((lane >> 4) & 1) * 2 + ((lane >> 3) & 1);
#pragma unroll 1
    for (int half = 0; half < 2; ++half) {
        __syncthreads();
        { f32x4 t[9];
#pragma unroll
          for (int i = 0; i < 9; ++i) t[i] = ((const GAS f32x4*)(wrt + half * 18 * D))[i * 512 + tid];
#pragma unroll
          for (int i = 0; i < 9; ++i) ((LAS f32x4*)wl)[i * 512 + tid] = t[i]; }
        __syncthreads();
#pragma unroll 2
        for (int o = 0; o < 18; ++o) {
            f32x4 w[4]; float acc[8];
#pragma unroll
            for (int j = 0; j < 4; ++j) w[j] = ((const LAS f32x4*)(wl + o * D))[64 * j + lane];
#pragma unroll
            for (int r = 0; r < 8; ++r) { float s = 0.f;
#pragma unroll
                for (int j = 0; j < 4; ++j) s += (xv[r][j].x * w[j].x + xv[r][j].y * w[j].y) + (xv[r][j].z * w[j].z + xv[r][j].w * w[j].w);
                acc[r] = s; }
            { const bool up = (lane & 32) != 0;
#pragma unroll
              for (int i = 0; i < 4; ++i) { const float keep = up ? acc[i + 4] : acc[i], send = up ? acc[i] : acc[i + 4]; acc[i] = keep + __shfl_xor(send, 32); } }
            { const bool up = (lane & 16) != 0;
#pragma unroll
              for (int i = 0; i < 2; ++i) { const float keep = up ? acc[i + 2] : acc[i], send = up ? acc[i] : acc[i + 2]; acc[i] = keep + __shfl_xor(send, 16); } }
            { const bool up = (lane & 8) != 0; const float keep = up ? acc[1] : acc[0], send = up ? acc[0] : acc[1]; acc[0] = keep + __shfl_xor(send, 8); }
            float v = acc[0]; v += __shfl_xor(v, 4); v += __shfl_xor(v, 2); v += __shfl_xor(v, 1);
            if ((lane & 7) == 0) dots[(wave * 8 + myr) * 36 + half * 18 + o] = v;
        }
    }
    __syncthreads();
    int e1 = 0, e2 = 0; unsigned lp1 = 0, lp2 = 0; const int row = row0 + lane;
    if (lane < 8) {
        const float rstd = rsl[wave * 8 + lane]; const LAS float* dr = dots + (wave * 8 + lane) * 36;
        float lg[4], le[32];
#pragma unroll
        for (int o = 0; o < 4; ++o) lg[o] = dr[o] * rstd + brg[o];
#pragma unroll
        for (int o = 0; o < 32; ++o) le[o] = dr[4 + o] * rstd + bre[o];
        float gm = lg[0]; int gs = 0;
#pragma unroll
        for (int o = 1; o < 4; ++o) if (lg[o] > gm) { gm = lg[o]; gs = o; }
        float gden = 0.f;
#pragma unroll
        for (int o = 0; o < 4; ++o) gden += __expf(lg[o] - gm);
        const float gw = 1.f / gden;
        float e8[8];
#pragma unroll
        for (int o = 0; o < 8; ++o) e8[o] = gs == 0 ? le[o] : gs == 1 ? le[8 + o] : gs == 2 ? le[16 + o] : le[24 + o];
        float m1 = e8[0]; int i1 = 0;
#pragma unroll
        for (int o = 1; o < 8; ++o) if (e8[o] > m1) { m1 = e8[o]; i1 = o; }
        float m2 = -3.0e38f; int i2 = 0;
#pragma unroll
        for (int o = 0; o < 8; ++o) if (o != i1 && e8[o] > m2) { m2 = e8[o]; i2 = o; }
        const float p2 = __expf(m2 - m1), inv = 1.f / (1.f + p2);
        e1 = gs * 8 + i1; e2 = gs * 8 + i2;
        ((float*)(ws + WS_RSTD1))[row] = rstd;
        ((float*)(ws + WS_CW))[row * 2] = gw * inv; ((float*)(ws + WS_CW))[row * 2 + 1] = gw * p2 * inv;
        lp1 = __hip_atomic_fetch_add(lcnt + e1, 1u, __ATOMIC_RELAXED, __HIP_MEMORY_SCOPE_WORKGROUP);
        lp2 = __hip_atomic_fetch_add(lcnt + e2, 1u, __ATOMIC_RELAXED, __HIP_MEMORY_SCOPE_WORKGROUP);
    }
    __syncthreads();
    if (tid < 32) { const unsigned n = lcnt[tid]; lbase[tid] = n ? __hip_atomic_fetch_add((unsigned*)(ws + WS_CTL) + CW_CNT + dummy * 4096 + 64 * tid, n, __ATOMIC_RELAXED, __HIP_MEMORY_SCOPE_AGENT) : 0u; }
    __syncthreads();
    if (lane < 8) { int* LIST = (int*)(ws + (dummy ? WS_HID : WS_LIST));
        LIST[e1 * 16384 + (int)(lbase[e1] + lp1)] = row * 2; LIST[e2 * 16384 + (int)(lbase[e2] + lp2)] = row * 2 + 1; }
    __syncthreads();
}
__device__ __forceinline__ void p7_expert_weights(unsigned char* ws, LAS unsigned char* lds, int vcu, int G, int wave, int lane) {
    LAS float* scr = (LAS float*)(lds + RING_OFF + wave * 16384);
    const float* weg = karg<I_WEG>(); const float* weu = karg<I_WEU>(); const float* wed = karg<I_WED>(); const float* ffg = karg<I_FFNG>();
    const int gw = vcu * NWAVES + wave, NGW = G * NWAVES;
    constexpr int I_GU = NE * 16 * 16, I_DN = NE * 4 * 32;
    for (int it = gw; it < I_GU + I_DN; it += NGW) {
        if (it < I_GU) { const int e = it >> 8, r = it & 255, kb = r >> 4, nbd = r & 15, pn = nbd >> 3, bj = (nbd >> 2) & 1, jb = nbd & 3;
            const float* W = (bj ? weu : weg) + (size_t)e * D * FF;
            p0_transpose_item(W, FF, 64 * kb, 128 * pn + 32 * jb, (bf16*)(ws + WS_WGU) + (size_t)e * 512 * D, D, 32 * nbd, ffg, scr, lane); }
        else { const int r2 = it - I_GU, e = r2 >> 7, r = r2 & 127, kb = r >> 5, nb = r & 31;
            p0_transpose_item(wed + (size_t)e * FF * D, D, 64 * kb, 32 * nb, (bf16*)(ws + WS_WD) + (size_t)e * D * FF, FF, 32 * nb, nullptr, scr, lane); }
    }
}
__device__ __forceinline__ pg8::MoeTables moe_tables(unsigned char* ws, LAS unsigned char* tb, int tid) {
    LAS int* cnt = (LAS int*)tb; LAS int* pre = cnt + 32;
    if (tid < 32) cnt[tid] = (int)__hip_atomic_load((unsigned*)(ws + WS_CTL) + CW_CNT + 64 * tid, __ATOMIC_RELAXED, __HIP_MEMORY_SCOPE_AGENT);
    __syncthreads();
    if (tid == 0) { int s = 0; for (int e = 0; e < 32; ++e) { pre[e] = s; s += (cnt[e] + 255) >> 8; } pre[32] = s; }
    __syncthreads();
    return pg8::MoeTables{cnt, pre};
}
__device__ __forceinline__ void combine_rows2(unsigned char* ws, int t0, int t1, int lane) {
    const int tt[2] = {t0, t1}; pg8::u32x2 xr[2][4], ya[2][4], yb[2][4];
#pragma unroll
    for (int q = 0; q < 2; ++q) { const GAS pg8::u32x2* x1 = (const GAS pg8::u32x2*)((const bf16*)(ws + WS_X1B) + (size_t)tt[q] * D) + lane;
        const GAS pg8::u32x2* y0 = (const GAS pg8::u32x2*)((const bf16*)(ws + WS_Y) + (size_t)(2 * tt[q]) * D) + lane;
#pragma unroll
        for (int j = 0; j < 4; ++j) { xr[q][j] = x1[64 * j]; ya[q][j] = y0[64 * j]; yb[q][j] = y0[D / 4 + 64 * j]; } }
#pragma unroll
    for (int q = 0; q < 2; ++q) { GAS pg8::u32x2* xb = (GAS pg8::u32x2*)((bf16*)(ws + WS_X2B) + (size_t)tt[q] * D) + lane; float s = 0.f;
#pragma unroll
        for (int j = 0; j < 4; ++j) { const f32x4 v = pg8::unpack4(xr[q][j]) + pg8::unpack4(ya[q][j]) + pg8::unpack4(yb[q][j]);
            pg8::u32x2 w; w.x = pk2(v.x, v.y); w.y = pk2(v.z, v.w); xb[64 * j] = w;
            const f32x4 vr = pg8::unpack4(w); s += (vr.x * vr.x + vr.y * vr.y) + (vr.z * vr.z + vr.w * vr.w); }
        s = wave_sum(s);
        float sp = lane < 16 ? ((const float*)(ws + WS_SSP))[(size_t)tt[q] * 16 + lane] : 0.f; sp = wave_sum(sp);
        if (lane == 0) { ((float*)(ws + WS_RSTD2))[tt[q]] = rsqrtf(s * (1.f / D) + EPS); ((float*)(ws + WS_RSTDP))[tt[q]] = rsqrtf(sp * (1.f / D) + EPS); } }
}

#ifndef PROBE_MASK
#define PROBE_MASK 0
#endif
#define PH_IDS int tid = threadIdx.x; asm volatile("" : "+v"(tid)); const int lane = tid & 63, wave = __builtin_amdgcn_readfirstlane(tid >> 6); (void)lane; (void)wave
struct Ctx { unsigned char* ws; float* out; LAS unsigned char* lds; int G, bx, vcu; };

__device__ __forceinline__ void phase0(const Ctx& c) { PH_IDS; p0_prologue(c.ws, c.lds, c.vcu, c.G, wave, lane); }
__device__ __forceinline__ void phase1(const Ctx& c) { unsigned char* ws = c.ws;
    pg8::TileOrder S; S.init(ws + WS_XN, ws + WS_WIN, T, INW, D, c.G, c.bx);
    pg8::EpiZ E{ws, karg<I_QG>(), karg<I_KG>()};
    pg8::gemm_phase<pg8::EpiZ, pg8::TileOrder>(c.lds + RING_OFF, D, S, E); }
__device__ __forceinline__ void phase2(const Ctx& c) { PH_IDS;
    mx::ret_kv_phase(c.ws, c.lds + RING_OFF, c.bx, c.G, tid, wave, lane); }
__device__ __forceinline__ void phase3(const Ctx& c) { PH_IDS;
    mx::ret_scan(c.ws, c.bx * (NWAVES * 64) + tid, c.G * NWAVES * 64);
    const float* sinks = karg<I_SINK>();
    for (int u = c.bx; u < BATCH * (SEQ / WIN) * SKV; u += c.G) mx::swa_unit(c.ws, c.lds + RING_OFF, sinks, u, tid, wave, lane); }
__device__ __forceinline__ void phase4(const Ctx& c) { PH_IDS;
    const float* gng = karg<I_GNG>(); const float* gnb = karg<I_GNB>();
    mx::ret_out_phase(c.ws, c.lds + RING_OFF, gng, gnb, c.bx, c.G, tid, wave, lane); }
__device__ __forceinline__ void phase5(const Ctx& c) { unsigned char* ws = c.ws;
    pg8::TwoPassOrder S; S.init(ws + WS_AR, ws + WS_WRO, ws + WS_AS, ws + WS_WSO, T, D, 512, c.G, c.bx);
    pg8::EpiMerge E{(const bf16*)(ws + WS_GR), (const bf16*)(ws + WS_GS), (bf16*)(ws + WS_MG)};
    pg8::gemm_phase<pg8::EpiMerge, pg8::TwoPassOrder>(c.lds + RING_OFF, 512, S, E); }
__device__ __forceinline__ void phase6(const Ctx& c) { unsigned char* ws = c.ws;
    { PH_IDS; const int gw = c.vcu * NWAVES + wave, NGW = c.G * NWAVES;
      const float* pp_ = karg<I_P>();
      for (int m = gw; m < T; m += 8 * NGW) { f32x4 v[8];
#pragma unroll
          for (int i = 0; i < 8; ++i) v[i] = ((const GAS f32x4*)(pp_ + (size_t)(m + i * NGW) * PLE))[lane];
#pragma unroll
          for (int i = 0; i < 8; ++i) ((GAS unsigned long long*)((bf16*)(ws + WS_PB) + (size_t)(m + i * NGW) * PLE))[lane] = (unsigned long long)pk2(v[i].x, v[i].y) | ((unsigned long long)pk2(v[i].z, v[i].w) << 32); } }
    pg8::TileOrder S; S.init(ws + WS_MG, ws + WS_WOUT, T, D, D, c.G, c.bx);
    pg8::EpiX1 E{karg<I_X>(), (bf16*)(ws + WS_X1B)};
    pg8::gemm_phase<pg8::EpiX1, pg8::TileOrder>(c.lds + RING_OFF, D, S, E); }
__device__ __forceinline__ void phase7a(const Ctx& c) { PH_IDS; const float* brg = karg<I_BRG>(); const float* bre = karg<I_BRE>();
    if ((PROBE_MASK >> 14) & 1) for (int rb = c.bx; rb < T / 64; rb += c.G) router_block(c.ws, brg, bre, c.lds + RING_OFF, rb, tid, wave, lane, 1);
    for (int rb = c.bx; rb < T / 64; rb += c.G) router_block(c.ws, brg, bre, c.lds + RING_OFF, rb, tid, wave, lane); }
__device__ __forceinline__ void phase7b(const Ctx& c) { PH_IDS; p7_expert_weights(c.ws, c.lds, c.vcu, c.G, wave, lane); __syncthreads(); }
__device__ __forceinline__ void phase7c(const Ctx& c) { unsigned char* ws = c.ws;
    pg8::TileOrder S; S.init(ws + WS_PB, ws + WS_WPLE, T, D, PLE, c.G, c.bx);
    pg8::EpiPP E{(bf16*)(ws + WS_PP), (float*)(ws + WS_SSP)};
    pg8::gemm_phase<pg8::EpiPP, pg8::TileOrder>(c.lds + RING_OFF, PLE, S, E); }
__device__ __forceinline__ void phase7(const Ctx& c) {
    phase7a(c);
    if ((PROBE_MASK >> 12) & 1) phase7b(c);
    phase7b(c);
    if ((PROBE_MASK >> 13) & 1) phase7c(c);
    phase7c(c); }
__device__ __forceinline__ void phase8(const Ctx& c) { unsigned char* ws = c.ws;
    const pg8::MoeTables tb = moe_tables(ws, c.lds + LDSCTL_OFF + 1024, threadIdx.x);
    pg8::MoeUpOrder S{tb, c.G, c.bx, (const char*)(ws + WS_X1B), (const char*)(ws + WS_WGU), (const int*)(ws + WS_LIST)};
    pg8::EpiUp E{tb, (const int*)(ws + WS_LIST), (const float*)(ws + WS_RSTD1), (const float*)(ws + WS_CW), (bf16*)(ws + WS_HID)};
    pg8::gemm_phase<pg8::EpiUp, pg8::MoeUpOrder>(c.lds + RING_OFF, D, S, E, (LAS unsigned short*)(c.lds + GTAB_OFF)); }
__device__ __forceinline__ void phase9(const Ctx& c) { unsigned char* ws = c.ws;
    const pg8::MoeTables tb = moe_tables(ws, c.lds + LDSCTL_OFF + 1024, threadIdx.x);
    pg8::MoeDownOrder S{tb, c.G, c.bx, (const char*)(ws + WS_HID), (const char*)(ws + WS_WD)};
    pg8::EpiDown E{tb, (const int*)(ws + WS_LIST), (bf16*)(ws + WS_Y)};
    pg8::gemm_phase<pg8::EpiDown, pg8::MoeDownOrder>(c.lds + RING_OFF, FF, S, E); }
__device__ __forceinline__ void phase10(const Ctx& c) { PH_IDS;
    const int gw = c.vcu * NWAVES + wave, NGW = c.G * NWAVES;
    for (int t = gw; t < T; t += 2 * NGW) combine_rows2(c.ws, t, t + NGW < T ? t + NGW : t, lane); }
__device__ __forceinline__ void phase11(const Ctx& c) { unsigned char* ws = c.ws;
    pg8::TileOrder S; S.init(ws + WS_X2B, ws + WS_WPG, T, D, D, c.G, c.bx);
    pg8::EpiFinal E{c.out, (const bf16*)(ws + WS_X2B), (const bf16*)(ws + WS_PP), (const float*)(ws + WS_RSTD2), (const float*)(ws + WS_RSTDP), karg<I_PLEG>()};
    pg8::gemm_phase<pg8::EpiFinal, pg8::TileOrder>(c.lds + RING_OFF, D, S, E); }

constexpr int N_PHASES = 12;
#ifndef PROBE_MASK
#define PROBE_MASK 0
#endif
__global__ void __launch_bounds__(NWAVES * 64, 2) mk_fwd(Args args) {
    extern __shared__ __attribute__((aligned(16))) unsigned char lds_raw[];
    LAS unsigned char* lds = (LAS unsigned char*)lds_raw;
    volatile LAS unsigned* MISC = (volatile LAS unsigned*)(lds + MISC_OFF);
    const int G = gridDim.x; const int bx = blockIdx.x; const int vcu = (G % 8 == 0) ? (bx % 8) * (G / 8) + bx / 8 : bx;
    unsigned char* ws = args.ws;
    gu32* ctl = (gu32*)(ws + WS_CTL);
    for (int u = threadIdx.x; u < (LDS_BYTES - LDSCTL_OFF) / 4; u += NWAVES * 64) ((LAS unsigned*)(lds + LDSCTL_OFF))[u] = 0u;
    __syncthreads();
    XcdBarrier bar = xcd_barrier_post((unsigned*)(ctl + CW_BAR), MISC + 8);
    const int lo = args.ph_lo, hi = args.ph_hi;
    const Ctx c{ws, args.out, lds, G, bx, vcu};
#define RUN(k, f) do { if (lo <= (k) && (k) < hi) { for (int r_ = (((PROBE_MASK >> (k)) & 1) ? 0 : 1); r_ < 2; ++r_) { f(c); if (r_ == 0 || (k) + 1 < hi) xcd_barrier(bar); } } } while (0)
    RUN(0, phase0); RUN(1, phase1); RUN(2, phase2); RUN(3, phase3); RUN(4, phase4); RUN(5, phase5);
    RUN(6, phase6); RUN(7, phase7); RUN(8, phase8); RUN(9, phase9); RUN(10, phase10); RUN(11, phase11);
#undef RUN
}

__global__ void __launch_bounds__(256) k_rmsnorm_bf16(const float* x, const float* g, bf16* out) {
    const int row = blockIdx.x * 4 + (threadIdx.x >> 6), lane = threadIdx.x & 63;
    const float4* xr = (const float4*)(x + (size_t)row * D) + lane;
    float4 v[4]; float s = 0.f;
#pragma unroll
    for (int j = 0; j < 4; ++j) { v[j] = xr[64 * j]; s += v[j].x * v[j].x + v[j].y * v[j].y + v[j].z * v[j].z + v[j].w * v[j].w; }
    const float rstd = rsqrtf(wave_sum(s) * (1.f / D) + EPS);
#pragma unroll
    for (int j = 0; j < 4; ++j) { const float4 gg = ((const float4*)g)[lane + 64 * j];
        uint2 o; o.x = f2bf(v[j].x * rstd * gg.x) | (f2bf(v[j].y * rstd * gg.y) << 16); o.y = f2bf(v[j].z * rstd * gg.z) | (f2bf(v[j].w * rstd * gg.w) << 16);
        ((uint2*)(out + (size_t)row * D))[lane + 64 * j] = o; }
}

struct NG_Args {
    const void* A; int lda; int a_is_f32; const float* B; int ldb; const float* kscale; int M, N, K;
    const void* A2; const float* B2;
    unsigned char* ws; const float* x; float* out; const float* aux0;
};
enum { MODE_Z = 1, MODE_MERGE = 2, MODE_X1 = 3, MODE_PP = 4, MODE_FINAL = 5 };

template <int MODE> __device__ __forceinline__ void ng_store(const NG_Args& a, int row, int col, float v, float v2) {
    unsigned char* ws = a.ws;
    if (MODE == MODE_Z) {
        if (col < 512) ((bf16*)(ws + WS_RQ))[(size_t)row * 512 + col] = (bf16)f2bf(v);
        else if (col < 1024) ((bf16*)(ws + WS_RK))[(size_t)row * 512 + col - 512] = (bf16)f2bf(v * 0.08838834764831845f);
        else if (col < 1536) ((bf16*)(ws + WS_RV))[(size_t)row * 512 + col - 1024] = (bf16)f2bf(v);
        else if (col < 2048) ((bf16*)(ws + WS_RG))[(size_t)row * 512 + col - 1536] = (bf16)f2bf(v * sigmoidf_(v));
        else if (col < 2816) ((bf16*)(ws + WS_SV))[(size_t)row * 128 + col - 2688] = (bf16)f2bf(v);
        else if (col < 3840) ((bf16*)(ws + WS_GR))[(size_t)row * 1024 + col - 2816] = (bf16)f2bf(sigmoidf_(v));
        else ((bf16*)(ws + WS_GS))[(size_t)row * 1024 + col - 3840] = (bf16)f2bf(sigmoidf_(v));
    } else if (MODE == MODE_MERGE) {
        const float gr = bf2f(((const bf16*)(ws + WS_GR))[(size_t)row * 1024 + col]), gs = bf2f(((const bf16*)(ws + WS_GS))[(size_t)row * 1024 + col]);
        ((bf16*)(ws + WS_MG))[(size_t)row * 1024 + col] = (bf16)f2bf(gr * v + gs * v2);
    } else if (MODE == MODE_X1) {
        const float x1 = a.x[(size_t)row * 1024 + col] + v;
        a.out[(size_t)row * 1024 + col] = x1; ((bf16*)(ws + WS_X1B))[(size_t)row * 1024 + col] = (bf16)f2bf(x1);
    } else if (MODE == MODE_PP) {
        ((bf16*)(ws + WS_PP))[(size_t)row * 1024 + col] = (bf16)f2bf(v);
    } else if (MODE == MODE_FINAL) {
        const float rstd2 = ((const float*)(ws + WS_RSTD2))[row], rstdp = ((const float*)(ws + WS_RSTDP))[row];
        const float ple = bf2f(((const bf16*)(ws + WS_PP))[(size_t)row * 1024 + col]) * rstdp * a.aux0[col];
        const float x2 = a.out[(size_t)row * 1024 + col];
        a.out[(size_t)row * 1024 + col] = x2 + sigmoidf_(rstd2 * v) * ple;
    }
}

template <int MODE> __global__ void __launch_bounds__(256) k_gemm_naive(NG_Args a) {
    __shared__ float As[16][68], Bs[16][68], As2[16][68], Bs2[16][68];
    const int tid = threadIdx.x, tx = tid & 15, ty = tid >> 4;
    const int m0 = blockIdx.y * 64, n0 = blockIdx.x * 64;
    float acc[4][4], acc2[4][4];
#pragma unroll
    for (int i = 0; i < 4; ++i)
#pragma unroll
        for (int j = 0; j < 4; ++j) { acc[i][j] = 0.f; acc2[i][j] = 0.f; }
    const int ar = tid >> 2, ak = (tid & 3) * 4;
    const int bk = tid >> 4, bn = (tid & 15) * 4;
    for (int k0 = 0; k0 < a.K; k0 += 16) {
        float av[4];
        if (a.a_is_f32) { const float4 t = *(const float4*)((const float*)a.A + (size_t)(m0 + ar) * a.lda + k0 + ak); av[0] = t.x; av[1] = t.y; av[2] = t.z; av[3] = t.w; }
        else { const uint2 t = *(const uint2*)((const bf16*)a.A + (size_t)(m0 + ar) * a.lda + k0 + ak); av[0] = bf2f(t.x & 0xffff); av[1] = bf2f(t.x >> 16); av[2] = bf2f(t.y & 0xffff); av[3] = bf2f(t.y >> 16); }
        float4 bv = *(const float4*)(a.B + (size_t)(k0 + bk) * a.ldb + n0 + bn);
        if (a.kscale) { const float s = a.kscale[k0 + bk]; bv.x *= s; bv.y *= s; bv.z *= s; bv.w *= s; }
#pragma unroll
        for (int i = 0; i < 4; ++i) As[ak + i][ar] = av[i];
        Bs[bk][bn] = bv.x; Bs[bk][bn + 1] = bv.y; Bs[bk][bn + 2] = bv.z; Bs[bk][bn + 3] = bv.w;
        if (MODE == MODE_MERGE) {
            const uint2 t = *(const uint2*)((const bf16*)a.A2 + (size_t)(m0 + ar) * a.lda + k0 + ak);
            As2[ak][ar] = bf2f(t.x & 0xffff); As2[ak + 1][ar] = bf2f(t.x >> 16); As2[ak + 2][ar] = bf2f(t.y & 0xffff); As2[ak + 3][ar] = bf2f(t.y >> 16);
            const float4 b2 = *(const float4*)(a.B2 + (size_t)(k0 + bk) * a.ldb + n0 + bn);
            Bs2[bk][bn] = b2.x; Bs2[bk][bn + 1] = b2.y; Bs2[bk][bn + 2] = b2.z; Bs2[bk][bn + 3] = b2.w;
        }
        __syncthreads();
#pragma unroll
        for (int kk = 0; kk < 16; ++kk) {
            float ra[4], rb[4];
#pragma unroll
            for (int i = 0; i < 4; ++i) { ra[i] = As[kk][ty * 4 + i]; rb[i] = Bs[kk][tx * 4 + i]; }
#pragma unroll
            for (int i = 0; i < 4; ++i)
#pragma unroll
                for (int j = 0; j < 4; ++j) acc[i][j] += ra[i] * rb[j];
            if (MODE == MODE_MERGE) {
#pragma unroll
                for (int i = 0; i < 4; ++i) { ra[i] = As2[kk][ty * 4 + i]; rb[i] = Bs2[kk][tx * 4 + i]; }
#pragma unroll
                for (int i = 0; i < 4; ++i)
#pragma unroll
                    for (int j = 0; j < 4; ++j) acc2[i][j] += ra[i] * rb[j];
            }
        }
        __syncthreads();
    }
#pragma unroll
    for (int i = 0; i < 4; ++i)
#pragma unroll
        for (int j = 0; j < 4; ++j) ng_store<MODE>(a, m0 + ty * 4 + i, n0 + tx * 4 + j, acc[i][j], acc2[i][j]);
}

__device__ __forceinline__ float ret_lg(int h) { return log1pf(-exp2f(-5.0f - (float)h)); }

__global__ void __launch_bounds__(256) k_ret_kv(unsigned char* ws) {
    const int bhn = blockIdx.x, n = bhn % NC, h = (bhn / NC) % RH, b = bhn / (NC * RH);
    const bf16* RK = (const bf16*)(ws + WS_RK); const bf16* RV = (const bf16*)(ws + WS_RV);
    float* KV = (float*)(ws + WS_KV) + (size_t)bhn * 128 * 128;
    const float lg = ret_lg(h);
    const size_t t0 = (size_t)b * SEQ + (size_t)n * RC;
    for (int o = threadIdx.x; o < 128 * 128; o += 256) {
        const int d = o >> 7, v = o & 127; float s = 0.f;
        for (int j = 0; j < 128; ++j) s += bf2f(RK[(t0 + j) * 512 + h * 128 + d]) * __expf((127.f - (float)j) * lg) * bf2f(RV[(t0 + j) * 512 + h * 128 + v]);
        KV[o] = s;
    }
}
__global__ void __launch_bounds__(256) k_ret_scan(unsigned char* ws) {
    const int gid = blockIdx.x * 256 + threadIdx.x;
    const int bh = gid >> 14, o = gid & 16383, d = o >> 7, v = o & 127, h = bh % RH;
    const float decay = __expf(128.f * ret_lg(h));
    const float* KV = (const float*)(ws + WS_KV); bf16* ST = (bf16*)(ws + WS_ST);
    float st = 0.f;
    for (int n = 0; n < NC; ++n) {
        const size_t bhn = (size_t)bh * NC + n;
        ST[bhn * 16384 + v * 128 + d] = (bf16)f2bf(st);
        st = decay * st + KV[bhn * 16384 + o];
    }
}
__global__ void __launch_bounds__(256) k_ret_out(unsigned char* ws, const float* gn_g, const float* gn_b) {
    extern __shared__ float sm[];
    float* sc = sm; float* yy = sm + 128 * 128;
    const int bhn = blockIdx.x, n = bhn % NC, h = (bhn / NC) % RH, b = bhn / (NC * RH);
    const bf16* RQ = (const bf16*)(ws + WS_RQ); const bf16* RK = (const bf16*)(ws + WS_RK); const bf16* RV = (const bf16*)(ws + WS_RV);
    const bf16* RG = (const bf16*)(ws + WS_RG); const bf16* ST = (const bf16*)(ws + WS_ST) + (size_t)bhn * 16384; bf16* AR = (bf16*)(ws + WS_AR);
    const float lg = ret_lg(h);
    const size_t t0 = (size_t)b * SEQ + (size_t)n * RC;
    for (int o = threadIdx.x; o < 128 * 128; o += 256) {
        const int i = o >> 7, j = o & 127; float s = 0.f;
        if (i >= j) { for (int d = 0; d < 128; ++d) s += bf2f(RQ[(t0 + i) * 512 + h * 128 + d]) * bf2f(RK[(t0 + j) * 512 + h * 128 + d]); s *= __expf((float)(i - j) * lg); }
        sc[o] = s;
    }
    __syncthreads();
    for (int o = threadIdx.x; o < 128 * 128; o += 256) {
        const int i = o >> 7, v = o & 127; float s = 0.f, c = 0.f;
        for (int j = 0; j <= i; ++j) s += sc[i * 128 + j] * bf2f(RV[(t0 + j) * 512 + h * 128 + v]);
        for (int d = 0; d < 128; ++d) c += bf2f(RQ[(t0 + i) * 512 + h * 128 + d]) * bf2f(ST[v * 128 + d]);
        yy[o] = s + c * __expf((float)(i + 1) * lg);
    }
    __syncthreads();
    if (threadIdx.x < 128) {
        const int i = threadIdx.x; float mu = 0.f;
        for (int v = 0; v < 128; ++v) mu += yy[i * 128 + ((v + i) & 127)];
        mu *= (1.f / 128.f); float var = 0.f;
        for (int v = 0; v < 128; ++v) { const float dd = yy[i * 128 + ((v + i) & 127)] - mu; var += dd * dd; }
        const float rstd = rsqrtf(var * (1.f / 128.f) + EPS);
        for (int v = 0; v < 128; ++v) { const int c = h * 128 + v; const float yn = (yy[i * 128 + v] - mu) * rstd * gn_g[c] + gn_b[c];
            AR[(t0 + i) * 512 + c] = (bf16)f2bf(bf2f(RG[(t0 + i) * 512 + c]) * yn); }
    }
}
__global__ void __launch_bounds__(256) k_swa(unsigned char* ws, const float* sinks) {
    const int gw = blockIdx.x * 4 + (threadIdx.x >> 6), lane = threadIdx.x & 63;
    const int t = gw >> 3, h = gw & 7, kvh = h >> 2, tpos = t & (SEQ - 1), tb = t - tpos;
    const bf16* SQ = (const bf16*)(ws + WS_SQ); const bf16* SK = (const bf16*)(ws + WS_SK); const bf16* SV = (const bf16*)(ws + WS_SV);
    const float q = bf2f(SQ[(size_t)t * 512 + h * 64 + lane]);
    const float slope2 = exp2f(-8.0f * (float)(h + 1) / 8.0f) * LOG2E;
    const float sink2 = sinks[h] * LOG2E;
    float m = sink2, l = 1.f, o = 0.f;
    const int lo = tpos - (WIN - 1) < 0 ? 0 : tpos - (WIN - 1);
    for (int kp = lo; kp <= tpos; ++kp) {
        const size_t tk = (size_t)(tb + kp);
        float s = wave_sum(q * bf2f(SK[tk * 128 + kvh * 64 + lane])) - slope2 * (float)(tpos - kp);
        const float mn = fmaxf(m, s), f = exp2f(m - mn), pp = exp2f(s - mn);
        l = l * f + pp; o = o * f + pp * bf2f(SV[tk * 128 + kvh * 64 + lane]); m = mn;
    }
    ((bf16*)(ws + WS_AS))[(size_t)t * 512 + h * 64 + lane] = (bf16)f2bf(o / l);
}
__global__ void __launch_bounds__(256) k_router(unsigned char* ws, const float* x1, const float* g, const float* wrg, const float* brg, const float* wre, const float* bre) {
    const int t = blockIdx.x * 4 + (threadIdx.x >> 6), lane = threadIdx.x & 63;
    float hv[16]; float ss = 0.f;
#pragma unroll
    for (int j = 0; j < 16; ++j) { hv[j] = x1[(size_t)t * D + j * 64 + lane]; ss += hv[j] * hv[j]; }
    const float rstd = rsqrtf(wave_sum(ss) * (1.f / D) + EPS);
#pragma unroll
    for (int j = 0; j < 16; ++j) hv[j] *= rstd * g[j * 64 + lane];
    float lgts[4], le[32];
#pragma unroll
    for (int o = 0; o < 4; ++o) { float s = 0.f;
#pragma unroll
        for (int j = 0; j < 16; ++j) s += hv[j] * wrg[(size_t)(j * 64 + lane) * 4 + o];
        lgts[o] = wave_sum(s) + brg[o]; }
#pragma unroll
    for (int o = 0; o < 32; ++o) { float s = 0.f;
#pragma unroll
        for (int j = 0; j < 16; ++j) s += hv[j] * wre[(size_t)(j * 64 + lane) * 32 + o];
        le[o] = wave_sum(s) + bre[o]; }
    float gm = lgts[0]; int gs = 0;
#pragma unroll
    for (int o = 1; o < 4; ++o) if (lgts[o] > gm) { gm = lgts[o]; gs = o; }
    float gden = 0.f;
#pragma unroll
    for (int o = 0; o < 4; ++o) gden += __expf(lgts[o] - gm);
    const float gw = 1.f / gden;
    float e8[8];
#pragma unroll
    for (int o = 0; o < 8; ++o) { e8[o] = gs == 0 ? le[o] : gs == 1 ? le[8 + o] : gs == 2 ? le[16 + o] : le[24 + o]; }
    float m1 = e8[0]; int i1 = 0;
#pragma unroll
    for (int o = 1; o < 8; ++o) if (e8[o] > m1) { m1 = e8[o]; i1 = o; }
    float m2 = -3.0e38f; int i2 = 0;
#pragma unroll
    for (int o = 0; o < 8; ++o) if (o != i1 && e8[o] > m2) { m2 = e8[o]; i2 = o; }
    const float p2 = __expf(m2 - m1), inv = 1.f / (1.f + p2);
    if (lane == 0) {
        ((float*)(ws + WS_RSTD1))[t] = rstd;
        ((int*)(ws + WS_SEL))[t * 2] = gs * 8 + i1; ((int*)(ws + WS_SEL))[t * 2 + 1] = gs * 8 + i2;
        ((float*)(ws + WS_CW))[t * 2] = gw * inv; ((float*)(ws + WS_CW))[t * 2 + 1] = gw * p2 * inv;
    }
}
__global__ void __launch_bounds__(256) k_moe_up(unsigned char* ws, const float* g, const float* wg, const float* wu) {
    const int tk = blockIdx.x, t = tk >> 1, f = threadIdx.x;
    const int e = ((const int*)(ws + WS_SEL))[tk]; const float cw = ((const float*)(ws + WS_CW))[tk], rstd = ((const float*)(ws + WS_RSTD1))[t];
    const bf16* xb = (const bf16*)(ws + WS_X1B) + (size_t)t * D;
    const float* Wg = wg + (size_t)e * D * FF; const float* Wu = wu + (size_t)e * D * FF;
    float a = 0.f, u = 0.f;
    for (int d = 0; d < D; ++d) { const float hv = bf2f(xb[d]) * g[d]; a += hv * Wg[(size_t)d * FF + f]; u += hv * Wu[(size_t)d * FF + f]; }
    a *= rstd; u *= rstd;
    ((bf16*)(ws + WS_HIDN))[(size_t)tk * FF + f] = (bf16)f2bf(a * sigmoidf_(a) * u * cw);
}
__global__ void __launch_bounds__(256) k_moe_down(unsigned char* ws, float* out, const float* wd) {
    const int t = blockIdx.x, c0 = threadIdx.x * 4;
    float4 acc = *(const float4*)(out + (size_t)t * D + c0);
    for (int k = 0; k < 2; ++k) {
        const int e = ((const int*)(ws + WS_SEL))[t * 2 + k]; const float* Wd = wd + (size_t)e * FF * D;
        const bf16* hid = (const bf16*)(ws + WS_HIDN) + (size_t)(t * 2 + k) * FF;
        for (int f = 0; f < FF; ++f) { const float hv = bf2f(hid[f]); const float4 w = *(const float4*)(Wd + (size_t)f * D + c0); acc.x += hv * w.x; acc.y += hv * w.y; acc.z += hv * w.z; acc.w += hv * w.w; }
    }
    *(float4*)(out + (size_t)t * D + c0) = acc;
}
__global__ void __launch_bounds__(256) k_x2_stats(unsigned char* ws, const float* x2) {
    const int row = blockIdx.x * 4 + (threadIdx.x >> 6), lane = threadIdx.x & 63;
    const float4* xr = (const float4*)(x2 + (size_t)row * D) + lane; float s = 0.f;
#pragma unroll
    for (int j = 0; j < 4; ++j) { const float4 v = xr[64 * j]; s += v.x * v.x + v.y * v.y + v.z * v.z + v.w * v.w;
        uint2 o; o.x = f2bf(v.x) | (f2bf(v.y) << 16); o.y = f2bf(v.z) | (f2bf(v.w) << 16); ((uint2*)((bf16*)(ws + WS_X2B) + (size_t)row * D))[lane + 64 * j] = o; }
    s = wave_sum(s);
    if (lane == 0) ((float*)(ws + WS_RSTD2))[row] = rsqrtf(s * (1.f / D) + EPS);
}
__global__ void __launch_bounds__(256) k_pp_stats(unsigned char* ws) {
    const int row = blockIdx.x * 4 + (threadIdx.x >> 6), lane = threadIdx.x & 63;
    const bf16* pr = (const bf16*)(ws + WS_PP) + (size_t)row * D; float s = 0.f;
#pragma unroll
    for (int j = 0; j < 16; ++j) { const float v = bf2f(pr[j * 64 + lane]); s += v * v; }
    s = wave_sum(s);
    if (lane == 0) ((float*)(ws + WS_RSTDP))[row] = rsqrtf(s * (1.f / D) + EPS);
}

extern "C" void kernel_launch(void* const* d_in, const int* in_sizes, int n_in, void* d_out, int out_size, void* d_ws, size_t ws_size, hipStream_t stream) {
    static int grid = 0;
    if (grid == 0) {
        if (n_in != 24 || in_sizes[0] != T * D || out_size != T * D || ws_size < WS_END) { fprintf(stderr, "kernel_launch: unexpected shapes (n_in %d, in0 %d, out %d, ws %zu); nothing launched\n", n_in, n_in > 0 ? in_sizes[0] : -1, out_size, ws_size); grid = -1; return; }
        int dev = 0, cus = 0, per_cu = 0;
        if (hipGetDevice(&dev) != hipSuccess || hipDeviceGetAttribute(&cus, hipDeviceAttributeMultiprocessorCount, dev) != hipSuccess) { grid = -1; return; }
        if (hipFuncSetAttribute((const void*)mk_fwd, hipFuncAttributeMaxDynamicSharedMemorySize, LDS_BYTES) != hipSuccess) { fprintf(stderr, "kernel_launch: hipFuncSetAttribute failed\n"); grid = -1; return; }
        if (hipOccupancyMaxActiveBlocksPerMultiprocessor(&per_cu, (const void*)mk_fwd, NWAVES * 64, LDS_BYTES) != hipSuccess || per_cu < 1) { fprintf(stderr, "kernel_launch: occupancy query says %d workgroups per CU\n", per_cu); }
        (void)hipGetLastError();
        grid = cus;
        (void)hipFuncSetAttribute((const void*)k_ret_out, hipFuncAttributeMaxDynamicSharedMemorySize, 131072);
    }
    if (grid < 0) return;
    const float* x = (const float*)d_in[0]; const float* p = (const float*)d_in[1];
    const float* gn_g = (const float*)d_in[4]; const float* gn_b = (const float*)d_in[5]; const float* w_ret_o = (const float*)d_in[6];
    const float* sinks = (const float*)d_in[9];
    const float* w_swa_o = (const float*)d_in[10]; const float* w_out = (const float*)d_in[11]; const float* ffn_g = (const float*)d_in[12];
    const float* wrg = (const float*)d_in[13]; const float* brg = (const float*)d_in[14]; const float* wre = (const float*)d_in[15]; const float* bre = (const float*)d_in[16];
    const float* weg = (const float*)d_in[17]; const float* weu = (const float*)d_in[18]; const float* wed = (const float*)d_in[19];
    const float* pg_g = (const float*)d_in[20]; const float* w_pg = (const float*)d_in[21]; const float* w_ple = (const float*)d_in[22]; const float* ple_g = (const float*)d_in[23];
    unsigned char* ws = (unsigned char*)d_ws; float* out = (float*)d_out;

    Args a{};
    for (int i = 0; i < 24; ++i) a.in[i] = (const float*)d_in[i];
    a.out = out; a.ws = ws;
#define MK(lo, hi) do { (void)hipMemsetAsync(ws + WS_CTL, 0, CTL_ZERO_BYTES, stream); a.ph_lo = (lo); a.ph_hi = (hi); hipLaunchKernelGGL(mk_fwd, dim3(grid), dim3(NWAVES * 64), LDS_BYTES, stream, a); } while (0)
    MK(0, 12);
}
```
